# Optimizing an MI355X kernel written in HIP

```python
import jax, jax.numpy as jnp
from jax import lax
import numpy as np

D_MODEL = 1024
BATCH = 2
SEQ = 8192
DEPTH = 4

GLA_HEADS = 4
GLA_DK = 128
GLA_DV = 128
GLA_QK = GLA_HEADS * GLA_DK
GLA_V = GLA_HEADS * GLA_DV
GLA_GATE_RANK = 16
GLA_GATE_NORM = 16.0
GLA_CHUNK = 64
GMLP_GROUPS = 4
GMLP_GROUP_CH = 128
GMLP_WIDTH = GMLP_GROUPS * GMLP_GROUP_CH
GMLP_CHUNK = 128
MOBA_HEADS = 4
MOBA_HD = 128
MOBA_W = MOBA_HEADS * MOBA_HD
MOBA_BLOCK = 256
MOBA_TOPK = 3
MOBA_QBLOCK = 64
ROPE_THETA = 500000.0
ROPE_DIMS = MOBA_HD // 4
N_BRANCH = 3
BRANCH_W = 512
D_FF = 4 * D_MODEL
IN_COLS = 2 * GLA_QK + 2 * GLA_V + GLA_GATE_RANK + 2 * GMLP_WIDTH + 3 * MOBA_W + N_BRANCH * D_MODEL
DEEPNORM_ALPHA = (2 * DEPTH) ** 0.25
DEEPNORM_BETA = (8 * DEPTH) ** -0.25
LN_EPS = 1e-5
RMS_EPS = 1e-6

kernel_name = 'hybrid_gla_gmlp_moba_deepnorm'


def layer_norm(x, g, b):
    xf = x.astype(jnp.float32)
    mu = jnp.mean(xf, axis=-1, keepdims=True)
    xc = xf - mu
    var = jnp.mean(xc * xc, axis=-1, keepdims=True)
    return (xc * lax.rsqrt(var + LN_EPS) * g + b).astype(x.dtype)


def partial_rope(t, positions):
    half = ROPE_DIMS // 2
    inv = 1.0 / (ROPE_THETA ** (jnp.arange(half, dtype=jnp.float32) * (2.0 / ROPE_DIMS)))
    ang = positions.astype(jnp.float32)[:, :, None] * inv
    cos = jnp.cos(ang)[:, :, None, :]
    sin = jnp.sin(ang)[:, :, None, :]
    tr = t[..., :ROPE_DIMS].astype(jnp.float32)
    x1, x2 = tr[..., :half], tr[..., half:]
    rot = jnp.concatenate([x1 * cos - x2 * sin, x2 * cos + x1 * sin], axis=-1)
    return jnp.concatenate([rot.astype(t.dtype), t[..., ROPE_DIMS:]], axis=-1)


def gla_branch(q, k, v, g, lr, w_gate_up, b_gate, norm_w):
    B, S, _ = q.shape
    H, DK, DV, C = GLA_HEADS, GLA_DK, GLA_DV, GLA_CHUNK
    nC = S // C
    f32 = jnp.float32

    def heads(t, d):
        return t.astype(f32).reshape(B, nC, C, H, d).transpose(0, 3, 1, 2, 4)

    log_a = jax.nn.log_sigmoid((lr @ w_gate_up + b_gate).astype(f32)) / GLA_GATE_NORM
    bcum = jnp.cumsum(heads(log_a, DK), axis=3)
    qh = heads(q, DK) * (DK ** -0.5)
    kh = heads(k, DK)
    vh = heads(v, DV)
    q_dec = qh * jnp.exp(bcum)
    k_inv = kh * jnp.exp(-bcum)
    causal = jnp.tril(jnp.ones((C, C), dtype=bool))
    attn = jnp.where(causal, jnp.einsum('bhntd,bhnsd->bhnts', q_dec, k_inv), 0.0)
    o_intra = jnp.einsum('bhnts,bhnsv->bhntv', attn, vh)
    b_end = bcum[:, :, :, -1:, :]
    kv_chunk = jnp.einsum('bhnsd,bhnsv->bhndv', kh * jnp.exp(b_end - bcum), vh)
    decay = jnp.exp(b_end[:, :, :, 0, :])

    def step(state, inp):
        kv_n, dec_n = inp
        return dec_n[..., None] * state + kv_n, state

    _, states = lax.scan(step, jnp.zeros((B, H, DK, DV), f32),
                         (jnp.moveaxis(kv_chunk, 2, 0), jnp.moveaxis(decay, 2, 0)))
    states = jnp.moveaxis(states, 0, 2)
    o = o_intra + jnp.einsum('bhntd,bhndv->bhntv', q_dec, states)
    o = o.transpose(0, 2, 3, 1, 4).reshape(B, S, H, DV)
    o = o * lax.rsqrt(jnp.mean(o * o, axis=-1, keepdims=True) + RMS_EPS) * norm_w
    o = o.reshape(B, S, H * DV) * jax.nn.silu(g.astype(f32))
    return o.astype(q.dtype)


def gmlp_branch(z, ln_g, ln_b, w_s, b_s):
    B, S, _ = z.shape
    G, CH, C = GMLP_GROUPS, GMLP_GROUP_CH, GMLP_CHUNK
    z = jax.nn.gelu(z, approximate=False)
    u, v = jnp.split(z, 2, axis=-1)
    v = layer_norm(v, ln_g, ln_b).reshape(B, S // C, C, G, CH)
    w = w_s * jnp.tril(jnp.ones((C, C), dtype=w_s.dtype))
    vs = jnp.einsum('gts,bnsgc->bntgc', w, v) + b_s.T[None, None, :, :, None]
    return u * vs.reshape(B, S, GMLP_WIDTH)


def moba_branch(q, k, v, positions):
    B, S, _ = q.shape
    H, HD, BLK, QB = MOBA_HEADS, MOBA_HD, MOBA_BLOCK, MOBA_QBLOCK
    f32 = jnp.float32
    qh = partial_rope(q.reshape(B, S, H, HD), positions).transpose(0, 2, 1, 3)
    kh = partial_rope(k.reshape(B, S, H, HD), positions).transpose(0, 2, 1, 3)
    vh = v.reshape(B, S, H, HD).transpose(0, 2, 1, 3)
    n_blk = -(-S // BLK)
    s_pad = n_blk * BLK
    pad = ((0, 0), (0, 0), (0, s_pad - S), (0, 0))
    kh = jnp.pad(kh, pad)
    vh = jnp.pad(vh, pad)
    k_blocks = kh.reshape(B, H, n_blk, BLK, HD)
    v_blocks = vh.reshape(B, H, n_blk, BLK, HD)
    k_mean = jnp.mean(k_blocks.astype(f32), axis=3)
    own_blk = jnp.arange(S) // BLK
    fully_past = jnp.arange(n_blk)[None, :] < own_blk[:, None]
    gate = jnp.where(fully_past, jnp.einsum('bhsd,bhnd->bhsn', qh.astype(f32), k_mean), -jnp.inf)
    n_sel = min(MOBA_TOPK, n_blk)
    _, sel = lax.top_k(gate, n_sel)
    nQ = S // QB
    q_c = jnp.moveaxis(qh.reshape(B, H, nQ, QB, HD), 2, 0)
    sel_c = jnp.moveaxis(sel.reshape(B, H, nQ, QB, n_sel), 2, 0)
    starts = jnp.arange(nQ, dtype=jnp.int32) * QB
    gather = jax.vmap(jax.vmap(lambda blocks, ids: blocks[ids]))
    scale = HD ** -0.5

    def attend(args):
        qb, sb, start = args
        t = start + jnp.arange(QB)
        blk_start = (start // BLK) * BLK
        kg = gather(k_blocks, sb)
        vg = gather(v_blocks, sb)
        s_g = jnp.einsum('bhqd,bhqjkd->bhqjk', qb, kg).astype(f32) * scale
        valid = jnp.arange(n_sel)[None, :] < (t // BLK)[:, None]
        s_g = jnp.where(valid[:, :, None], s_g, -jnp.inf).reshape(B, H, QB, n_sel * BLK)
        k_own = lax.dynamic_slice_in_dim(kh, blk_start, BLK, axis=2)
        v_own = lax.dynamic_slice_in_dim(vh, blk_start, BLK, axis=2)
        s_o = jnp.einsum('bhqd,bhkd->bhqk', qb, k_own).astype(f32) * scale
        s_o = jnp.where((blk_start + jnp.arange(BLK))[None, :] <= t[:, None], s_o, -jnp.inf)
        p = jax.nn.softmax(jnp.concatenate([s_g, s_o], axis=-1), axis=-1).astype(vh.dtype)
        p_g = p[..., :n_sel * BLK].reshape(B, H, QB, n_sel, BLK)
        return (jnp.einsum('bhqjk,bhqjkd->bhqd', p_g, vg)
                + jnp.einsum('bhqk,bhkd->bhqd', p[..., n_sel * BLK:], v_own))

    out = lax.map(attend, (q_c, sel_c, starts))
    out = jnp.moveaxis(out, 0, 2).reshape(B, H, S, HD)
    return out.transpose(0, 2, 1, 3).reshape(B, S, MOBA_W)


def mixer_sublayer(x, positions, w_in, w_gate_up, b_gate, gla_norm_w, gmlp_ln_g, gmlp_ln_b,
                   gmlp_w_s, gmlp_b_s, w_branch, w_out):
    sizes = [GLA_QK, GLA_QK, GLA_V, GLA_V, GLA_GATE_RANK, 2 * GMLP_WIDTH,
             MOBA_W, MOBA_W, MOBA_W, N_BRANCH * D_MODEL]
    offsets = [int(o) for o in np.cumsum(sizes)[:-1]]
    proj = x @ w_in
    gq, gk, gv, gg, glr, gz, mq, mk, mv, gl = jnp.split(proj, offsets, axis=-1)
    a = gla_branch(gq, gk, gv, gg, glr, w_gate_up, b_gate, gla_norm_w) @ w_branch[0]
    b = gmlp_branch(gz, gmlp_ln_g, gmlp_ln_b, gmlp_w_s, gmlp_b_s) @ w_branch[1]
    c = moba_branch(mq, mk, mv, positions) @ w_branch[2]
    ga, gb, gc = jnp.split(jax.nn.sigmoid(gl), N_BRANCH, axis=-1)
    return (ga * a + gb * b + gc * c) @ w_out


def setup_inputs(seed: int = 0) -> dict:
    key = jax.random.key(seed)
    ks = jax.random.split(key, 20)
    L, D = DEPTH, D_MODEL
    nrm = lambda k, shape, s: jax.random.normal(k, shape, jnp.float32) * s
    offset = jax.random.randint(ks[1], (BATCH, 1), 0, 1024, dtype=jnp.int32)
    return {
        'x': nrm(ks[0], (BATCH, SEQ, D), 1.0),
        'positions': offset + jnp.arange(SEQ, dtype=jnp.int32)[None, :],
        'w_in': nrm(ks[2], (L, D, IN_COLS), D ** -0.5),
        'w_gate_up': nrm(ks[3], (L, GLA_GATE_RANK, GLA_QK), GLA_GATE_RANK ** -0.5),
        'b_gate': nrm(ks[4], (L, GLA_QK), 0.1),
        'gla_norm_w': 1.0 + nrm(ks[5], (L, GLA_DV), 0.02),
        'gmlp_ln_g': 1.0 + nrm(ks[6], (L, GMLP_WIDTH), 0.02),
        'gmlp_ln_b': nrm(ks[7], (L, GMLP_WIDTH), 0.02),
        'gmlp_w_s': nrm(ks[8], (L, GMLP_GROUPS, GMLP_CHUNK, GMLP_CHUNK), 0.5 * GMLP_CHUNK ** -0.5),
        'gmlp_b_s': 1.0 + nrm(ks[9], (L, GMLP_GROUPS, GMLP_CHUNK), 0.1),
        'w_branch': nrm(ks[10], (L, N_BRANCH, BRANCH_W, D), BRANCH_W ** -0.5),
        'w_out': nrm(ks[11], (L, D, D), DEEPNORM_BETA * D ** -0.5),
        'ln1_g': 1.0 + nrm(ks[12], (L, D), 0.02),
        'ln1_b': nrm(ks[13], (L, D), 0.02),
        'w_ff1': nrm(ks[14], (L, D, D_FF), D ** -0.5),
        'w_ff2': nrm(ks[15], (L, D_FF, D), DEEPNORM_BETA * D_FF ** -0.5),
        'ln2_g': 1.0 + nrm(ks[16], (L, D), 0.02),
        'ln2_b': nrm(ks[17], (L, D), 0.02),
    }


def reference(x, positions, w_in, w_gate_up, b_gate, gla_norm_w, gmlp_ln_g, gmlp_ln_b, gmlp_w_s,
              gmlp_b_s, w_branch, w_out, ln1_g, ln1_b, w_ff1, w_ff2, ln2_g, ln2_b):
    for l in range(DEPTH):
        mix = mixer_sublayer(x, positions, w_in[l], w_gate_up[l], b_gate[l], gla_norm_w[l],
                             gmlp_ln_g[l], gmlp_ln_b[l], gmlp_w_s[l], gmlp_b_s[l], w_branch[l], w_out[l])
        x = layer_norm(DEEPNORM_ALPHA * x + mix, ln1_g[l], ln1_b[l])
        ff = jnp.square(jax.nn.relu(x @ w_ff1[l])) @ w_ff2[l]
        x = layer_norm(DEEPNORM_ALPHA * x + ff, ln2_g[l], ln2_b[l])
    return x
```

```cpp
#include <hip/hip_runtime.h>
#include <hip/hip_cooperative_groups.h>
#include <cstdio>
#include <cstdint>
namespace cg = cooperative_groups;

#define LAS __attribute__((address_space(3)))
typedef unsigned short bf16_t;
typedef short bf16x8 __attribute__((ext_vector_type(8)));
typedef short s16x4 __attribute__((ext_vector_type(4)));
typedef float f32x4 __attribute__((ext_vector_type(4)));
typedef float f32x2 __attribute__((ext_vector_type(2)));
typedef unsigned u32x4 __attribute__((ext_vector_type(4)));
typedef unsigned u32x2 __attribute__((ext_vector_type(2)));

constexpr int BATCH = 2, SEQ = 8192, M = BATCH * SEQ, D = 1024, DEPTH = 4, FF = 4096;
constexpr int IN_COLS = 7696, NP = 7680;
constexpr int C_GQ = 0, C_GK = 512, C_GV = 1024, C_GG = 1536, C_GZU = 2048, C_GZV = 2560, C_MQ = 3072, C_MK = 3584, C_MV = 4096, C_GL = 4608;
constexpr int NWAVES = 8, NTHREADS = 512;
constexpr int LDS_BYTES = 147456;
constexpr float LN_EPS = 1e-5f, RMS_EPS = 1e-6f;
constexpr int PH_PER_LAYER = 11, N_PHASES = DEPTH * PH_PER_LAYER;

constexpr size_t MiB = 1u << 20;
constexpr size_t WS_WIN = 0, WS_GLR = 15 * MiB, WS_WBR = 16 * MiB, WS_WOUT = 19 * MiB, WS_W1 = 21 * MiB, WS_W2 = 29 * MiB;
constexpr size_t WS_XBF = 38 * MiB;
constexpr size_t WS_BR = 70 * MiB;
constexpr size_t WS_ST = 118 * MiB;
constexpr size_t WS_DEC = 150 * MiB;
constexpr size_t WS_KMEAN = WS_DEC + 512 * 1024;
constexpr size_t WS_VT = 151 * MiB;
constexpr size_t WS_MERGED = 167 * MiB;
constexpr size_t WS_PROJ = 200 * MiB;
constexpr size_t WS_END = 440 * MiB;

typedef __bf16 bf16x2_t __attribute__((ext_vector_type(2)));
__device__ __forceinline__ unsigned cvt_pk_bf16(float lo, float hi) { const f32x2 v = {lo, hi}; const bf16x2_t b = __builtin_convertvector(v, bf16x2_t); return __builtin_bit_cast(unsigned, b); }
__device__ __forceinline__ float bf2f(unsigned h) { return __builtin_bit_cast(float, h << 16); }
__device__ __forceinline__ float bflo(unsigned w) { return __builtin_bit_cast(float, w << 16); }
__device__ __forceinline__ float bfhi(unsigned w) { return __builtin_bit_cast(float, w & 0xffff0000u); }
__device__ __forceinline__ int otid() { int t = threadIdx.x; asm volatile("" : "+v"(t)); return t; }
__device__ __forceinline__ f32x4 mfma16(bf16x8 a, bf16x8 b, f32x4 c) { return __builtin_amdgcn_mfma_f32_16x16x32_bf16(a, b, c, 0, 0, 0); }

namespace pg8 {
constexpr int BM = 256, BK = 64, HALF = 128, HTB = HALF * BK * 2, NXCD = 8, WGM = 8;
__host__ __device__ __forceinline__ int lds_byte(int r, int c) { const int st = (r >> 4) * 2 + (c >> 5), rr = r & 15, cc = c & 31, ob = rr * 64 + cc * 2; return st * 1024 + (ob ^ (((ob >> 9) & 1) << 5)); }
__host__ __device__ __forceinline__ void stage_rc(int b, int& R, int& C) { const int st = b / 1024, sb = b % 1024, swz = sb ^ (((sb >> 9) & 1) << 5); R = (st >> 1) * 16 + swz / 64; C = (st & 1) * 32 + (swz % 64) / 2; }
__host__ __device__ __forceinline__ int perm32(int rho) { const int n = rho >> 4, i = rho & 15; return 8 * (i >> 2) + 4 * n + (i & 3); }

struct Unit { int pm, pn; };
struct Gemm { const bf16_t* A; const bf16_t* Bt; int M, N, K, lda; };

struct StaticOrder {
    int nM, nN, nwg, G, c;
    __device__ void init(int M_, int N_, int G_, int c_) { nM = M_ / BM; nN = N_ / BM; nwg = nM * nN; G = G_; c = c_; }
    __device__ bool next(int i, Unit& u) const {
        const long L = (long)i * G + c; if (L >= nwg) return false;
        int wgid = (int)L; { const int q = nwg / NXCD, r = nwg % NXCD, xcd = wgid % NXCD, off = wgid / NXCD; wgid = (xcd < r ? xcd * (q + 1) : r * (q + 1) + (xcd - r) * q) + off; }
        const int nig = WGM * nN, gid = wgid / nig, fm = gid * WGM, gsz = (nM - fm) < WGM ? (nM - fm) : WGM;
        u.pm = fm + ((wgid % nig) % gsz); u.pn = (wgid % nig) / gsz; return true;
    }
};
struct MergeOrder {
    int G, c;
    __device__ bool next(int i, Unit& u) const { const int t = (i / 3) * G + c; if (t >= 256) return false; const int br = i % 3; u.pm = br * 64 + (t >> 2); u.pn = br * 4 + (t & 3); return true; }
};

template <int ACT  > struct EpiStore {
    bf16_t* O; int ldc;
    __device__ __forceinline__ void operator()(const f32x4 (&acc)[2][2][4][2], const Unit& u, int wr, int wc, int fr, int fq) const {
        const int row0 = u.pm * BM + wr * 64 + fr, col0 = u.pn * BM + wc * 32 + 8 * fq;
#pragma unroll
        for (int ai = 0; ai < 2; ++ai)
#pragma unroll
            for (int m = 0; m < 4; ++m) { bf16_t* rowp = O + (size_t)(row0 + ai * HALF + m * 16) * ldc + col0;
#pragma unroll
                for (int bj = 0; bj < 2; ++bj) { f32x4 v0 = acc[ai][bj][m][0], v1 = acc[ai][bj][m][1];
                    if (ACT == 2) {
#pragma unroll
                        for (int e = 0; e < 4; ++e) { float a = fmaxf(v0[e], 0.f), b = fmaxf(v1[e], 0.f); v0[e] = a * a; v1[e] = b * b; } }
                    u32x4 w; w.x = cvt_pk_bf16(v0[0], v0[1]); w.y = cvt_pk_bf16(v0[2], v0[3]); w.z = cvt_pk_bf16(v1[0], v1[1]); w.w = cvt_pk_bf16(v1[2], v1[3]);
                    *(u32x4*)(rowp + bj * HALF) = w; } }
    }
};
struct EpiResid {
    const float* R; float* O; float alpha;
    __device__ __forceinline__ void operator()(const f32x4 (&acc)[2][2][4][2], const Unit& u, int wr, int wc, int fr, int fq) const {
        const int row0 = u.pm * BM + wr * 64 + fr, col0 = u.pn * BM + wc * 32 + 8 * fq;
#pragma unroll
        for (int ai = 0; ai < 2; ++ai)
#pragma unroll
            for (int m = 0; m < 4; ++m) { const size_t off = (size_t)(row0 + ai * HALF + m * 16) * 1024 + col0;
#pragma unroll
                for (int bj = 0; bj < 2; ++bj) { const f32x4 r0 = *(const f32x4*)(R + off + bj * HALF), r1 = *(const f32x4*)(R + off + bj * HALF + 4);
                    *(f32x4*)(O + off + bj * HALF) = r0 * alpha + acc[ai][bj][m][0]; *(f32x4*)(O + off + bj * HALF + 4) = r1 * alpha + acc[ai][bj][m][1]; } }
    }
};
struct EpiMerge {
    const bf16_t* proj; float* stash; bf16_t* merged;
    __device__ __forceinline__ void operator()(const f32x4 (&acc)[2][2][4][2], const Unit& u, int wr, int wc, int fr, int fq) const {
        const int br = u.pm >> 6, tm = u.pm & 63, tn = u.pn & 3;
        const int row0 = tm * BM + wr * 64 + fr, col0 = tn * BM + wc * 32 + 8 * fq;
#pragma unroll
        for (int ai = 0; ai < 2; ++ai)
#pragma unroll
            for (int m = 0; m < 4; ++m) { const int row = row0 + ai * HALF + m * 16;
#pragma unroll
                for (int bj = 0; bj < 2; ++bj) { const int col = col0 + bj * HALF;
                    const u32x4 gw = *(const u32x4*)(proj + (size_t)row * NP + C_GL + br * 1024 + col);
                    float g[8] = {bflo(gw.x), bfhi(gw.x), bflo(gw.y), bfhi(gw.y), bflo(gw.z), bfhi(gw.z), bflo(gw.w), bfhi(gw.w)};
                    f32x4 v0, v1;
#pragma unroll
                    for (int e = 0; e < 4; ++e) { v0[e] = acc[ai][bj][m][0][e] / (1.f + __expf(-g[e])); v1[e] = acc[ai][bj][m][1][e] / (1.f + __expf(-g[4 + e])); }
                    float* sp = stash + (size_t)row * 3840 + col;
                    if (br == 0) { *(f32x4*)sp = v0; *(f32x4*)(sp + 4) = v1; }
                    else { v0 += *(const f32x4*)sp; v1 += *(const f32x4*)(sp + 4);
                        if (br == 1) { *(f32x4*)sp = v0; *(f32x4*)(sp + 4) = v1; }
                        else { u32x4 w; w.x = cvt_pk_bf16(v0[0], v0[1]); w.y = cvt_pk_bf16(v0[2], v0[3]); w.z = cvt_pk_bf16(v1[0], v1[1]); w.w = cvt_pk_bf16(v1[2], v1[3]);
                            *(u32x4*)(merged + (size_t)row * 1024 + col) = w; } } } }
    }
};

template <class Epi, class Sched>
__device__ __forceinline__ void gemm_phase(LAS unsigned char* lds, const Gemm g, const Sched& S, const Epi& E) {
    const int tid = otid(), wid = __builtin_amdgcn_readfirstlane(tid >> 6), lane = tid & 63, wr = wid >> 2, wc = wid & 3, fr = lane & 15, fq = lane >> 4;
    const int K = g.K, nt = K / BK, lda = g.lda;
    unsigned voffA[2], voffB[2];
#pragma unroll
    for (int i = 0; i < 2; ++i) { int R, C; stage_rc(tid * 16 + i * 8192, R, C); const int Rb = (R & ~31) + perm32(R & 31);
        voffA[i] = (unsigned)(R * lda + C) * 2u; voffB[i] = (unsigned)(Rb * K + C) * 2u; }
    const size_t kstep = (size_t)(BK * 2);
    const size_t hstepA = (size_t)HALF * lda * 2, hstepB = (size_t)HALF * K * 2;
    const size_t tstepA = 2 * hstepA, tstepB = 2 * hstepB;
    const unsigned ldsw = (unsigned)wid * 1024u;
    const int aoff = lds_byte(wr * 64 + fr, fq * 8), boff = lds_byte(wc * 32 + fr, fq * 8);
#define PG8_SA(b, h) (((b) * 2 + (h)) * HTB)
#define PG8_SB(b, h) ((4 + (b) * 2 + (h)) * HTB)
#define PG8_STAGE(bufoff, gbase, voff) do { _Pragma("unroll") for (int _i = 0; _i < 2; ++_i) \
        __builtin_amdgcn_global_load_lds((const unsigned*)((const char*)(gbase) + (voff)[_i]), (LAS unsigned*)(lds + (bufoff) + ldsw + _i * 8192), 16, 0, 0); } while (0)
#define PG8_LDA(dst, b, h) do { _Pragma("unroll") for (int m = 0; m < 4; ++m) _Pragma("unroll") for (int k = 0; k < 2; ++k) dst[m][k] = *(const LAS bf16x8*)(lds + PG8_SA(b, h) + aoff + m * 2048 + k * 1024); } while (0)
#define PG8_LDB(dst, b, h) do { _Pragma("unroll") for (int n = 0; n < 2; ++n) _Pragma("unroll") for (int k = 0; k < 2; ++k) dst[n][k] = *(const LAS bf16x8*)(lds + PG8_SB(b, h) + boff + n * 2048 + k * 1024); } while (0)
#define PG8_MMA(ai, bj, At, Bt) do { __builtin_amdgcn_s_setprio(1); _Pragma("unroll") for (int m = 0; m < 4; ++m) _Pragma("unroll") for (int n = 0; n < 2; ++n) _Pragma("unroll") for (int k = 0; k < 2; ++k) \
        acc[ai][bj][m][n] = __builtin_amdgcn_mfma_f32_16x16x32_bf16(Bt[n][k], At[m][k], acc[ai][bj][m][n], 0, 0, 0); __builtin_amdgcn_s_setprio(0); } while (0)
#define PG8_WAIT_V(n) asm volatile("s_waitcnt vmcnt(" #n ")" ::: "memory")
#define PG8_WAIT_L(n) asm volatile("s_waitcnt lgkmcnt(" #n ")" ::: "memory")
#define PG8_BAR __builtin_amdgcn_s_barrier()
#define PG8_SCHED __builtin_amdgcn_sched_barrier(0)
    Unit cur, nxt; int ui = 0;
    if (!S.next(0, cur)) return;
    f32x4 acc[2][2][4][2];
#pragma unroll
    for (int a = 0; a < 2; ++a)
#pragma unroll
        for (int b = 0; b < 2; ++b)
#pragma unroll
            for (int m = 0; m < 4; ++m)
#pragma unroll
                for (int n = 0; n < 2; ++n) acc[a][b][m][n] = (f32x4){0.f, 0.f, 0.f, 0.f};
    bf16x8 At[4][2], B0[2][2], B1[2][2];
    const char* cA = (const char*)g.A + (size_t)cur.pm * tstepA; const char* cB = (const char*)g.Bt + (size_t)cur.pn * tstepB;
    PG8_STAGE(PG8_SB(0, 0), cB, voffB); PG8_STAGE(PG8_SB(0, 1), cB + hstepB, voffB); PG8_STAGE(PG8_SA(0, 0), cA, voffA); PG8_STAGE(PG8_SA(0, 1), cA + hstepA, voffA);
    if (wr == 1) PG8_BAR;
    PG8_WAIT_V(2); PG8_BAR;
    PG8_STAGE(PG8_SB(1, 0), cB + kstep, voffB); PG8_STAGE(PG8_SA(1, 0), cA + kstep, voffA); PG8_STAGE(PG8_SB(1, 1), cB + hstepB + kstep, voffB);
    PG8_WAIT_V(6); PG8_BAR;
    for (;;) {
        const bool has_next = S.next(ui + 1, nxt);
        const char* nA = has_next ? (const char*)g.A + (size_t)nxt.pm * tstepA : cA; const char* nB = has_next ? (const char*)g.Bt + (size_t)nxt.pn * tstepB : cB;
        for (int t = 0; t < nt; t += 2) {
            const bool last = (t == nt - 2);
            const char* a1 = cA + (size_t)(t + 1) * kstep;
            const char* a2 = last ? nA : cA + (size_t)(t + 2) * kstep; const char* b2 = last ? nB : cB + (size_t)(t + 2) * kstep;
            const char* a3 = a2 + kstep; const char* b3 = b2 + kstep;
            PG8_LDB(B0, 0, 0); PG8_LDB(B1, 0, 1); PG8_SCHED; PG8_LDA(At, 0, 0); PG8_STAGE(PG8_SA(1, 1), a1 + hstepA, voffA);
            PG8_WAIT_V(8); PG8_WAIT_L(0); PG8_BAR; PG8_MMA(0, 0, At, B0); PG8_MMA(0, 1, At, B1); PG8_BAR; PG8_SCHED;
            PG8_LDA(At, 0, 1); PG8_STAGE(PG8_SB(0, 0), b2, voffB); PG8_STAGE(PG8_SB(0, 1), b2 + hstepB, voffB); PG8_STAGE(PG8_SA(0, 0), a2, voffA);
            PG8_WAIT_V(8); PG8_WAIT_L(0); PG8_BAR; PG8_MMA(1, 0, At, B0); PG8_MMA(1, 1, At, B1); PG8_BAR; PG8_SCHED;
            PG8_LDB(B0, 1, 0); PG8_LDB(B1, 1, 1); PG8_SCHED; PG8_LDA(At, 1, 0); PG8_STAGE(PG8_SA(0, 1), a2 + hstepA, voffA);
            PG8_WAIT_V(8); PG8_WAIT_L(0); PG8_BAR; PG8_MMA(0, 0, At, B0); PG8_MMA(0, 1, At, B1); PG8_BAR; PG8_SCHED;
            PG8_LDA(At, 1, 1); PG8_STAGE(PG8_SB(1, 0), b3, voffB); PG8_STAGE(PG8_SB(1, 1), b3 + hstepB, voffB); PG8_STAGE(PG8_SA(1, 0), a3, voffA);
            PG8_WAIT_V(8); PG8_WAIT_L(0); PG8_BAR; PG8_MMA(1, 0, At, B0); PG8_MMA(1, 1, At, B1); PG8_BAR; PG8_SCHED;
        }
        if (wr == 0) PG8_BAR;
        E(acc, cur, wr, wc, fr, fq);
        if (!has_next) break;
#pragma unroll
        for (int a = 0; a < 2; ++a)
#pragma unroll
            for (int b = 0; b < 2; ++b)
#pragma unroll
                for (int m = 0; m < 4; ++m)
#pragma unroll
                    for (int n = 0; n < 2; ++n) acc[a][b][m][n] = (f32x4){0.f, 0.f, 0.f, 0.f};
        cur = nxt; cA = nA; cB = nB; ++ui;
        if (wr == 1) PG8_BAR;
    }
    PG8_WAIT_V(0);
    PG8_BAR;
#undef PG8_SA
#undef PG8_SB
#undef PG8_STAGE
#undef PG8_LDA
#undef PG8_LDB
#undef PG8_MMA
#undef PG8_WAIT_V
#undef PG8_WAIT_L
#undef PG8_BAR
#undef PG8_SCHED
}
}

struct Args {
    const float* x; const int* pos; const float* w_in; const float* w_gate_up; const float* b_gate; const float* gla_norm_w; const float* gmlp_ln_g; const float* gmlp_ln_b;
    const float* gmlp_w_s; const float* gmlp_b_s; const float* w_branch; const float* w_out; const float* ln1_g; const float* ln1_b; const float* w_ff1; const float* w_ff2;
    const float* ln2_g; const float* ln2_b; float* out; unsigned char* ws; int ph_lo, ph_hi;
};

__device__ __forceinline__ float wave_sum(float v) {
#pragma unroll
    for (int o = 1; o < 64; o <<= 1) v += __shfl_xor(v, o);
    return v;
}

__device__ __forceinline__ void transpose_item(const float* W, int ldw, int col0, int K, int nblk, bf16_t* WT, int row_off, LAS float* scr, int item, int lane) {
    const int kb = item / nblk, nb = item % nblk, k0 = 64 * kb, n0 = 32 * nb;
#pragma unroll 8
    for (int i = 0; i < 32; ++i) { const int kk = 2 * i + (lane >> 5); scr[kk * 33 + (lane & 31)] = W[(size_t)(k0 + kk) * ldw + col0 + n0 + (lane & 31)]; }
    asm volatile("s_waitcnt lgkmcnt(0)" ::: "memory");
    const int c = lane & 7;
#pragma unroll
    for (int j = 0; j < 4; ++j) { const int n = (lane >> 3) + 8 * j; const LAS float* s = scr + (8 * c) * 33 + n;
        u32x4 o; o.x = cvt_pk_bf16(s[0 * 33], s[1 * 33]); o.y = cvt_pk_bf16(s[2 * 33], s[3 * 33]); o.z = cvt_pk_bf16(s[4 * 33], s[5 * 33]); o.w = cvt_pk_bf16(s[6 * 33], s[7 * 33]);
        *(u32x4*)(WT + (size_t)(row_off + n0 + n) * K + k0 + 8 * c) = o; }
    asm volatile("s_waitcnt lgkmcnt(0)" ::: "memory");
}

__device__ __forceinline__ void phase_prep(const Args& a, int l, LAS unsigned char* lds, int G) {
    const int tid = otid(), lane = tid & 63, wave = tid >> 6;
    LAS float* scr = (LAS float*)(lds + wave * 16384);
    const int gw = blockIdx.x * NWAVES + wave, NGW = G * NWAVES;
    bf16_t* WinT = (bf16_t*)(a.ws + WS_WIN); bf16_t* WbrT = (bf16_t*)(a.ws + WS_WBR); bf16_t* WoutT = (bf16_t*)(a.ws + WS_WOUT); bf16_t* W1T = (bf16_t*)(a.ws + WS_W1); bf16_t* W2T = (bf16_t*)(a.ws + WS_W2);
    const float* win = a.w_in + (size_t)l * D * IN_COLS;
    constexpr int I_IN_A = 16 * 64, I_IN_B = 16 * 176, I_BR = 8 * 32, I_OUT = 16 * 32, I_1 = 16 * 128, I_2 = 64 * 32;
    constexpr int NITEMS = I_IN_A + I_IN_B + 3 * I_BR + I_OUT + I_1 + I_2;
    for (int it = gw; it < NITEMS; it += NGW) {
        int r = it;
        if (r < I_IN_A) { transpose_item(win, IN_COLS, 0, D, 64, WinT, 0, scr, r, lane); continue; } r -= I_IN_A;
        if (r < I_IN_B) { transpose_item(win, IN_COLS, 2064, D, 176, WinT, 2048, scr, r, lane); continue; } r -= I_IN_B;
        if (r < 3 * I_BR) { const int br = r / I_BR; transpose_item(a.w_branch + ((size_t)l * 3 + br) * 512 * 1024, 1024, 0, 512, 32, WbrT, br * 1024, scr, r % I_BR, lane); continue; } r -= 3 * I_BR;
        if (r < I_OUT) { transpose_item(a.w_out + (size_t)l * D * D, D, 0, D, 32, WoutT, 0, scr, r, lane); continue; } r -= I_OUT;
        if (r < I_1) { transpose_item(a.w_ff1 + (size_t)l * D * FF, FF, 0, D, 128, W1T, 0, scr, r, lane); continue; } r -= I_1;
        transpose_item(a.w_ff2 + (size_t)l * FF * D, D, 0, FF, 32, W2T, 0, scr, r, lane);
    }
    { bf16_t* glrT = (bf16_t*)(a.ws + WS_GLR);
      for (int e = blockIdx.x * NTHREADS + tid; e < 16 * 1024; e += G * NTHREADS) { const int n = e >> 10, k = e & 1023; glrT[e] = (bf16_t)(cvt_pk_bf16(win[(size_t)k * IN_COLS + 2048 + n], 0.f) & 0xffffu); } }
    if (l == 0) {
        bf16_t* xbf = (bf16_t*)(a.ws + WS_XBF);
        for (size_t e = (size_t)(blockIdx.x * NTHREADS + tid) * 8; e < (size_t)M * D; e += (size_t)G * NTHREADS * 8) {
            const f32x4 v0 = *(const f32x4*)(a.x + e), v1 = *(const f32x4*)(a.x + e + 4);
            u32x4 w; w.x = cvt_pk_bf16(v0[0], v0[1]); w.y = cvt_pk_bf16(v0[2], v0[3]); w.z = cvt_pk_bf16(v1[0], v1[1]); w.w = cvt_pk_bf16(v1[2], v1[3]);
            *(u32x4*)(xbf + e) = w; }
    }
}

__device__ __forceinline__ void gla_bcum(const Args& a, int l, LAS unsigned char* lds, int m0, int h, float (&c)[16], float& bend) {
    const int tid = otid(), lane = tid & 63, wave = tid >> 6, fr = lane & 15, fq = lane >> 4;
    LAS float* lr = (LAS float*)lds; LAS float* tot = (LAS float*)(lds + 4352);
    const bf16_t* xbf = (const bf16_t*)(a.ws + WS_XBF); const bf16_t* glrT = (const bf16_t*)(a.ws + WS_GLR);
    if (wave < 4) {
        const bf16_t* ap = xbf + (size_t)(m0 + wave * 16 + fr) * D + fq * 8; const bf16_t* bp = glrT + (size_t)fr * D + fq * 8;
        f32x4 acc = {0.f, 0.f, 0.f, 0.f};
#pragma unroll 8
        for (int kk = 0; kk < 32; ++kk) { const bf16x8 av = *(const bf16x8*)(ap + kk * 32), bv = *(const bf16x8*)(bp + kk * 32); acc = mfma16(av, bv, acc); }
#pragma unroll
        for (int jj = 0; jj < 4; ++jj) lr[(wave * 16 + 4 * fq + jj) * 17 + fr] = acc[jj];
    }
    __syncthreads();
    const int d = tid & 127, g = tid >> 7, col = h * 128 + d;
    float wu[16];
#pragma unroll
    for (int r = 0; r < 16; ++r) wu[r] = a.w_gate_up[((size_t)l * 16 + r) * 512 + col];
    const float bg = a.b_gate[(size_t)l * 512 + col];
    float run = 0.f;
#pragma unroll
    for (int i = 0; i < 16; ++i) { const int s = g * 16 + i; float z = bg;
#pragma unroll
        for (int r = 0; r < 16; ++r) z += lr[s * 17 + r] * wu[r];
        const float la = (fminf(z, 0.f) - log1pf(__expf(-fabsf(z)))) * (1.f / 16.f);
        run += la; c[i] = run; }
    tot[g * 128 + d] = run;
    __syncthreads();
    float pre = 0.f, all = 0.f;
#pragma unroll
    for (int gg = 0; gg < 4; ++gg) { const float t = tot[gg * 128 + d]; all += t; if (gg < g) pre += t; }
#pragma unroll
    for (int i = 0; i < 16; ++i) c[i] += pre;
    bend = all;
}

__device__ __forceinline__ void gla_kv_unit(const Args& a, int l, LAS unsigned char* lds, int unit) {
    const int h = unit & 3, n = (unit >> 2) & 127, b = unit >> 9, m0 = b * SEQ + n * 64;
    const int tid = otid(), lane = tid & 63, wave = tid >> 6, fr = lane & 15, fq = lane >> 4;
    const bf16_t* proj = (const bf16_t*)(a.ws + WS_PROJ);
    float c[16], bend; gla_bcum(a, l, lds, m0, h, c, bend);
    const int d = tid & 127, g = tid >> 7, col = h * 128 + d;
    LAS unsigned char* keT = lds + 8192; LAS unsigned char* vT = lds + 8192 + 128 * 144;
    unsigned kw[8], vw[8];
#pragma unroll
    for (int i = 0; i < 16; i += 2) { const size_t r0 = (size_t)(m0 + g * 16 + i) * NP, r1 = r0 + NP;
        const float k0 = bf2f(proj[r0 + C_GK + col]) * __expf(bend - c[i]), k1 = bf2f(proj[r1 + C_GK + col]) * __expf(bend - c[i + 1]);
        kw[i >> 1] = cvt_pk_bf16(k0, k1); vw[i >> 1] = (unsigned)proj[r0 + C_GV + col] | ((unsigned)proj[r1 + C_GV + col] << 16); }
    *(LAS u32x4*)(keT + d * 144 + g * 32) = (u32x4){kw[0], kw[1], kw[2], kw[3]}; *(LAS u32x4*)(keT + d * 144 + g * 32 + 16) = (u32x4){kw[4], kw[5], kw[6], kw[7]};
    *(LAS u32x4*)(vT + d * 144 + g * 32) = (u32x4){vw[0], vw[1], vw[2], vw[3]}; *(LAS u32x4*)(vT + d * 144 + g * 32 + 16) = (u32x4){vw[4], vw[5], vw[6], vw[7]};
    const int bh = b * 4 + h;
    if (g == 0) ((float*)(a.ws + WS_DEC))[((size_t)bh * 128 + n) * 128 + d] = __expf(bend);
    __syncthreads();
    bf16_t* ST = (bf16_t*)(a.ws + WS_ST) + ((size_t)bh * 128 + n) * 16384;
    bf16x8 af[2];
#pragma unroll
    for (int kk = 0; kk < 2; ++kk) af[kk] = *(const LAS bf16x8*)(keT + (wave * 16 + fr) * 144 + kk * 64 + fq * 16);
#pragma unroll
    for (int dvt = 0; dvt < 8; ++dvt) { f32x4 acc = {0.f, 0.f, 0.f, 0.f};
#pragma unroll
        for (int kk = 0; kk < 2; ++kk) { const bf16x8 bv = *(const LAS bf16x8*)(vT + (dvt * 16 + fr) * 144 + kk * 64 + fq * 16); acc = mfma16(af[kk], bv, acc); }
        u32x2 w; w.x = cvt_pk_bf16(acc[0], acc[1]); w.y = cvt_pk_bf16(acc[2], acc[3]);
        *(u32x2*)(ST + (size_t)(dvt * 16 + fr) * 128 + wave * 16 + 4 * fq) = w; }
    __syncthreads();
}

__device__ __forceinline__ void gla_scan(const Args& a, int G) {
    const int tid = otid();
    for (int e = blockIdx.x * NTHREADS + tid; e < 8 * 128 * 64; e += G * NTHREADS) {
        const int dkp = e & 63, dv = (e >> 6) & 127, bh = e >> 13;
        unsigned* st = (unsigned*)(a.ws + WS_ST) + ((size_t)bh * 128 * 16384 + (size_t)dv * 128) / 2 + dkp;
        const f32x2* dec = (const f32x2*)(a.ws + WS_DEC) + ((size_t)bh * 128 * 128) / 2 + dkp;
        float s0 = 0.f, s1 = 0.f;
#pragma unroll 8
        for (int n = 0; n < 128; ++n) { const unsigned kv = st[(size_t)n * 8192]; const f32x2 dc = dec[n * 64];
            st[(size_t)n * 8192] = cvt_pk_bf16(s0, s1);
            s0 = dc.x * s0 + bflo(kv); s1 = dc.y * s1 + bfhi(kv); }
    }
}

__device__ __forceinline__ void gla_out_unit(const Args& a, int l, LAS unsigned char* lds, int unit) {
    const int h = unit & 3, n = (unit >> 2) & 127, b = unit >> 9, m0 = b * SEQ + n * 64;
    const int tid = otid(), lane = tid & 63, wave = tid >> 6, fr = lane & 15, fq = lane >> 4;
    const bf16_t* proj = (const bf16_t*)(a.ws + WS_PROJ);
    float c[16], bend; gla_bcum(a, l, lds, m0, h, c, bend);
    const int d = tid & 127, g = tid >> 7, col = h * 128 + d;
    LAS unsigned char* qd = lds + 8192;
    LAS unsigned char* ki = qd + 64 * 272;
    LAS unsigned char* vT = ki + 64 * 272;
    LAS unsigned char* at = vT + 128 * 144;
    LAS float* ssq = (LAS float*)(at + 64 * 144);
    unsigned vw[8];
#pragma unroll
    for (int i = 0; i < 16; i += 2) { const size_t r0 = (size_t)(m0 + g * 16 + i) * NP, r1 = r0 + NP;
        const float e0 = __expf(c[i]), e1 = __expf(c[i + 1]);
        const float q0 = bf2f(proj[r0 + C_GQ + col]) * e0, q1 = bf2f(proj[r1 + C_GQ + col]) * e1;
        const float k0 = bf2f(proj[r0 + C_GK + col]) * 0.08838834764831845f / e0, k1 = bf2f(proj[r1 + C_GK + col]) * 0.08838834764831845f / e1;
        *(LAS bf16_t*)(qd + (g * 16 + i) * 272 + d * 2) = (bf16_t)(cvt_pk_bf16(q0, 0.f) & 0xffffu); *(LAS bf16_t*)(qd + (g * 16 + i + 1) * 272 + d * 2) = (bf16_t)(cvt_pk_bf16(q1, 0.f) & 0xffffu);
        *(LAS bf16_t*)(ki + (g * 16 + i) * 272 + d * 2) = (bf16_t)(cvt_pk_bf16(k0, 0.f) & 0xffffu); *(LAS bf16_t*)(ki + (g * 16 + i + 1) * 272 + d * 2) = (bf16_t)(cvt_pk_bf16(k1, 0.f) & 0xffffu);
        vw[i >> 1] = (unsigned)proj[r0 + C_GV + col] | ((unsigned)proj[r1 + C_GV + col] << 16); }
    *(LAS u32x4*)(vT + d * 144 + g * 32) = (u32x4){vw[0], vw[1], vw[2], vw[3]}; *(LAS u32x4*)(vT + d * 144 + g * 32 + 16) = (u32x4){vw[4], vw[5], vw[6], vw[7]};
    __syncthreads();
    { const int tt = wave >> 1;
      bf16x8 qf[4];
#pragma unroll
      for (int kk = 0; kk < 4; ++kk) qf[kk] = *(const LAS bf16x8*)(qd + (tt * 16 + fr) * 272 + kk * 64 + fq * 16);
#pragma unroll
      for (int s2 = 0; s2 < 2; ++s2) { const int stl = (wave & 1) * 2 + s2; f32x4 acc = {0.f, 0.f, 0.f, 0.f};
#pragma unroll
          for (int kk = 0; kk < 4; ++kk) { const bf16x8 kf = *(const LAS bf16x8*)(ki + (stl * 16 + fr) * 272 + kk * 64 + fq * 16); acc = mfma16(kf, qf[kk], acc); }
          const int t = tt * 16 + fr, s0 = stl * 16 + 4 * fq;
#pragma unroll
          for (int jj = 0; jj < 4; ++jj) if (s0 + jj > t) acc[jj] = 0.f;
          u32x2 w; w.x = cvt_pk_bf16(acc[0], acc[1]); w.y = cvt_pk_bf16(acc[2], acc[3]);
          *(LAS u32x2*)(at + t * 144 + s0 * 2) = w; } }
    __syncthreads();
    const int tt = wave & 3, dvh = wave >> 2, bh = b * 4 + h;
    const bf16_t* ST = (const bf16_t*)(a.ws + WS_ST) + ((size_t)bh * 128 + n) * 16384;
    bf16x8 atf[2], qf[4];
#pragma unroll
    for (int kk = 0; kk < 2; ++kk) atf[kk] = *(const LAS bf16x8*)(at + (tt * 16 + fr) * 144 + kk * 64 + fq * 16);
#pragma unroll
    for (int kk = 0; kk < 4; ++kk) qf[kk] = *(const LAS bf16x8*)(qd + (tt * 16 + fr) * 272 + kk * 64 + fq * 16);
    f32x4 o[4]; float sq = 0.f;
#pragma unroll
    for (int j = 0; j < 4; ++j) { const int dvt = dvh * 4 + j; f32x4 acc = {0.f, 0.f, 0.f, 0.f};
#pragma unroll
        for (int kk = 0; kk < 2; ++kk) { const bf16x8 vf = *(const LAS bf16x8*)(vT + (dvt * 16 + fr) * 144 + kk * 64 + fq * 16); acc = mfma16(vf, atf[kk], acc); }
        f32x4 acs = {0.f, 0.f, 0.f, 0.f};
#pragma unroll
        for (int kk = 0; kk < 4; ++kk) { const bf16x8 sf = *(const bf16x8*)(ST + (size_t)(dvt * 16 + fr) * 128 + kk * 32 + fq * 8); acs = mfma16(sf, qf[kk], acs); }
        acc += acs * 0.08838834764831845f;
        o[j] = acc; sq += acc[0] * acc[0] + acc[1] * acc[1] + acc[2] * acc[2] + acc[3] * acc[3]; }
    sq += __shfl_xor(sq, 16); sq += __shfl_xor(sq, 32);
    if (fq == 0) ssq[dvh * 64 + tt * 16 + fr] = sq;
    __syncthreads();
    const float rs = 1.f / sqrtf((ssq[tt * 16 + fr] + ssq[64 + tt * 16 + fr]) * (1.f / 128.f) + RMS_EPS);
    const int m = m0 + tt * 16 + fr;
    bf16_t* br0 = (bf16_t*)(a.ws + WS_BR);
#pragma unroll
    for (int j = 0; j < 4; ++j) { const int dv = (dvh * 4 + j) * 16 + 4 * fq;
        const f32x4 nw = *(const f32x4*)(a.gla_norm_w + (size_t)l * 128 + dv);
        const u32x2 gw = *(const u32x2*)(proj + (size_t)m * NP + C_GG + h * 128 + dv);
        const float gg[4] = {bflo(gw.x), bfhi(gw.x), bflo(gw.y), bfhi(gw.y)}; float r[4];
#pragma unroll
        for (int e = 0; e < 4; ++e) r[e] = o[j][e] * rs * nw[e] * (gg[e] / (1.f + __expf(-gg[e])));
        u32x2 w; w.x = cvt_pk_bf16(r[0], r[1]); w.y = cvt_pk_bf16(r[2], r[3]);
        *(u32x2*)(br0 + (size_t)m * 512 + h * 128 + dv) = w; }
    __syncthreads();
}

__device__ __forceinline__ float gelu_erf(float v) { return 0.5f * v * (1.f + erff(v * 0.70710678118654752f)); }
__device__ __forceinline__ void gmlp_unit(const Args& a, int l, LAS unsigned char* lds, int unit) {
    const int g = unit & 3, nc = (unit >> 2) & 63, b = unit >> 8, m0 = b * SEQ + nc * 128;
    const int tid = otid(), lane = tid & 63, wave = tid >> 6, fr = lane & 15, fq = lane >> 4;
    const bf16_t* proj = (const bf16_t*)(a.ws + WS_PROJ);
    LAS float* stats = (LAS float*)lds;
    LAS unsigned char* vnT = lds + 1024;
    LAS unsigned char* wm = vnT + 128 * 272;
    { const int tok = tid >> 2, part = tid & 3; const bf16_t* vp = proj + (size_t)(m0 + tok) * NP + C_GZV + part * 128;
      float s = 0.f, s2 = 0.f;
#pragma unroll 4
      for (int j = 0; j < 16; ++j) { const u32x4 w = *(const u32x4*)(vp + j * 8); const unsigned ww[4] = {w.x, w.y, w.z, w.w};
#pragma unroll
          for (int e = 0; e < 4; ++e) { const float g0 = gelu_erf(bflo(ww[e])), g1 = gelu_erf(bfhi(ww[e])); s += g0 + g1; s2 += g0 * g0 + g1 * g1; } }
      s += __shfl_xor(s, 1); s += __shfl_xor(s, 2); s2 += __shfl_xor(s2, 1); s2 += __shfl_xor(s2, 2);
      const float mean = s * (1.f / 512.f), var = fmaxf(s2 * (1.f / 512.f) - mean * mean, 0.f);
      if (part == 0) { stats[tok * 2] = mean; stats[tok * 2 + 1] = 1.f / sqrtf(var + LN_EPS); } }
    { const int t = tid >> 2, sq4 = (tid & 3) * 32; const float* wp = a.gmlp_w_s + (((size_t)l * 4 + g) * 128 + t) * 128 + sq4;
#pragma unroll
      for (int j = 0; j < 4; ++j) { const f32x4 w0 = *(const f32x4*)(wp + j * 8), w1 = *(const f32x4*)(wp + j * 8 + 4); float v[8] = {w0[0], w0[1], w0[2], w0[3], w1[0], w1[1], w1[2], w1[3]};
#pragma unroll
          for (int e = 0; e < 8; ++e) if (sq4 + j * 8 + e > t) v[e] = 0.f;
          *(LAS u32x4*)(wm + t * 272 + (sq4 + j * 8) * 2) = (u32x4){cvt_pk_bf16(v[0], v[1]), cvt_pk_bf16(v[2], v[3]), cvt_pk_bf16(v[4], v[5]), cvt_pk_bf16(v[6], v[7])}; } }
    __syncthreads();
    { const int cch = tid & 127, sg = tid >> 7; const float lg = a.gmlp_ln_g[(size_t)l * 512 + g * 128 + cch], lb = a.gmlp_ln_b[(size_t)l * 512 + g * 128 + cch];
#pragma unroll
      for (int j = 0; j < 4; ++j) { unsigned w[4];
#pragma unroll
          for (int e = 0; e < 4; ++e) { const int s0 = sg * 32 + j * 8 + e * 2;
              const float v0 = gelu_erf(bf2f(proj[(size_t)(m0 + s0) * NP + C_GZV + g * 128 + cch])), v1 = gelu_erf(bf2f(proj[(size_t)(m0 + s0 + 1) * NP + C_GZV + g * 128 + cch]));
              w[e] = cvt_pk_bf16((v0 - stats[s0 * 2]) * stats[s0 * 2 + 1] * lg + lb, (v1 - stats[s0 * 2 + 2]) * stats[s0 * 2 + 3] * lg + lb); }
          *(LAS u32x4*)(vnT + cch * 272 + (sg * 32 + j * 8) * 2) = (u32x4){w[0], w[1], w[2], w[3]}; } }
    __syncthreads();
    const int nk = ((wave * 16 + 15) >> 5) + 1;
    bf16x8 wf[4];
#pragma unroll
    for (int kk = 0; kk < 4; ++kk) wf[kk] = *(const LAS bf16x8*)(wm + (wave * 16 + fr) * 272 + kk * 64 + fq * 16);
    const int t = wave * 16 + fr, m = m0 + t;
    const float bs = a.gmlp_b_s[((size_t)l * 4 + g) * 128 + t];
    bf16_t* br1 = (bf16_t*)(a.ws + WS_BR) + (size_t)M * 512;
#pragma unroll
    for (int ct = 0; ct < 8; ++ct) { f32x4 acc = {0.f, 0.f, 0.f, 0.f};
#pragma unroll
        for (int kk = 0; kk < 4; ++kk) if (kk < nk) { const bf16x8 vf = *(const LAS bf16x8*)(vnT + (ct * 16 + fr) * 272 + kk * 64 + fq * 16); acc = mfma16(vf, wf[kk], acc); }
        const int cc = g * 128 + ct * 16 + 4 * fq;
        const u32x2 uw = *(const u32x2*)(proj + (size_t)m * NP + C_GZU + cc);
        const float u0 = gelu_erf(bflo(uw.x)), u1 = gelu_erf(bfhi(uw.x)), u2 = gelu_erf(bflo(uw.y)), u3 = gelu_erf(bfhi(uw.y));
        u32x2 w; w.x = cvt_pk_bf16(u0 * (acc[0] + bs), u1 * (acc[1] + bs)); w.y = cvt_pk_bf16(u2 * (acc[2] + bs), u3 * (acc[3] + bs));
        *(u32x2*)(br1 + (size_t)m * 512 + cc) = w; }
    __syncthreads();
}

__device__ __forceinline__ void moba_prep_unit(const Args& a, LAS unsigned char* lds, int unit) {
    const int blk = unit & 31, h = (unit >> 5) & 3, b = unit >> 7, m0 = b * SEQ + blk * 256;
    const int tid = otid();
    bf16_t* proj = (bf16_t*)(a.ws + WS_PROJ);
#pragma unroll 2
    for (int it = 0; it < 8; ++it) { const int item = tid + it * NTHREADS, tok = item >> 4, i = item & 15; const size_t m = (size_t)(m0 + tok);
        const float inv = exp2f(-(float)i * (18.931568569324174f / 16.f));
        const float ang = (float)a.pos[m] * inv; float sn, cs; sincosf(ang, &sn, &cs);
        bf16_t* kp = proj + m * NP + C_MK + h * 128 + i; bf16_t* qp = proj + m * NP + C_MQ + h * 128 + i;
        const float k1 = bf2f(kp[0]), k2 = bf2f(kp[16]), q1 = bf2f(qp[0]), q2 = bf2f(qp[16]);
        const unsigned kw = cvt_pk_bf16(k1 * cs - k2 * sn, k2 * cs + k1 * sn), qw = cvt_pk_bf16(q1 * cs - q2 * sn, q2 * cs + q1 * sn);
        kp[0] = (bf16_t)(kw & 0xffffu); kp[16] = (bf16_t)(kw >> 16); qp[0] = (bf16_t)(qw & 0xffffu); qp[16] = (bf16_t)(qw >> 16); }
    __threadfence_block();
    __syncthreads();
    { const int d = tid & 127, kg = tid >> 7; LAS float* red = (LAS float*)lds; float s = 0.f;
#pragma unroll 8
      for (int j = 0; j < 64; ++j) s += bf2f(proj[(size_t)(m0 + kg * 64 + j) * NP + C_MK + h * 128 + d]);
      red[kg * 128 + d] = s;
      __syncthreads();
      if (kg == 0) ((float*)(a.ws + WS_KMEAN))[((size_t)(b * 4 + h) * 32 + blk) * 128 + d] = (red[d] + red[128 + d] + red[256 + d] + red[384 + d]) * (1.f / 256.f);
      __syncthreads(); }
    { LAS unsigned char* tT = lds + 4096;
#pragma unroll 2
      for (int it = 0; it < 8; ++it) { const int p = tid + it * NTHREADS, key = p >> 4, pc = p & 15;
          const u32x4 w = *(const u32x4*)(proj + (size_t)(m0 + key) * NP + C_MV + h * 128 + pc * 8); const unsigned ww[4] = {w.x, w.y, w.z, w.w};
#pragma unroll
          for (int e = 0; e < 4; ++e) { *(LAS bf16_t*)(tT + (pc * 8 + 2 * e) * 528 + key * 2) = (bf16_t)(ww[e] & 0xffffu); *(LAS bf16_t*)(tT + (pc * 8 + 2 * e + 1) * 528 + key * 2) = (bf16_t)(ww[e] >> 16); } }
      __syncthreads();
      bf16_t* VT = (bf16_t*)(a.ws + WS_VT) + (size_t)(b * 4 + h) * 128 * SEQ + blk * 256;
#pragma unroll 2
      for (int it = 0; it < 8; ++it) { const int p = tid + it * NTHREADS, dv = p >> 5, pc = p & 31;
          *(u32x4*)(VT + (size_t)dv * SEQ + pc * 8) = *(const LAS u32x4*)(tT + dv * 528 + pc * 16); }
      __syncthreads(); }
}

__device__ __forceinline__ void moba_attn_unit(const Args& a, LAS unsigned char* lds, int b, int h, int qt) {
    const int tid = otid(), lane = tid & 63, wave = tid >> 6, fr = lane & 15, fq = lane >> 4;
    const int q0 = qt * 128, own = q0 >> 8, bs = own * 256, m0 = b * SEQ + q0, bh = b * 4 + h;
    const bf16_t* proj = (const bf16_t*)(a.ws + WS_PROJ);
    LAS float* km = (LAS float*)lds;
    LAS float* sc = (LAS float*)(lds + 16384);
    LAS unsigned* rmask = (LAS unsigned*)(lds + 33280);
    LAS int* tlist = (LAS int*)(lds + 33792);
    LAS unsigned char* Ks = lds + 34816;
    LAS unsigned char* Vs = lds + 34816 + 64 * 272;
    const float* kmg = (const float*)(a.ws + WS_KMEAN) + (size_t)bh * 32 * 128;
    for (int e = tid; e < own * 128; e += NTHREADS) km[e] = kmg[e];
    __syncthreads();
    if (own > 3) {
        const int row = tid >> 2, part = tid & 3; const bf16_t* qp = proj + (size_t)(m0 + row) * NP + C_MQ + h * 128;
        float s8[8];
#pragma unroll
        for (int jj = 0; jj < 8; ++jj) s8[jj] = 0.f;
#pragma unroll 2
        for (int dc = 0; dc < 16; ++dc) { const u32x4 w = *(const u32x4*)(qp + dc * 8); const float qv[8] = {bflo(w.x), bfhi(w.x), bflo(w.y), bfhi(w.y), bflo(w.z), bfhi(w.z), bflo(w.w), bfhi(w.w)};
#pragma unroll
            for (int jj = 0; jj < 8; ++jj) { const int j = part + 4 * jj; if (j < own) {
#pragma unroll
                for (int e = 0; e < 8; ++e) s8[jj] += qv[e] * km[j * 128 + dc * 8 + e]; } } }
#pragma unroll
        for (int jj = 0; jj < 8; ++jj) { const int j = part + 4 * jj; if (j < own) sc[row * 33 + j] = s8[jj]; }
    }
    __syncthreads();
    if (tid < 128) { unsigned mk;
        if (own <= 3) mk = (1u << own) - 1u;
        else { float b0 = -INFINITY, b1 = -INFINITY, b2 = -INFINITY; int i0 = 0, i1 = 0, i2 = 0;
            for (int j = 0; j < own; ++j) { const float v = sc[tid * 33 + j];
                if (v > b0) { b2 = b1; i2 = i1; b1 = b0; i1 = i0; b0 = v; i0 = j; } else if (v > b1) { b2 = b1; i2 = i1; b1 = v; i1 = j; } else if (v > b2) { b2 = v; i2 = j; } }
            mk = (1u << i0) | (1u << i1) | (1u << i2); }
        rmask[tid] = mk; }
    __syncthreads();
    unsigned bun = rmask[lane] | rmask[lane + 64];
#pragma unroll
    for (int o = 1; o < 64; o <<= 1) bun |= __shfl_xor(bun, o);
    bun = __builtin_amdgcn_readfirstlane(bun);
    const int r = wave * 16 + fr; const unsigned mymask = rmask[r];
    unsigned wmask = mymask;
#pragma unroll
    for (int o = 1; o < 16; o <<= 1) wmask |= __shfl_xor(wmask, o);
    wmask = __builtin_amdgcn_readfirstlane(wmask);
    const int n_own = ((q0 - bs) >> 6) + 2, ntiles = n_own + 4 * __builtin_popcount(bun);
    if (tid == 0) { int k = 0; for (int i = 0; i < n_own; ++i) tlist[k++] = bs + i * 64;
        for (int j = 0; j < own; ++j) if ((bun >> j) & 1u) { for (int i = 0; i < 4; ++i) tlist[k++] = j * 256 + i * 64; } }
    bf16x8 qf[4];
#pragma unroll
    for (int kk = 0; kk < 4; ++kk) qf[kk] = *(const bf16x8*)(proj + (size_t)(m0 + r) * NP + C_MQ + h * 128 + kk * 32 + fq * 8);
    const int qpos = q0 + r;
    f32x4 o[8];
#pragma unroll
    for (int j = 0; j < 8; ++j) o[j] = (f32x4){0.f, 0.f, 0.f, 0.f};
    float mrun = -INFINITY, lrun = 0.f;
    const bf16_t* kbase = proj + (size_t)(b * SEQ) * NP + C_MK + h * 128;
    const bf16_t* vbase = (const bf16_t*)(a.ws + WS_VT) + (size_t)bh * 128 * SEQ;
    __syncthreads();
    u32x4 kreg[2], vreg[2];
    { const int kp0 = tlist[0];
#pragma unroll
      for (int i = 0; i < 2; ++i) { const int p = tid + i * NTHREADS; kreg[i] = *(const u32x4*)(kbase + (size_t)(kp0 + (p >> 4)) * NP + (p & 15) * 8); vreg[i] = *(const u32x4*)(vbase + (size_t)(p >> 3) * SEQ + kp0 + (p & 7) * 8); } }
    const float SC = 0.08838834764831845f * 1.4426950408889634f;
    for (int it = 0; it < ntiles; ++it) {
        const int kp0 = tlist[it];
        __syncthreads();
#pragma unroll
        for (int i = 0; i < 2; ++i) { const int p = tid + i * NTHREADS; *(LAS u32x4*)(Ks + (p >> 4) * 272 + (p & 15) * 16) = kreg[i]; *(LAS u32x4*)(Vs + (p >> 3) * 144 + (p & 7) * 16) = vreg[i]; }
        __syncthreads();
        if (it + 1 < ntiles) { const int kn = tlist[it + 1];
#pragma unroll
            for (int i = 0; i < 2; ++i) { const int p = tid + i * NTHREADS; kreg[i] = *(const u32x4*)(kbase + (size_t)(kn + (p >> 4)) * NP + (p & 15) * 8); vreg[i] = *(const u32x4*)(vbase + (size_t)(p >> 3) * SEQ + kn + (p & 7) * 8); } }
        const int kblk = kp0 >> 8; const bool isown = (kblk == own);
        const bool active = isown ? (kp0 <= q0 + wave * 16 + 15) : (((wmask >> kblk) & 1u) != 0u);
        if (active) {
            f32x4 st[4];
#pragma unroll
            for (int kt = 0; kt < 4; ++kt) { f32x4 acc = {0.f, 0.f, 0.f, 0.f};
#pragma unroll
                for (int kk = 0; kk < 4; ++kk) { const bf16x8 kf = *(const LAS bf16x8*)(Ks + (kt * 16 + fr) * 272 + kk * 64 + fq * 16); acc = mfma16(kf, qf[kk], acc); }
                st[kt] = acc * SC; }
            if (isown) {
#pragma unroll
                for (int kt = 0; kt < 4; ++kt)
#pragma unroll
                    for (int jj = 0; jj < 4; ++jj) if (kp0 + kt * 16 + 4 * fq + jj > qpos) st[kt][jj] = -INFINITY;
            } else if (!((mymask >> kblk) & 1u)) {
#pragma unroll
                for (int kt = 0; kt < 4; ++kt) st[kt] = (f32x4){-INFINITY, -INFINITY, -INFINITY, -INFINITY};
            }
            float mx = -INFINITY;
#pragma unroll
            for (int kt = 0; kt < 4; ++kt) mx = fmaxf(mx, fmaxf(fmaxf(st[kt][0], st[kt][1]), fmaxf(st[kt][2], st[kt][3])));
            mx = fmaxf(mx, __shfl_xor(mx, 16)); mx = fmaxf(mx, __shfl_xor(mx, 32));
            const float mnew = fmaxf(mrun, mx);
            const float msafe = (mnew == -INFINITY) ? 0.f : mnew;
            const float alpha = exp2f(mrun - msafe);
            float ls = 0.f;
#pragma unroll
            for (int kt = 0; kt < 4; ++kt)
#pragma unroll
                for (int jj = 0; jj < 4; ++jj) { const float p = exp2f(st[kt][jj] - msafe); st[kt][jj] = p; ls += p; }
            ls += __shfl_xor(ls, 16); ls += __shfl_xor(ls, 32);
            lrun = lrun * alpha + ls; mrun = mnew;
            bf16x8 pf[2];
#pragma unroll
            for (int k2 = 0; k2 < 2; ++k2) { const u32x4 w = {cvt_pk_bf16(st[2 * k2][0], st[2 * k2][1]), cvt_pk_bf16(st[2 * k2][2], st[2 * k2][3]), cvt_pk_bf16(st[2 * k2 + 1][0], st[2 * k2 + 1][1]), cvt_pk_bf16(st[2 * k2 + 1][2], st[2 * k2 + 1][3])};
                pf[k2] = __builtin_bit_cast(bf16x8, w); }
#pragma unroll
            for (int dvt = 0; dvt < 8; ++dvt) { f32x4 acc = o[dvt] * alpha;
#pragma unroll
                for (int k2 = 0; k2 < 2; ++k2) { const u32x2 v0 = *(const LAS u32x2*)(Vs + (dvt * 16 + fr) * 144 + (32 * k2 + 4 * fq) * 2), v1 = *(const LAS u32x2*)(Vs + (dvt * 16 + fr) * 144 + (32 * k2 + 16 + 4 * fq) * 2);
                    const u32x4 vw = {v0.x, v0.y, v1.x, v1.y};
                    acc = mfma16(__builtin_bit_cast(bf16x8, vw), pf[k2], acc); }
                o[dvt] = acc; }
        }
    }
    const float il = 1.f / lrun;
    bf16_t* br2 = (bf16_t*)(a.ws + WS_BR) + (size_t)2 * M * 512;
#pragma unroll
    for (int dvt = 0; dvt < 8; ++dvt) { u32x2 w; w.x = cvt_pk_bf16(o[dvt][0] * il, o[dvt][1] * il); w.y = cvt_pk_bf16(o[dvt][2] * il, o[dvt][3] * il);
        *(u32x2*)(br2 + (size_t)(m0 + r) * 512 + h * 128 + dvt * 16 + 4 * fq) = w; }
    __syncthreads();
}

__device__ __forceinline__ void phase_ln(const Args& a, const float* gam, const float* bet, int G) {
    const int tid = otid(), lane = tid & 63, wave = tid >> 6;
    bf16_t* xbf = (bf16_t*)(a.ws + WS_XBF);
    f32x4 gv[4], bv[4];
#pragma unroll
    for (int j = 0; j < 4; ++j) { gv[j] = *(const f32x4*)(gam + 4 * lane + 256 * j); bv[j] = *(const f32x4*)(bet + 4 * lane + 256 * j); }
    for (int m = blockIdx.x * NWAVES + wave; m < M; m += G * NWAVES) {
        f32x4* xr = (f32x4*)(a.out + (size_t)m * D) + lane;
        f32x4 v[4]; float s = 0.f;
#pragma unroll
        for (int j = 0; j < 4; ++j) { v[j] = xr[64 * j]; s += (v[j][0] + v[j][1]) + (v[j][2] + v[j][3]); }
        const float mean = wave_sum(s) * (1.f / D); float s2 = 0.f;
#pragma unroll
        for (int j = 0; j < 4; ++j) { v[j] = v[j] - mean; s2 += (v[j][0] * v[j][0] + v[j][1] * v[j][1]) + (v[j][2] * v[j][2] + v[j][3] * v[j][3]); }
        const float rstd = 1.f / sqrtf(wave_sum(s2) * (1.f / D) + LN_EPS);
        u32x2* o8 = (u32x2*)(xbf + (size_t)m * D) + lane;
#pragma unroll
        for (int j = 0; j < 4; ++j) { const f32x4 y = v[j] * rstd * gv[j] + bv[j]; xr[64 * j] = y; o8[64 * j] = (u32x2){cvt_pk_bf16(y[0], y[1]), cvt_pk_bf16(y[2], y[3])}; }
    }
}

__global__ void __launch_bounds__(NTHREADS, 2) fwd_mega(Args a) {
    extern __shared__ __attribute__((aligned(16))) unsigned char lds_raw[];
    LAS unsigned char* lds = (LAS unsigned char*)lds_raw;
    cg::grid_group grid = cg::this_grid();
    const int G = gridDim.x, bid = blockIdx.x;
    const float ALPHA = 1.6817928305074290f;
    bf16_t* xbf = (bf16_t*)(a.ws + WS_XBF); bf16_t* proj = (bf16_t*)(a.ws + WS_PROJ);
    for (int ph = a.ph_lo; ph < a.ph_hi; ++ph) {
        const int l = ph / PH_PER_LAYER, k = ph % PH_PER_LAYER;
        switch (k) {
        case 0: phase_prep(a, l, lds, G); break;
        case 1: { pg8::Gemm g{xbf, (const bf16_t*)(a.ws + WS_WIN), M, NP, D, D}; pg8::StaticOrder S; S.init(M, NP, G, bid);
                  pg8::EpiStore<0> E{proj, NP}; pg8::gemm_phase(lds, g, S, E); } break;
        case 2: {
                  for (int u = bid; u < 1792; u += G) { if (u < 256) moba_prep_unit(a, lds, u); else if (u < 768) gmlp_unit(a, l, lds, u - 256); else gla_kv_unit(a, l, lds, u - 768); } } break;
        case 3: { gla_scan(a, G);
                  for (int i = 0;; ++i) { const int u = i * G + bid; if (u >= 512) break;
                      int qt, bh; if (u < 256) { qt = 63 - (u >> 3); bh = u & 7; } else { qt = (u - 256) >> 3; bh = u & 7; }
                      moba_attn_unit(a, lds, bh >> 2, bh & 3, qt); } } break;
        case 4: { for (int u = bid; u < 1024; u += G) gla_out_unit(a, l, lds, u); } break;
        case 5: { pg8::Gemm g{(const bf16_t*)(a.ws + WS_BR), (const bf16_t*)(a.ws + WS_WBR), 3 * M, 3 * D, 512, 512}; pg8::MergeOrder S{G, bid};
                  pg8::EpiMerge E{proj, (float*)(a.ws + WS_PROJ), (bf16_t*)(a.ws + WS_MERGED)}; pg8::gemm_phase(lds, g, S, E); } break;
        case 6: { pg8::Gemm g{(const bf16_t*)(a.ws + WS_MERGED), (const bf16_t*)(a.ws + WS_WOUT), M, D, D, D}; pg8::StaticOrder S; S.init(M, D, G, bid);
                  pg8::EpiResid E{l == 0 ? a.x : a.out, a.out, ALPHA}; pg8::gemm_phase(lds, g, S, E); } break;
        case 7: phase_ln(a, a.ln1_g + (size_t)l * D, a.ln1_b + (size_t)l * D, G); break;
        case 8: { pg8::Gemm g{xbf, (const bf16_t*)(a.ws + WS_W1), M, FF, D, D}; pg8::StaticOrder S; S.init(M, FF, G, bid);
                  pg8::EpiStore<2> E{proj, FF}; pg8::gemm_phase(lds, g, S, E); } break;
        case 9: { pg8::Gemm g{proj, (const bf16_t*)(a.ws + WS_W2), M, D, FF, FF}; pg8::StaticOrder S; S.init(M, D, G, bid);
                  pg8::EpiResid E{a.out, a.out, ALPHA}; pg8::gemm_phase(lds, g, S, E); } break;
        default: phase_ln(a, a.ln2_g + (size_t)l * D, a.ln2_b + (size_t)l * D, G); break;
        }
        if (ph + 1 < a.ph_hi) grid.sync();
    }
}

#ifndef MK_PER_PHASE
#define MK_PER_PHASE 0
#endif
extern "C" void kernel_launch(void* const* d_in, const int* in_sizes, int n_in, void* d_out, int out_size, void* d_ws, size_t ws_size, hipStream_t stream) {
    static int grid = 0;
    if (grid == 0) {
        if (n_in != 18 || out_size != M * D || ws_size < WS_END) { fprintf(stderr, "kernel_launch: unexpected problem (n_in %d out %d ws %zu)\n", n_in, out_size, ws_size); grid = -1; return; }
        int dev = 0, cus = 0, per_cu = 0;
        if (hipGetDevice(&dev) != hipSuccess || hipDeviceGetAttribute(&cus, hipDeviceAttributeMultiprocessorCount, dev) != hipSuccess) { grid = -1; return; }
        if (hipFuncSetAttribute((const void*)fwd_mega, hipFuncAttributeMaxDynamicSharedMemorySize, LDS_BYTES) != hipSuccess) { fprintf(stderr, "kernel_launch: hipFuncSetAttribute failed\n"); grid = -1; return; }
        if (hipOccupancyMaxActiveBlocksPerMultiprocessor(&per_cu, (const void*)fwd_mega, NTHREADS, LDS_BYTES) != hipSuccess || per_cu < 1) { fprintf(stderr, "kernel_launch: occupancy query says %d\n", per_cu); per_cu = 1; }
        (void)hipGetLastError();
        grid = cus;
    }
    if (grid < 0) return;
    Args a{};
    a.x = (const float*)d_in[0]; a.pos = (const int*)d_in[1]; a.w_in = (const float*)d_in[2]; a.w_gate_up = (const float*)d_in[3]; a.b_gate = (const float*)d_in[4];
    a.gla_norm_w = (const float*)d_in[5]; a.gmlp_ln_g = (const float*)d_in[6]; a.gmlp_ln_b = (const float*)d_in[7]; a.gmlp_w_s = (const float*)d_in[8]; a.gmlp_b_s = (const float*)d_in[9];
    a.w_branch = (const float*)d_in[10]; a.w_out = (const float*)d_in[11]; a.ln1_g = (const float*)d_in[12]; a.ln1_b = (const float*)d_in[13]; a.w_ff1 = (const float*)d_in[14];
    a.w_ff2 = (const float*)d_in[15]; a.ln2_g = (const float*)d_in[16]; a.ln2_b = (const float*)d_in[17]; a.out = (float*)d_out; a.ws = (unsigned char*)d_ws;
#if MK_PER_PHASE
    for (int ph = 0; ph < N_PHASES; ++ph) { a.ph_lo = ph; a.ph_hi = ph + 1; hipLaunchKernelGGL(fwd_mega, dim3(grid), dim3(NTHREADS), LDS_BYTES, stream, a); }
#else
    a.ph_lo = 0; a.ph_hi = N_PHASES;
    void* args[] = {&a};
    hipError_t e = hipLaunchCooperativeKernel((const void*)fwd_mega, dim3(grid), dim3(NTHREADS), args, LDS_BYTES, stream);
    if (e != hipSuccess) fprintf(stderr, "kernel_launch: cooperative launch failed: %s (grid %d)\n", hipGetErrorString(e), grid);
#endif
}
```

```cpp
#include <hip/hip_runtime.h>
#include <hip/hip_cooperative_groups.h>
#include <cstdio>
#include <cstdint>
namespace cg = cooperative_groups;

#define LAS __attribute__((address_space(3)))
typedef unsigned short bf16_t;
typedef short bf16x8 __attribute__((ext_vector_type(8)));
typedef short s16x4 __attribute__((ext_vector_type(4)));
typedef float f32x4 __attribute__((ext_vector_type(4)));
typedef float f32x2 __attribute__((ext_vector_type(2)));
typedef unsigned u32x4 __attribute__((ext_vector_type(4)));
typedef unsigned u32x2 __attribute__((ext_vector_type(2)));

constexpr int BATCH = 2, SEQ = 8192, M = BATCH * SEQ, D = 1024, DEPTH = 4, FF = 4096;
constexpr int IN_COLS = 7696, NP = 7936, C_LR = 7680;
constexpr int C_GQ = 0, C_GK = 512, C_GV = 1024, C_GG = 1536, C_GZU = 2048, C_GZV = 2560, C_MQ = 3072, C_MK = 3584, C_MV = 4096, C_GL = 4608;
constexpr int NWAVES = 8, NTHREADS = 512;
constexpr int LDS_BYTES = 147456;
constexpr float LN_EPS = 1e-5f, RMS_EPS = 1e-6f;
constexpr int PH_PER_LAYER = 11, N_PHASES = DEPTH * PH_PER_LAYER;

constexpr size_t MiB = 1u << 20;
constexpr size_t WS_WIN = 0, WS_GLR = 15 * MiB, WS_WBR = 16 * MiB, WS_WOUT = 19 * MiB, WS_W1 = 21 * MiB, WS_W2 = 29 * MiB;
constexpr size_t WS_XBF = 38 * MiB;
constexpr size_t WS_BR = 70 * MiB;
constexpr size_t WS_ST = 118 * MiB;
constexpr size_t WS_DEC = 150 * MiB;
constexpr size_t WS_KMEAN = WS_DEC + 512 * 1024;
constexpr size_t WS_VT = 151 * MiB;
constexpr size_t WS_MERGED = 167 * MiB;
constexpr size_t WS_PROJ = 200 * MiB;
constexpr size_t WS_END = 448 * MiB;

typedef __bf16 bf16x2_t __attribute__((ext_vector_type(2)));
__device__ __forceinline__ unsigned cvt_pk_bf16(float lo, float hi) { const f32x2 v = {lo, hi}; const bf16x2_t b = __builtin_convertvector(v, bf16x2_t); return __builtin_bit_cast(unsigned, b); }
__device__ __forceinline__ float bf2f(unsigned h) { return __builtin_bit_cast(float, h << 16); }
__device__ __forceinline__ float bflo(unsigned w) { return __builtin_bit_cast(float, w << 16); }
__device__ __forceinline__ float bfhi(unsigned w) { return __builtin_bit_cast(float, w & 0xffff0000u); }
__device__ __forceinline__ int otid() { int t = threadIdx.x; asm volatile("" : "+v"(t)); return t; }
__device__ __forceinline__ f32x4 mfma16(bf16x8 a, bf16x8 b, f32x4 c) { return __builtin_amdgcn_mfma_f32_16x16x32_bf16(a, b, c, 0, 0, 0); }

namespace pg8 {
constexpr int BM = 256, BK = 64, HALF = 128, HTB = HALF * BK * 2, NXCD = 8, WGM = 8;
__host__ __device__ __forceinline__ int lds_byte(int r, int c) { const int st = (r >> 4) * 2 + (c >> 5), rr = r & 15, cc = c & 31, ob = rr * 64 + cc * 2; return st * 1024 + (ob ^ (((ob >> 9) & 1) << 5)); }
__host__ __device__ __forceinline__ void stage_rc(int b, int& R, int& C) { const int st = b / 1024, sb = b % 1024, swz = sb ^ (((sb >> 9) & 1) << 5); R = (st >> 1) * 16 + swz / 64; C = (st & 1) * 32 + (swz % 64) / 2; }
__host__ __device__ __forceinline__ int perm32(int rho) { const int n = rho >> 4, i = rho & 15; return 8 * (i >> 2) + 4 * n + (i & 3); }

struct Unit { int pm, pn; };
struct Gemm { const bf16_t* A; const bf16_t* Bt; int M, N, K, lda; };

struct StaticOrder {
    int nM, nN, nwg, G, c;
    __device__ void init(int M_, int N_, int G_, int c_) { nM = M_ / BM; nN = N_ / BM; nwg = nM * nN; G = G_; c = c_; }
    __device__ bool next(int i, Unit& u) const {
        const long L = (long)i * G + c; if (L >= nwg) return false;
        int wgid = (int)L; { const int q = nwg / NXCD, r = nwg % NXCD, xcd = wgid % NXCD, off = wgid / NXCD; wgid = (xcd < r ? xcd * (q + 1) : r * (q + 1) + (xcd - r) * q) + off; }
        const int nig = WGM * nN, gid = wgid / nig, fm = gid * WGM, gsz = (nM - fm) < WGM ? (nM - fm) : WGM;
        u.pm = fm + ((wgid % nig) % gsz); u.pn = (wgid % nig) / gsz; return true;
    }
};
struct MergeOrder {
    int G, c;
    __device__ bool next(int i, Unit& u) const { const int t = (i / 3) * G + c; if (t >= 256) return false; const int br = i % 3; u.pm = br * 64 + (t >> 2); u.pn = br * 4 + (t & 3); return true; }
};

template <int ACT  > struct EpiStore {
    bf16_t* O; int ldc;
    __device__ __forceinline__ void operator()(const f32x4 (&acc)[2][2][4][2], const Unit& u, int wr, int wc, int fr, int fq) const {
        const int row0 = u.pm * BM + wr * 64 + fr, col0 = u.pn * BM + wc * 32 + 8 * fq;
#pragma unroll
        for (int ai = 0; ai < 2; ++ai)
#pragma unroll
            for (int m = 0; m < 4; ++m) { bf16_t* rowp = O + (size_t)(row0 + ai * HALF + m * 16) * ldc + col0;
#pragma unroll
                for (int bj = 0; bj < 2; ++bj) { f32x4 v0 = acc[ai][bj][m][0], v1 = acc[ai][bj][m][1];
                    if (ACT == 2) {
#pragma unroll
                        for (int e = 0; e < 4; ++e) { float a = fmaxf(v0[e], 0.f), b = fmaxf(v1[e], 0.f); v0[e] = a * a; v1[e] = b * b; } }
                    u32x4 w; w.x = cvt_pk_bf16(v0[0], v0[1]); w.y = cvt_pk_bf16(v0[2], v0[3]); w.z = cvt_pk_bf16(v1[0], v1[1]); w.w = cvt_pk_bf16(v1[2], v1[3]);
                    *(u32x4*)(rowp + bj * HALF) = w; } }
    }
};
struct EpiResid {
    const float* R; float* O; float alpha;
    __device__ __forceinline__ void operator()(const f32x4 (&acc)[2][2][4][2], const Unit& u, int wr, int wc, int fr, int fq) const {
        const int row0 = u.pm * BM + wr * 64 + fr, col0 = u.pn * BM + wc * 32 + 8 * fq;
#pragma unroll
        for (int ai = 0; ai < 2; ++ai)
#pragma unroll
            for (int m = 0; m < 4; ++m) { const size_t off = (size_t)(row0 + ai * HALF + m * 16) * 1024 + col0;
#pragma unroll
                for (int bj = 0; bj < 2; ++bj) { const f32x4 r0 = *(const f32x4*)(R + off + bj * HALF), r1 = *(const f32x4*)(R + off + bj * HALF + 4);
                    *(f32x4*)(O + off + bj * HALF) = r0 * alpha + acc[ai][bj][m][0]; *(f32x4*)(O + off + bj * HALF + 4) = r1 * alpha + acc[ai][bj][m][1]; } }
    }
};
struct EpiMerge {
    const bf16_t* proj; float* stash; bf16_t* merged;
    __device__ __forceinline__ void operator()(const f32x4 (&acc)[2][2][4][2], const Unit& u, int wr, int wc, int fr, int fq) const {
        const int br = u.pm >> 6, tm = u.pm & 63, tn = u.pn & 3;
        const int row0 = tm * BM + wr * 64 + fr, col0 = tn * BM + wc * 32 + 8 * fq;
#pragma unroll
        for (int ai = 0; ai < 2; ++ai)
#pragma unroll
            for (int m = 0; m < 4; ++m) { const int row = row0 + ai * HALF + m * 16;
#pragma unroll
                for (int bj = 0; bj < 2; ++bj) { const int col = col0 + bj * HALF;
                    const u32x4 gw = *(const u32x4*)(proj + (size_t)row * NP + C_GL + br * 1024 + col);
                    float g[8] = {bflo(gw.x), bfhi(gw.x), bflo(gw.y), bfhi(gw.y), bflo(gw.z), bfhi(gw.z), bflo(gw.w), bfhi(gw.w)};
                    f32x4 v0, v1;
#pragma unroll
                    for (int e = 0; e < 4; ++e) { v0[e] = acc[ai][bj][m][0][e] / (1.f + __expf(-g[e])); v1[e] = acc[ai][bj][m][1][e] / (1.f + __expf(-g[4 + e])); }
                    float* sp = stash + (size_t)row * (NP / 2) + col;
                    if (br == 0) { *(f32x4*)sp = v0; *(f32x4*)(sp + 4) = v1; }
                    else { v0 += *(const f32x4*)sp; v1 += *(const f32x4*)(sp + 4);
                        if (br == 1) { *(f32x4*)sp = v0; *(f32x4*)(sp + 4) = v1; }
                        else { u32x4 w; w.x = cvt_pk_bf16(v0[0], v0[1]); w.y = cvt_pk_bf16(v0[2], v0[3]); w.z = cvt_pk_bf16(v1[0], v1[1]); w.w = cvt_pk_bf16(v1[2], v1[3]);
                            *(u32x4*)(merged + (size_t)row * 1024 + col) = w; } } } }
    }
};

template <class Epi, class Sched>
__device__ __forceinline__ void gemm_phase(LAS unsigned char* lds, const Gemm g, const Sched& S, const Epi& E) {
    const int tid = otid(), wid = __builtin_amdgcn_readfirstlane(tid >> 6), lane = tid & 63, wr = wid >> 2, wc = wid & 3, fr = lane & 15, fq = lane >> 4;
    const int K = g.K, nt = K / BK, lda = g.lda;
    unsigned voffA[2], voffB[2];
#pragma unroll
    for (int i = 0; i < 2; ++i) { int R, C; stage_rc(tid * 16 + i * 8192, R, C); const int Rb = (R & ~31) + perm32(R & 31);
        voffA[i] = (unsigned)(R * lda + C) * 2u; voffB[i] = (unsigned)(Rb * K + C) * 2u; }
    const size_t kstep = (size_t)(BK * 2);
    const size_t hstepA = (size_t)HALF * lda * 2, hstepB = (size_t)HALF * K * 2;
    const size_t tstepA = 2 * hstepA, tstepB = 2 * hstepB;
    const unsigned ldsw = (unsigned)wid * 1024u;
    const int aoff = lds_byte(wr * 64 + fr, fq * 8), boff = lds_byte(wc * 32 + fr, fq * 8);
#define PG8_SA(b, h) (((b) * 2 + (h)) * HTB)
#define PG8_SB(b, h) ((4 + (b) * 2 + (h)) * HTB)
#define PG8_STAGE(bufoff, gbase, voff) do { _Pragma("unroll") for (int _i = 0; _i < 2; ++_i) \
        __builtin_amdgcn_global_load_lds((const unsigned*)((const char*)(gbase) + (voff)[_i]), (LAS unsigned*)(lds + (bufoff) + ldsw + _i * 8192), 16, 0, 0); } while (0)
#define PG8_LDA(dst, b, h) do { _Pragma("unroll") for (int m = 0; m < 4; ++m) _Pragma("unroll") for (int k = 0; k < 2; ++k) dst[m][k] = *(const LAS bf16x8*)(lds + PG8_SA(b, h) + aoff + m * 2048 + k * 1024); } while (0)
#define PG8_LDB(dst, b, h) do { _Pragma("unroll") for (int n = 0; n < 2; ++n) _Pragma("unroll") for (int k = 0; k < 2; ++k) dst[n][k] = *(const LAS bf16x8*)(lds + PG8_SB(b, h) + boff + n * 2048 + k * 1024); } while (0)
#define PG8_MMA(ai, bj, At, Bt) do { __builtin_amdgcn_s_setprio(1); _Pragma("unroll") for (int m = 0; m < 4; ++m) _Pragma("unroll") for (int n = 0; n < 2; ++n) _Pragma("unroll") for (int k = 0; k < 2; ++k) \
        acc[ai][bj][m][n] = __builtin_amdgcn_mfma_f32_16x16x32_bf16(Bt[n][k], At[m][k], acc[ai][bj][m][n], 0, 0, 0); __builtin_amdgcn_s_setprio(0); } while (0)
#define PG8_WAIT_V(n) asm volatile("s_waitcnt vmcnt(" #n ")" ::: "memory")
#define PG8_WAIT_L(n) asm volatile("s_waitcnt lgkmcnt(" #n ")" ::: "memory")
#define PG8_BAR __builtin_amdgcn_s_barrier()
#define PG8_SCHED __builtin_amdgcn_sched_barrier(0)
    Unit cur, nxt; int ui = 0;
    if (!S.next(0, cur)) return;
    f32x4 acc[2][2][4][2];
#pragma unroll
    for (int a = 0; a < 2; ++a)
#pragma unroll
        for (int b = 0; b < 2; ++b)
#pragma unroll
            for (int m = 0; m < 4; ++m)
#pragma unroll
                for (int n = 0; n < 2; ++n) acc[a][b][m][n] = (f32x4){0.f, 0.f, 0.f, 0.f};
    bf16x8 At[4][2], B0[2][2], B1[2][2];
    const char* cA = (const char*)g.A + (size_t)cur.pm * tstepA; const char* cB = (const char*)g.Bt + (size_t)cur.pn * tstepB;
    PG8_STAGE(PG8_SB(0, 0), cB, voffB); PG8_STAGE(PG8_SB(0, 1), cB + hstepB, voffB); PG8_STAGE(PG8_SA(0, 0), cA, voffA); PG8_STAGE(PG8_SA(0, 1), cA + hstepA, voffA);
    if (wr == 1) PG8_BAR;
    PG8_WAIT_V(2); PG8_BAR;
    PG8_STAGE(PG8_SB(1, 0), cB + kstep, voffB); PG8_STAGE(PG8_SA(1, 0), cA + kstep, voffA); PG8_STAGE(PG8_SB(1, 1), cB + hstepB + kstep, voffB);
    PG8_WAIT_V(6); PG8_BAR;
    for (;;) {
        const bool has_next = S.next(ui + 1, nxt);
        const char* nA = has_next ? (const char*)g.A + (size_t)nxt.pm * tstepA : cA; const char* nB = has_next ? (const char*)g.Bt + (size_t)nxt.pn * tstepB : cB;
        for (int t = 0; t < nt; t += 2) {
            const bool last = (t == nt - 2);
            const char* a1 = cA + (size_t)(t + 1) * kstep;
            const char* a2 = last ? nA : cA + (size_t)(t + 2) * kstep; const char* b2 = last ? nB : cB + (size_t)(t + 2) * kstep;
            const char* a3 = a2 + kstep; const char* b3 = b2 + kstep;
            PG8_LDB(B0, 0, 0); PG8_LDB(B1, 0, 1); PG8_SCHED; PG8_LDA(At, 0, 0); PG8_STAGE(PG8_SA(1, 1), a1 + hstepA, voffA);
            PG8_WAIT_V(8); PG8_WAIT_L(0); PG8_BAR; PG8_MMA(0, 0, At, B0); PG8_MMA(0, 1, At, B1); PG8_BAR; PG8_SCHED;
            PG8_LDA(At, 0, 1); PG8_STAGE(PG8_SB(0, 0), b2, voffB); PG8_STAGE(PG8_SB(0, 1), b2 + hstepB, voffB); PG8_STAGE(PG8_SA(0, 0), a2, voffA);
            PG8_WAIT_V(8); PG8_WAIT_L(0); PG8_BAR; PG8_MMA(1, 0, At, B0); PG8_MMA(1, 1, At, B1); PG8_BAR; PG8_SCHED;
            PG8_LDB(B0, 1, 0); PG8_LDB(B1, 1, 1); PG8_SCHED; PG8_LDA(At, 1, 0); PG8_STAGE(PG8_SA(0, 1), a2 + hstepA, voffA);
            PG8_WAIT_V(8); PG8_WAIT_L(0); PG8_BAR; PG8_MMA(0, 0, At, B0); PG8_MMA(0, 1, At, B1); PG8_BAR; PG8_SCHED;
            PG8_LDA(At, 1, 1); PG8_STAGE(PG8_SB(1, 0), b3, voffB); PG8_STAGE(PG8_SB(1, 1), b3 + hstepB, voffB); PG8_STAGE(PG8_SA(1, 0), a3, voffA);
            PG8_WAIT_V(8); PG8_WAIT_L(0); PG8_BAR; PG8_MMA(1, 0, At, B0); PG8_MMA(1, 1, At, B1); PG8_BAR; PG8_SCHED;
        }
        if (wr == 0) PG8_BAR;
        E(acc, cur, wr, wc, fr, fq);
        if (!has_next) break;
#pragma unroll
        for (int a = 0; a < 2; ++a)
#pragma unroll
            for (int b = 0; b < 2; ++b)
#pragma unroll
                for (int m = 0; m < 4; ++m)
#pragma unroll
                    for (int n = 0; n < 2; ++n) acc[a][b][m][n] = (f32x4){0.f, 0.f, 0.f, 0.f};
        cur = nxt; cA = nA; cB = nB; ++ui;
        if (wr == 1) PG8_BAR;
    }
    PG8_WAIT_V(0);
    PG8_BAR;
#undef PG8_SA
#undef PG8_SB
#undef PG8_STAGE
#undef PG8_LDA
#undef PG8_LDB
#undef PG8_MMA
#undef PG8_WAIT_V
#undef PG8_WAIT_L
#undef PG8_BAR
#undef PG8_SCHED
}
}

struct Args {
    const float* x; const int* pos; const float* w_in; const float* w_gate_up; const float* b_gate; const float* gla_norm_w; const float* gmlp_ln_g; const float* gmlp_ln_b;
    const float* gmlp_w_s; const float* gmlp_b_s; const float* w_branch; const float* w_out; const float* ln1_g; const float* ln1_b; const float* w_ff1; const float* w_ff2;
    const float* ln2_g; const float* ln2_b; float* out; unsigned char* ws; int ph_lo, ph_hi;
};

__device__ __forceinline__ float wave_sum(float v) {
#pragma unroll
    for (int o = 1; o < 64; o <<= 1) v += __shfl_xor(v, o);
    return v;
}

__device__ __forceinline__ void transpose_item(const float* W, int ldw, int col0, int K, int nblk, bf16_t* WT, int row_off, LAS float* scr, int item, int lane) {
    const int kb = item / nblk, nb = item % nblk, k0 = 64 * kb, n0 = 32 * nb;
#pragma unroll 8
    for (int i = 0; i < 32; ++i) { const int kk = 2 * i + (lane >> 5); scr[kk * 33 + (lane & 31)] = W[(size_t)(k0 + kk) * ldw + col0 + n0 + (lane & 31)]; }
    asm volatile("s_waitcnt lgkmcnt(0)" ::: "memory");
    const int c = lane & 7;
#pragma unroll
    for (int j = 0; j < 4; ++j) { const int n = (lane >> 3) + 8 * j; const LAS float* s = scr + (8 * c) * 33 + n;
        u32x4 o; o.x = cvt_pk_bf16(s[0 * 33], s[1 * 33]); o.y = cvt_pk_bf16(s[2 * 33], s[3 * 33]); o.z = cvt_pk_bf16(s[4 * 33], s[5 * 33]); o.w = cvt_pk_bf16(s[6 * 33], s[7 * 33]);
        *(u32x4*)(WT + (size_t)(row_off + n0 + n) * K + k0 + 8 * c) = o; }
    asm volatile("s_waitcnt lgkmcnt(0)" ::: "memory");
}

__device__ __forceinline__ void phase_prep(const Args& a, int l, LAS unsigned char* lds, int G) {
    const int tid = otid(), lane = tid & 63, wave = tid >> 6;
    LAS float* scr = (LAS float*)(lds + wave * 16384);
    const int gw = blockIdx.x * NWAVES + wave, NGW = G * NWAVES;
    bf16_t* WinT = (bf16_t*)(a.ws + WS_WIN); bf16_t* WbrT = (bf16_t*)(a.ws + WS_WBR); bf16_t* WoutT = (bf16_t*)(a.ws + WS_WOUT); bf16_t* W1T = (bf16_t*)(a.ws + WS_W1); bf16_t* W2T = (bf16_t*)(a.ws + WS_W2);
    const float* win = a.w_in + (size_t)l * D * IN_COLS;
    constexpr int I_IN_A = 16 * 64, I_IN_B = 16 * 176, I_BR = 8 * 32, I_OUT = 16 * 32, I_1 = 16 * 128, I_2 = 64 * 32;
    constexpr int NITEMS = I_IN_A + I_IN_B + 3 * I_BR + I_OUT + I_1 + I_2;
    for (int it = gw; it < NITEMS; it += NGW) {
        int r = it;
        if (r < I_IN_A) { transpose_item(win, IN_COLS, 0, D, 64, WinT, 0, scr, r, lane); continue; } r -= I_IN_A;
        if (r < I_IN_B) { transpose_item(win, IN_COLS, 2064, D, 176, WinT, 2048, scr, r, lane); continue; } r -= I_IN_B;
        if (r < 3 * I_BR) { const int br = r / I_BR; transpose_item(a.w_branch + ((size_t)l * 3 + br) * 512 * 1024, 1024, 0, 512, 32, WbrT, br * 1024, scr, r % I_BR, lane); continue; } r -= 3 * I_BR;
        if (r < I_OUT) { transpose_item(a.w_out + (size_t)l * D * D, D, 0, D, 32, WoutT, 0, scr, r, lane); continue; } r -= I_OUT;
        if (r < I_1) { transpose_item(a.w_ff1 + (size_t)l * D * FF, FF, 0, D, 128, W1T, 0, scr, r, lane); continue; } r -= I_1;
        transpose_item(a.w_ff2 + (size_t)l * FF * D, D, 0, FF, 32, W2T, 0, scr, r, lane);
    }
    { bf16_t* glrT = (bf16_t*)(a.ws + WS_GLR);
      for (int e = blockIdx.x * NTHREADS + tid; e < 16 * 1024; e += G * NTHREADS) { const int n = e >> 10, k = e & 1023; glrT[e] = (bf16_t)(cvt_pk_bf16(win[(size_t)k * IN_COLS + 2048 + n], 0.f) & 0xffffu); } }
    if (l == 0) {
        bf16_t* xbf = (bf16_t*)(a.ws + WS_XBF);
        for (size_t e = (size_t)(blockIdx.x * NTHREADS + tid) * 8; e < (size_t)M * D; e += (size_t)G * NTHREADS * 8) {
            const f32x4 v0 = *(const f32x4*)(a.x + e), v1 = *(const f32x4*)(a.x + e + 4);
            u32x4 w; w.x = cvt_pk_bf16(v0[0], v0[1]); w.y = cvt_pk_bf16(v0[2], v0[3]); w.z = cvt_pk_bf16(v1[0], v1[1]); w.w = cvt_pk_bf16(v1[2], v1[3]);
            *(u32x4*)(xbf + e) = w; }
    }
}

__device__ __forceinline__ void gla_bcum(const Args& a, int l, LAS unsigned char* lds, int m0, int h, float (&c)[16], float& bend) {
    const int tid = otid(), lane = tid & 63, wave = tid >> 6, fr = lane & 15, fq = lane >> 4;
    LAS float* lr = (LAS float*)lds; LAS float* tot = (LAS float*)(lds + 4352);
    const bf16_t* xbf = (const bf16_t*)(a.ws + WS_XBF); const bf16_t* glrT = (const bf16_t*)(a.ws + WS_GLR);
    if (tid < 128) {
        const int s = tid >> 1, hf = tid & 1;
        const u32x4 w = *(const u32x4*)((const bf16_t*)(a.ws + WS_PROJ) + (size_t)(m0 + s) * NP + C_LR + hf * 8);
        LAS float* lp = lr + s * 17 + hf * 8;
        lp[0] = bflo(w.x); lp[1] = bfhi(w.x); lp[2] = bflo(w.y); lp[3] = bfhi(w.y); lp[4] = bflo(w.z); lp[5] = bfhi(w.z); lp[6] = bflo(w.w); lp[7] = bfhi(w.w);
    }
    __syncthreads();
    const int d = tid & 127, g = tid >> 7, col = h * 128 + d;
    float wu[16];
#pragma unroll
    for (int r = 0; r < 16; ++r) wu[r] = a.w_gate_up[((size_t)l * 16 + r) * 512 + col];
    const float bg = a.b_gate[(size_t)l * 512 + col];
    float run = 0.f;
#pragma unroll
    for (int i = 0; i < 16; ++i) { const int s = g * 16 + i; float z = bg;
#pragma unroll
        for (int r = 0; r < 16; ++r) z += lr[s * 17 + r] * wu[r];
        const float la = (fminf(z, 0.f) - log1pf(__expf(-fabsf(z)))) * (1.f / 16.f);
        run += la; c[i] = run; }
    tot[g * 128 + d] = run;
    __syncthreads();
    float pre = 0.f, all = 0.f;
#pragma unroll
    for (int gg = 0; gg < 4; ++gg) { const float t = tot[gg * 128 + d]; all += t; if (gg < g) pre += t; }
#pragma unroll
    for (int i = 0; i < 16; ++i) c[i] += pre;
    bend = all;
}

__device__ __forceinline__ void gla_kv_unit(const Args& a, int l, LAS unsigned char* lds, int unit) {
    const int h = unit & 3, n = (unit >> 2) & 127, b = unit >> 9, m0 = b * SEQ + n * 64;
    const int tid = otid(), lane = tid & 63, wave = tid >> 6, fr = lane & 15, fq = lane >> 4;
    const bf16_t* proj = (const bf16_t*)(a.ws + WS_PROJ);
    float c[16], bend; gla_bcum(a, l, lds, m0, h, c, bend);
    const int d = tid & 127, g = tid >> 7, col = h * 128 + d;
    LAS unsigned char* keT = lds + 8192; LAS unsigned char* vT = lds + 8192 + 128 * 144;
    unsigned kw[8], vw[8];
#pragma unroll
    for (int i = 0; i < 16; i += 2) { const size_t r0 = (size_t)(m0 + g * 16 + i) * NP, r1 = r0 + NP;
        const float k0 = bf2f(proj[r0 + C_GK + col]) * __expf(bend - c[i]), k1 = bf2f(proj[r1 + C_GK + col]) * __expf(bend - c[i + 1]);
        kw[i >> 1] = cvt_pk_bf16(k0, k1); vw[i >> 1] = (unsigned)proj[r0 + C_GV + col] | ((unsigned)proj[r1 + C_GV + col] << 16); }
    *(LAS u32x4*)(keT + d * 144 + g * 32) = (u32x4){kw[0], kw[1], kw[2], kw[3]}; *(LAS u32x4*)(keT + d * 144 + g * 32 + 16) = (u32x4){kw[4], kw[5], kw[6], kw[7]};
    *(LAS u32x4*)(vT + d * 144 + g * 32) = (u32x4){vw[0], vw[1], vw[2], vw[3]}; *(LAS u32x4*)(vT + d * 144 + g * 32 + 16) = (u32x4){vw[4], vw[5], vw[6], vw[7]};
    const int bh = b * 4 + h;
    if (g == 0) ((float*)(a.ws + WS_DEC))[((size_t)bh * 128 + n) * 128 + d] = __expf(bend);
    __syncthreads();
    bf16_t* ST = (bf16_t*)(a.ws + WS_ST) + ((size_t)bh * 128 + n) * 16384;
    bf16x8 af[2];
#pragma unroll
    for (int kk = 0; kk < 2; ++kk) af[kk] = *(const LAS bf16x8*)(keT + (wave * 16 + fr) * 144 + kk * 64 + fq * 16);
#pragma unroll
    for (int dvt = 0; dvt < 8; ++dvt) { f32x4 acc = {0.f, 0.f, 0.f, 0.f};
#pragma unroll
        for (int kk = 0; kk < 2; ++kk) { const bf16x8 bv = *(const LAS bf16x8*)(vT + (dvt * 16 + fr) * 144 + kk * 64 + fq * 16); acc = mfma16(af[kk], bv, acc); }
        u32x2 w; w.x = cvt_pk_bf16(acc[0], acc[1]); w.y = cvt_pk_bf16(acc[2], acc[3]);
        *(u32x2*)(ST + (size_t)(dvt * 16 + fr) * 128 + wave * 16 + 4 * fq) = w; }
    __syncthreads();
}

__device__ __forceinline__ void gla_scan(const Args& a, int G) {
    const int tid = otid();
    for (int e = blockIdx.x * NTHREADS + tid; e < 8 * 128 * 64; e += G * NTHREADS) {
        const int dkp = e & 63, dv = (e >> 6) & 127, bh = e >> 13;
        unsigned* st = (unsigned*)(a.ws + WS_ST) + ((size_t)bh * 128 * 16384 + (size_t)dv * 128) / 2 + dkp;
        const f32x2* dec = (const f32x2*)(a.ws + WS_DEC) + ((size_t)bh * 128 * 128) / 2 + dkp;
        float s0 = 0.f, s1 = 0.f;
#pragma unroll 8
        for (int n = 0; n < 128; ++n) { const unsigned kv = st[(size_t)n * 8192]; const f32x2 dc = dec[n * 64];
            st[(size_t)n * 8192] = cvt_pk_bf16(s0, s1);
            s0 = dc.x * s0 + bflo(kv); s1 = dc.y * s1 + bfhi(kv); }
    }
}

__device__ __forceinline__ void gla_out_unit(const Args& a, int l, LAS unsigned char* lds, int unit) {
    const int h = unit & 3, n = (unit >> 2) & 127, b = unit >> 9, m0 = b * SEQ + n * 64;
    const int tid = otid(), lane = tid & 63, wave = tid >> 6, fr = lane & 15, fq = lane >> 4;
    const bf16_t* proj = (const bf16_t*)(a.ws + WS_PROJ);
    float c[16], bend; gla_bcum(a, l, lds, m0, h, c, bend);
    const int d = tid & 127, g = tid >> 7, col = h * 128 + d;
    LAS unsigned char* qd = lds + 8192;
    LAS unsigned char* ki = qd + 64 * 272;
    LAS unsigned char* vT = ki + 64 * 272;
    LAS unsigned char* at = vT + 128 * 144;
    LAS float* ssq = (LAS float*)(at + 64 * 144);
    unsigned vw[8];
#pragma unroll
    for (int i = 0; i < 16; i += 2) { const size_t r0 = (size_t)(m0 + g * 16 + i) * NP, r1 = r0 + NP;
        const float e0 = __expf(c[i]), e1 = __expf(c[i + 1]);
        const float q0 = bf2f(proj[r0 + C_GQ + col]) * e0, q1 = bf2f(proj[r1 + C_GQ + col]) * e1;
        const float k0 = bf2f(proj[r0 + C_GK + col]) * 0.08838834764831845f / e0, k1 = bf2f(proj[r1 + C_GK + col]) * 0.08838834764831845f / e1;
        *(LAS bf16_t*)(qd + (g * 16 + i) * 272 + d * 2) = (bf16_t)(cvt_pk_bf16(q0, 0.f) & 0xffffu); *(LAS bf16_t*)(qd + (g * 16 + i + 1) * 272 + d * 2) = (bf16_t)(cvt_pk_bf16(q1, 0.f) & 0xffffu);
        *(LAS bf16_t*)(ki + (g * 16 + i) * 272 + d * 2) = (bf16_t)(cvt_pk_bf16(k0, 0.f) & 0xffffu); *(LAS bf16_t*)(ki + (g * 16 + i + 1) * 272 + d * 2) = (bf16_t)(cvt_pk_bf16(k1, 0.f) & 0xffffu);
        vw[i >> 1] = (unsigned)proj[r0 + C_GV + col] | ((unsigned)proj[r1 + C_GV + col] << 16); }
    *(LAS u32x4*)(vT + d * 144 + g * 32) = (u32x4){vw[0], vw[1], vw[2], vw[3]}; *(LAS u32x4*)(vT + d * 144 + g * 32 + 16) = (u32x4){vw[4], vw[5], vw[6], vw[7]};
    __syncthreads();
    { const int tt = wave >> 1;
      bf16x8 qf[4];
#pragma unroll
      for (int kk = 0; kk < 4; ++kk) qf[kk] = *(const LAS bf16x8*)(qd + (tt * 16 + fr) * 272 + kk * 64 + fq * 16);
#pragma unroll
      for (int s2 = 0; s2 < 2; ++s2) { const int stl = (wave & 1) * 2 + s2; f32x4 acc = {0.f, 0.f, 0.f, 0.f};
#pragma unroll
          for (int kk = 0; kk < 4; ++kk) { const bf16x8 kf = *(const LAS bf16x8*)(ki + (stl * 16 + fr) * 272 + kk * 64 + fq * 16); acc = mfma16(kf, qf[kk], acc); }
          const int t = tt * 16 + fr, s0 = stl * 16 + 4 * fq;
#pragma unroll
          for (int jj = 0; jj < 4; ++jj) if (s0 + jj > t) acc[jj] = 0.f;
          u32x2 w; w.x = cvt_pk_bf16(acc[0], acc[1]); w.y = cvt_pk_bf16(acc[2], acc[3]);
          *(LAS u32x2*)(at + t * 144 + s0 * 2) = w; } }
    __syncthreads();
    const int tt = wave & 3, dvh = wave >> 2, bh = b * 4 + h;
    const bf16_t* ST = (const bf16_t*)(a.ws + WS_ST) + ((size_t)bh * 128 + n) * 16384;
    bf16x8 atf[2], qf[4];
#pragma unroll
    for (int kk = 0; kk < 2; ++kk) atf[kk] = *(const LAS bf16x8*)(at + (tt * 16 + fr) * 144 + kk * 64 + fq * 16);
#pragma unroll
    for (int kk = 0; kk < 4; ++kk) qf[kk] = *(const LAS bf16x8*)(qd + (tt * 16 + fr) * 272 + kk * 64 + fq * 16);
    f32x4 o[4]; float sq = 0.f;
#pragma unroll
    for (int j = 0; j < 4; ++j) { const int dvt = dvh * 4 + j; f32x4 acc = {0.f, 0.f, 0.f, 0.f};
#pragma unroll
        for (int kk = 0; kk < 2; ++kk) { const bf16x8 vf = *(const LAS bf16x8*)(vT + (dvt * 16 + fr) * 144 + kk * 64 + fq * 16); acc = mfma16(vf, atf[kk], acc); }
        f32x4 acs = {0.f, 0.f, 0.f, 0.f};
#pragma unroll
        for (int kk = 0; kk < 4; ++kk) { const bf16x8 sf = *(const bf16x8*)(ST + (size_t)(dvt * 16 + fr) * 128 + kk * 32 + fq * 8); acs = mfma16(sf, qf[kk], acs); }
        acc += acs * 0.08838834764831845f;
        o[j] = acc; sq += acc[0] * acc[0] + acc[1] * acc[1] + acc[2] * acc[2] + acc[3] * acc[3]; }
    sq += __shfl_xor(sq, 16); sq += __shfl_xor(sq, 32);
    if (fq == 0) ssq[dvh * 64 + tt * 16 + fr] = sq;
    __syncthreads();
    const float rs = 1.f / sqrtf((ssq[tt * 16 + fr] + ssq[64 + tt * 16 + fr]) * (1.f / 128.f) + RMS_EPS);
    const int m = m0 + tt * 16 + fr;
    bf16_t* br0 = (bf16_t*)(a.ws + WS_BR);
#pragma unroll
    for (int j = 0; j < 4; ++j) { const int dv = (dvh * 4 + j) * 16 + 4 * fq;
        const f32x4 nw = *(const f32x4*)(a.gla_norm_w + (size_t)l * 128 + dv);
        const u32x2 gw = *(const u32x2*)(proj + (size_t)m * NP + C_GG + h * 128 + dv);
        const float gg[4] = {bflo(gw.x), bfhi(gw.x), bflo(gw.y), bfhi(gw.y)}; float r[4];
#pragma unroll
        for (int e = 0; e < 4; ++e) r[e] = o[j][e] * rs * nw[e] * (gg[e] / (1.f + __expf(-gg[e])));
        u32x2 w; w.x = cvt_pk_bf16(r[0], r[1]); w.y = cvt_pk_bf16(r[2], r[3]);
        *(u32x2*)(br0 + (size_t)m * 512 + h * 128 + dv) = w; }
    __syncthreads();
}

__device__ __forceinline__ float gelu_erf(float v) { return 0.5f * v * (1.f + erff(v * 0.70710678118654752f)); }
__device__ __forceinline__ void gmlp_unit(const Args& a, int l, LAS unsigned char* lds, int unit) {
    const int g = unit & 3, nc = (unit >> 2) & 63, b = unit >> 8, m0 = b * SEQ + nc * 128;
    const int tid = otid(), lane = tid & 63, wave = tid >> 6, fr = lane & 15, fq = lane >> 4;
    const bf16_t* proj = (const bf16_t*)(a.ws + WS_PROJ);
    LAS float* stats = (LAS float*)lds;
    LAS unsigned char* vnT = lds + 1024;
    LAS unsigned char* wm = vnT + 128 * 272;
    { const int tok = tid >> 2, part = tid & 3; const bf16_t* vp = proj + (size_t)(m0 + tok) * NP + C_GZV + part * 128;
      float s = 0.f, s2 = 0.f;
#pragma unroll 4
      for (int j = 0; j < 16; ++j) { const u32x4 w = *(const u32x4*)(vp + j * 8); const unsigned ww[4] = {w.x, w.y, w.z, w.w};
#pragma unroll
          for (int e = 0; e < 4; ++e) { const float g0 = gelu_erf(bflo(ww[e])), g1 = gelu_erf(bfhi(ww[e])); s += g0 + g1; s2 += g0 * g0 + g1 * g1; } }
      s += __shfl_xor(s, 1); s += __shfl_xor(s, 2); s2 += __shfl_xor(s2, 1); s2 += __shfl_xor(s2, 2);
      const float mean = s * (1.f / 512.f), var = fmaxf(s2 * (1.f / 512.f) - mean * mean, 0.f);
      if (part == 0) { stats[tok * 2] = mean; stats[tok * 2 + 1] = 1.f / sqrtf(var + LN_EPS); } }
    { const int t = tid >> 2, sq4 = (tid & 3) * 32; const float* wp = a.gmlp_w_s + (((size_t)l * 4 + g) * 128 + t) * 128 + sq4;
#pragma unroll
      for (int j = 0; j < 4; ++j) { const f32x4 w0 = *(const f32x4*)(wp + j * 8), w1 = *(const f32x4*)(wp + j * 8 + 4); float v[8] = {w0[0], w0[1], w0[2], w0[3], w1[0], w1[1], w1[2], w1[3]};
#pragma unroll
          for (int e = 0; e < 8; ++e) if (sq4 + j * 8 + e > t) v[e] = 0.f;
          *(LAS u32x4*)(wm + t * 272 + (sq4 + j * 8) * 2) = (u32x4){cvt_pk_bf16(v[0], v[1]), cvt_pk_bf16(v[2], v[3]), cvt_pk_bf16(v[4], v[5]), cvt_pk_bf16(v[6], v[7])}; } }
    __syncthreads();
    { const int cch = tid & 127, sg = tid >> 7; const float lg = a.gmlp_ln_g[(size_t)l * 512 + g * 128 + cch], lb = a.gmlp_ln_b[(size_t)l * 512 + g * 128 + cch];
#pragma unroll
      for (int j = 0; j < 4; ++j) { unsigned w[4];
#pragma unroll
          for (int e = 0; e < 4; ++e) { const int s0 = sg * 32 + j * 8 + e * 2;
              const float v0 = gelu_erf(bf2f(proj[(size_t)(m0 + s0) * NP + C_GZV + g * 128 + cch])), v1 = gelu_erf(bf2f(proj[(size_t)(m0 + s0 + 1) * NP + C_GZV + g * 128 + cch]));
              w[e] = cvt_pk_bf16((v0 - stats[s0 * 2]) * stats[s0 * 2 + 1] * lg + lb, (v1 - stats[s0 * 2 + 2]) * stats[s0 * 2 + 3] * lg + lb); }
          *(LAS u32x4*)(vnT + cch * 272 + (sg * 32 + j * 8) * 2) = (u32x4){w[0], w[1], w[2], w[3]}; } }
    __syncthreads();
    const int nk = ((wave * 16 + 15) >> 5) + 1;
    bf16x8 wf[4];
#pragma unroll
    for (int kk = 0; kk < 4; ++kk) wf[kk] = *(const LAS bf16x8*)(wm + (wave * 16 + fr) * 272 + kk * 64 + fq * 16);
    const int t = wave * 16 + fr, m = m0 + t;
    const float bs = a.gmlp_b_s[((size_t)l * 4 + g) * 128 + t];
    bf16_t* br1 = (bf16_t*)(a.ws + WS_BR) + (size_t)M * 512;
#pragma unroll
    for (int ct = 0; ct < 8; ++ct) { f32x4 acc = {0.f, 0.f, 0.f, 0.f};
#pragma unroll
        for (int kk = 0; kk < 4; ++kk) if (kk < nk) { const bf16x8 vf = *(const LAS bf16x8*)(vnT + (ct * 16 + fr) * 272 + kk * 64 + fq * 16); acc = mfma16(vf, wf[kk], acc); }
        const int cc = g * 128 + ct * 16 + 4 * fq;
        const u32x2 uw = *(const u32x2*)(proj + (size_t)m * NP + C_GZU + cc);
        const float u0 = gelu_erf(bflo(uw.x)), u1 = gelu_erf(bfhi(uw.x)), u2 = gelu_erf(bflo(uw.y)), u3 = gelu_erf(bfhi(uw.y));
        u32x2 w; w.x = cvt_pk_bf16(u0 * (acc[0] + bs), u1 * (acc[1] + bs)); w.y = cvt_pk_bf16(u2 * (acc[2] + bs), u3 * (acc[3] + bs));
        *(u32x2*)(br1 + (size_t)m * 512 + cc) = w; }
    __syncthreads();
}

__device__ __forceinline__ void moba_prep_unit(const Args& a, LAS unsigned char* lds, int unit) {
    const int blk = unit & 31, h = (unit >> 5) & 3, b = unit >> 7, m0 = b * SEQ + blk * 256;
    const int tid = otid();
    bf16_t* proj = (bf16_t*)(a.ws + WS_PROJ);
#pragma unroll 2
    for (int it = 0; it < 8; ++it) { const int item = tid + it * NTHREADS, tok = item >> 4, i = item & 15; const size_t m = (size_t)(m0 + tok);
        const float inv = exp2f(-(float)i * (18.931568569324174f / 16.f));
        const float ang = (float)a.pos[m] * inv; float sn, cs; sincosf(ang, &sn, &cs);
        bf16_t* kp = proj + m * NP + C_MK + h * 128 + i; bf16_t* qp = proj + m * NP + C_MQ + h * 128 + i;
        const float k1 = bf2f(kp[0]), k2 = bf2f(kp[16]), q1 = bf2f(qp[0]), q2 = bf2f(qp[16]);
        const unsigned kw = cvt_pk_bf16(k1 * cs - k2 * sn, k2 * cs + k1 * sn), qw = cvt_pk_bf16(q1 * cs - q2 * sn, q2 * cs + q1 * sn);
        kp[0] = (bf16_t)(kw & 0xffffu); kp[16] = (bf16_t)(kw >> 16); qp[0] = (bf16_t)(qw & 0xffffu); qp[16] = (bf16_t)(qw >> 16); }
    __threadfence_block();
    __syncthreads();
    { const int d = tid & 127, kg = tid >> 7; LAS float* red = (LAS float*)lds; float s = 0.f;
#pragma unroll 8
      for (int j = 0; j < 64; ++j) s += bf2f(proj[(size_t)(m0 + kg * 64 + j) * NP + C_MK + h * 128 + d]);
      red[kg * 128 + d] = s;
      __syncthreads();
      if (kg == 0) ((float*)(a.ws + WS_KMEAN))[((size_t)(b * 4 + h) * 32 + blk) * 128 + d] = (red[d] + red[128 + d] + red[256 + d] + red[384 + d]) * (1.f / 256.f);
      __syncthreads(); }
    { LAS unsigned char* tT = lds + 4096;
#pragma unroll 2
      for (int it = 0; it < 8; ++it) { const int p = tid + it * NTHREADS, key = p >> 4, pc = p & 15;
          const u32x4 w = *(const u32x4*)(proj + (size_t)(m0 + key) * NP + C_MV + h * 128 + pc * 8); const unsigned ww[4] = {w.x, w.y, w.z, w.w};
#pragma unroll
          for (int e = 0; e < 4; ++e) { *(LAS bf16_t*)(tT + (pc * 8 + 2 * e) * 528 + key * 2) = (bf16_t)(ww[e] & 0xffffu); *(LAS bf16_t*)(tT + (pc * 8 + 2 * e + 1) * 528 + key * 2) = (bf16_t)(ww[e] >> 16); } }
      __syncthreads();
      bf16_t* VT = (bf16_t*)(a.ws + WS_VT) + (size_t)(b * 4 + h) * 128 * SEQ + blk * 256;
#pragma unroll 2
      for (int it = 0; it < 8; ++it) { const int p = tid + it * NTHREADS, dv = p >> 5, pc = p & 31;
          *(u32x4*)(VT + (size_t)dv * SEQ + pc * 8) = *(const LAS u32x4*)(tT + dv * 528 + pc * 16); }
      __syncthreads(); }
}

__device__ __forceinline__ void moba_attn_unit(const Args& a, LAS unsigned char* lds, int b, int h, int qt) {
    const int tid = otid(), lane = tid & 63, wave = tid >> 6, fr = lane & 15, fq = lane >> 4;
    const int q0 = qt * 128, own = q0 >> 8, bs = own * 256, m0 = b * SEQ + q0, bh = b * 4 + h;
    const bf16_t* proj = (const bf16_t*)(a.ws + WS_PROJ);
    LAS float* km = (LAS float*)lds;
    LAS float* sc = (LAS float*)(lds + 16384);
    LAS unsigned* rmask = (LAS unsigned*)(lds + 33280);
    LAS int* tlist = (LAS int*)(lds + 33792);
    LAS unsigned char* Ks = lds + 34816;
    LAS unsigned char* Vs = lds + 34816 + 64 * 272;
    const float* kmg = (const float*)(a.ws + WS_KMEAN) + (size_t)bh * 32 * 128;
    for (int e = tid; e < own * 128; e += NTHREADS) km[e] = kmg[e];
    __syncthreads();
    if (own > 3) {
        const int row = tid >> 2, part = tid & 3; const bf16_t* qp = proj + (size_t)(m0 + row) * NP + C_MQ + h * 128;
        float s8[8];
#pragma unroll
        for (int jj = 0; jj < 8; ++jj) s8[jj] = 0.f;
#pragma unroll 2
        for (int dc = 0; dc < 16; ++dc) { const u32x4 w = *(const u32x4*)(qp + dc * 8); const float qv[8] = {bflo(w.x), bfhi(w.x), bflo(w.y), bfhi(w.y), bflo(w.z), bfhi(w.z), bflo(w.w), bfhi(w.w)};
#pragma unroll
            for (int jj = 0; jj < 8; ++jj) { const int j = part + 4 * jj; if (j < own) {
#pragma unroll
                for (int e = 0; e < 8; ++e) s8[jj] += qv[e] * km[j * 128 + dc * 8 + e]; } } }
#pragma unroll
        for (int jj = 0; jj < 8; ++jj) { const int j = part + 4 * jj; if (j < own) sc[row * 33 + j] = s8[jj]; }
    }
    __syncthreads();
    if (tid < 128) { unsigned mk;
        if (own <= 3) mk = (1u << own) - 1u;
        else { float b0 = -INFINITY, b1 = -INFINITY, b2 = -INFINITY; int i0 = 0, i1 = 0, i2 = 0;
            for (int j = 0; j < own; ++j) { const float v = sc[tid * 33 + j];
                if (v > b0) { b2 = b1; i2 = i1; b1 = b0; i1 = i0; b0 = v; i0 = j; } else if (v > b1) { b2 = b1; i2 = i1; b1 = v; i1 = j; } else if (v > b2) { b2 = v; i2 = j; } }
            mk = (1u << i0) | (1u << i1) | (1u << i2); }
        rmask[tid] = mk; }
    __syncthreads();
    unsigned bun = rmask[lane] | rmask[lane + 64];
#pragma unroll
    for (int o = 1; o < 64; o <<= 1) bun |= __shfl_xor(bun, o);
    bun = __builtin_amdgcn_readfirstlane(bun);
    const int r = wave * 16 + fr; const unsigned mymask = rmask[r];
    unsigned wmask = mymask;
#pragma unroll
    for (int o = 1; o < 16; o <<= 1) wmask |= __shfl_xor(wmask, o);
    wmask = __builtin_amdgcn_readfirstlane(wmask);
    const int n_own = ((q0 - bs) >> 6) + 2, ntiles = n_own + 4 * __builtin_popcount(bun);
    if (tid == 0) { int k = 0; for (int i = 0; i < n_own; ++i) tlist[k++] = bs + i * 64;
        for (int j = 0; j < own; ++j) if ((bun >> j) & 1u) { for (int i = 0; i < 4; ++i) tlist[k++] = j * 256 + i * 64; } }
    bf16x8 qf[4];
#pragma unroll
    for (int kk = 0; kk < 4; ++kk) qf[kk] = *(const bf16x8*)(proj + (size_t)(m0 + r) * NP + C_MQ + h * 128 + kk * 32 + fq * 8);
    const int qpos = q0 + r;
    f32x4 o[8];
#pragma unroll
    for (int j = 0; j < 8; ++j) o[j] = (f32x4){0.f, 0.f, 0.f, 0.f};
    float mrun = -INFINITY, lrun = 0.f;
    const bf16_t* kbase = proj + (size_t)(b * SEQ) * NP + C_MK + h * 128;
    const bf16_t* vbase = (const bf16_t*)(a.ws + WS_VT) + (size_t)bh * 128 * SEQ;
    __syncthreads();
    u32x4 kreg[2], vreg[2];
    { const int kp0 = tlist[0];
#pragma unroll
      for (int i = 0; i < 2; ++i) { const int p = tid + i * NTHREADS; kreg[i] = *(const u32x4*)(kbase + (size_t)(kp0 + (p >> 4)) * NP + (p & 15) * 8); vreg[i] = *(const u32x4*)(vbase + (size_t)(p >> 3) * SEQ + kp0 + (p & 7) * 8); } }
    const float SC = 0.08838834764831845f * 1.4426950408889634f;
    for (int it = 0; it < ntiles; ++it) {
        const int kp0 = tlist[it];
        __syncthreads();
#pragma unroll
        for (int i = 0; i < 2; ++i) { const int p = tid + i * NTHREADS; *(LAS u32x4*)(Ks + (p >> 4) * 272 + (p & 15) * 16) = kreg[i]; *(LAS u32x4*)(Vs + (p >> 3) * 144 + (p & 7) * 16) = vreg[i]; }
        __syncthreads();
        if (it + 1 < ntiles) { const int kn = tlist[it + 1];
#pragma unroll
            for (int i = 0; i < 2; ++i) { const int p = tid + i * NTHREADS; kreg[i] = *(const u32x4*)(kbase + (size_t)(kn + (p >> 4)) * NP + (p & 15) * 8); vreg[i] = *(const u32x4*)(vbase + (size_t)(p >> 3) * SEQ + kn + (p & 7) * 8); } }
        const int kblk = kp0 >> 8; const bool isown = (kblk == own);
        const bool active = isown ? (kp0 <= q0 + wave * 16 + 15) : (((wmask >> kblk) & 1u) != 0u);
        if (active) {
            f32x4 st[4];
#pragma unroll
            for (int kt = 0; kt < 4; ++kt) { f32x4 acc = {0.f, 0.f, 0.f, 0.f};
#pragma unroll
                for (int kk = 0; kk < 4; ++kk) { const bf16x8 kf = *(const LAS bf16x8*)(Ks + (kt * 16 + fr) * 272 + kk * 64 + fq * 16); acc = mfma16(kf, qf[kk], acc); }
                st[kt] = acc * SC; }
            if (isown) {
#pragma unroll
                for (int kt = 0; kt < 4; ++kt)
#pragma unroll
                    for (int jj = 0; jj < 4; ++jj) if (kp0 + kt * 16 + 4 * fq + jj > qpos) st[kt][jj] = -INFINITY;
            } else if (!((mymask >> kblk) & 1u)) {
#pragma unroll
                for (int kt = 0; kt < 4; ++kt) st[kt] = (f32x4){-INFINITY, -INFINITY, -INFINITY, -INFINITY};
            }
            float mx = -INFINITY;
#pragma unroll
            for (int kt = 0; kt < 4; ++kt) mx = fmaxf(mx, fmaxf(fmaxf(st[kt][0], st[kt][1]), fmaxf(st[kt][2], st[kt][3])));
            mx = fmaxf(mx, __shfl_xor(mx, 16)); mx = fmaxf(mx, __shfl_xor(mx, 32));
            const float mnew = fmaxf(mrun, mx);
            const float msafe = (mnew == -INFINITY) ? 0.f : mnew;
            const float alpha = exp2f(mrun - msafe);
            float ls = 0.f;
#pragma unroll
            for (int kt = 0; kt < 4; ++kt)
#pragma unroll
                for (int jj = 0; jj < 4; ++jj) { const float p = exp2f(st[kt][jj] - msafe); st[kt][jj] = p; ls += p; }
            ls += __shfl_xor(ls, 16); ls += __shfl_xor(ls, 32);
            lrun = lrun * alpha + ls; mrun = mnew;
            bf16x8 pf[2];
#pragma unroll
            for (int k2 = 0; k2 < 2; ++k2) { const u32x4 w = {cvt_pk_bf16(st[2 * k2][0], st[2 * k2][1]), cvt_pk_bf16(st[2 * k2][2], st[2 * k2][3]), cvt_pk_bf16(st[2 * k2 + 1][0], st[2 * k2 + 1][1]), cvt_pk_bf16(st[2 * k2 + 1][2], st[2 * k2 + 1][3])};
                pf[k2] = __builtin_bit_cast(bf16x8, w); }
#pragma unroll
            for (int dvt = 0; dvt < 8; ++dvt) { f32x4 acc = o[dvt] * alpha;
#pragma unroll
                for (int k2 = 0; k2 < 2; ++k2) { const u32x2 v0 = *(const LAS u32x2*)(Vs + (dvt * 16 + fr) * 144 + (32 * k2 + 4 * fq) * 2), v1 = *(const LAS u32x2*)(Vs + (dvt * 16 + fr) * 144 + (32 * k2 + 16 + 4 * fq) * 2);
                    const u32x4 vw = {v0.x, v0.y, v1.x, v1.y};
                    acc = mfma16(__builtin_bit_cast(bf16x8, vw), pf[k2], acc); }
                o[dvt] = acc; }
        }
    }
    const float il = 1.f / lrun;
    bf16_t* br2 = (bf16_t*)(a.ws + WS_BR) + (size_t)2 * M * 512;
#pragma unroll
    for (int dvt = 0; dvt < 8; ++dvt) { u32x2 w; w.x = cvt_pk_bf16(o[dvt][0] * il, o[dvt][1] * il); w.y = cvt_pk_bf16(o[dvt][2] * il, o[dvt][3] * il);
        *(u32x2*)(br2 + (size_t)(m0 + r) * 512 + h * 128 + dvt * 16 + 4 * fq) = w; }
    __syncthreads();
}

__device__ __forceinline__ void phase_ln(const Args& a, const float* gam, const float* bet, int G) {
    const int tid = otid(), lane = tid & 63, wave = tid >> 6;
    bf16_t* xbf = (bf16_t*)(a.ws + WS_XBF);
    f32x4 gv[4], bv[4];
#pragma unroll
    for (int j = 0; j < 4; ++j) { gv[j] = *(const f32x4*)(gam + 4 * lane + 256 * j); bv[j] = *(const f32x4*)(bet + 4 * lane + 256 * j); }
    for (int m = blockIdx.x * NWAVES + wave; m < M; m += G * NWAVES) {
        f32x4* xr = (f32x4*)(a.out + (size_t)m * D) + lane;
        f32x4 v[4]; float s = 0.f;
#pragma unroll
        for (int j = 0; j < 4; ++j) { v[j] = xr[64 * j]; s += (v[j][0] + v[j][1]) + (v[j][2] + v[j][3]); }
        const float mean = wave_sum(s) * (1.f / D); float s2 = 0.f;
#pragma unroll
        for (int j = 0; j < 4; ++j) { v[j] = v[j] - mean; s2 += (v[j][0] * v[j][0] + v[j][1] * v[j][1]) + (v[j][2] * v[j][2] + v[j][3] * v[j][3]); }
        const float rstd = 1.f / sqrtf(wave_sum(s2) * (1.f / D) + LN_EPS);
        u32x2* o8 = (u32x2*)(xbf + (size_t)m * D) + lane;
#pragma unroll
        for (int j = 0; j < 4; ++j) { const f32x4 y = v[j] * rstd * gv[j] + bv[j]; xr[64 * j] = y; o8[64 * j] = (u32x2){cvt_pk_bf16(y[0], y[1]), cvt_pk_bf16(y[2], y[3])}; }
    }
}

__global__ void __launch_bounds__(NTHREADS, 2) fwd_mega(Args a) {
    extern __shared__ __attribute__((aligned(16))) unsigned char lds_raw[];
    LAS unsigned char* lds = (LAS unsigned char*)lds_raw;
    cg::grid_group grid = cg::this_grid();
    const int G = gridDim.x, bid = blockIdx.x;
    const float ALPHA = 1.6817928305074290f;
    bf16_t* xbf = (bf16_t*)(a.ws + WS_XBF); bf16_t* proj = (bf16_t*)(a.ws + WS_PROJ);
    for (int ph = a.ph_lo; ph < a.ph_hi; ++ph) {
        const int l = ph / PH_PER_LAYER, k = ph % PH_PER_LAYER;
        switch (k) {
        case 0: if (l == 0) phase_prep(a, 0, lds, G); break;
        case 1: { pg8::Gemm g{xbf, (const bf16_t*)(a.ws + WS_WIN), M, NP, D, D}; pg8::StaticOrder S; S.init(M, NP, G, bid);
                  pg8::EpiStore<0> E{proj, NP}; pg8::gemm_phase(lds, g, S, E); } break;
        case 2: {
                  for (int u = bid; u < 1792; u += G) { if (u < 256) moba_prep_unit(a, lds, u); else if (u < 768) gmlp_unit(a, l, lds, u - 256); else gla_kv_unit(a, l, lds, u - 768); } } break;
        case 3: { gla_scan(a, G);
                  for (int i = 0;; ++i) { const int u = i * G + bid; if (u >= 512) break;
                      int qt, bh; if (u < 256) { qt = 63 - (u >> 3); bh = u & 7; } else { qt = (u - 256) >> 3; bh = u & 7; }
                      moba_attn_unit(a, lds, bh >> 2, bh & 3, qt); } } break;
        case 4: { for (int u = bid; u < 1024; u += G) gla_out_unit(a, l, lds, u); } break;
        case 5: { pg8::Gemm g{(const bf16_t*)(a.ws + WS_BR), (const bf16_t*)(a.ws + WS_WBR), 3 * M, 3 * D, 512, 512}; pg8::MergeOrder S{G, bid};
                  pg8::EpiMerge E{proj, (float*)(a.ws + WS_PROJ), (bf16_t*)(a.ws + WS_MERGED)}; pg8::gemm_phase(lds, g, S, E); } break;
        case 6: { pg8::Gemm g{(const bf16_t*)(a.ws + WS_MERGED), (const bf16_t*)(a.ws + WS_WOUT), M, D, D, D}; pg8::StaticOrder S; S.init(M, D, G, bid);
                  pg8::EpiResid E{l == 0 ? a.x : a.out, a.out, ALPHA}; pg8::gemm_phase(lds, g, S, E); } break;
        case 7: phase_ln(a, a.ln1_g + (size_t)l * D, a.ln1_b + (size_t)l * D, G); break;
        case 8: { pg8::Gemm g{xbf, (const bf16_t*)(a.ws + WS_W1), M, FF, D, D}; pg8::StaticOrder S; S.init(M, FF, G, bid);
                  pg8::EpiStore<2> E{proj, FF}; pg8::gemm_phase(lds, g, S, E); } break;
        case 9: { pg8::Gemm g{proj, (const bf16_t*)(a.ws + WS_W2), M, D, FF, FF}; pg8::StaticOrder S; S.init(M, D, G, bid);
                  pg8::EpiResid E{a.out, a.out, ALPHA}; pg8::gemm_phase(lds, g, S, E); } break;
        default: phase_ln(a, a.ln2_g + (size_t)l * D, a.ln2_b + (size_t)l * D, G); if (l + 1 < DEPTH) phase_prep(a, l + 1, lds, G); break;
        }
        if (ph + 1 < a.ph_hi && !(ph % PH_PER_LAYER == 0 && ph > 0)) grid.sync();
    }
}

#ifndef MK_PER_PHASE
#define MK_PER_PHASE 0
#endif
extern "C" void kernel_launch(void* const* d_in, const int* in_sizes, int n_in, void* d_out, int out_size, void* d_ws, size_t ws_size, hipStream_t stream) {
    static int grid = 0;
    if (grid == 0) {
        if (n_in != 18 || out_size != M * D || ws_size < WS_END) { fprintf(stderr, "kernel_launch: unexpected problem (n_in %d out %d ws %zu)\n", n_in, out_size, ws_size); grid = -1; return; }
        int dev = 0, cus = 0, per_cu = 0;
        if (hipGetDevice(&dev) != hipSuccess || hipDeviceGetAttribute(&cus, hipDeviceAttributeMultiprocessorCount, dev) != hipSuccess) { grid = -1; return; }
        if (hipFuncSetAttribute((const void*)fwd_mega, hipFuncAttributeMaxDynamicSharedMemorySize, LDS_BYTES) != hipSuccess) { fprintf(stderr, "kernel_launch: hipFuncSetAttribute failed\n"); grid = -1; return; }
        if (hipOccupancyMaxActiveBlocksPerMultiprocessor(&per_cu, (const void*)fwd_mega, NTHREADS, LDS_BYTES) != hipSuccess || per_cu < 1) { fprintf(stderr, "kernel_launch: occupancy query says %d\n", per_cu); per_cu = 1; }
        (void)hipGetLastError();
        grid = cus;
    }
    if (grid < 0) return;
    Args a{};
    a.x = (const float*)d_in[0]; a.pos = (const int*)d_in[1]; a.w_in = (const float*)d_in[2]; a.w_gate_up = (const float*)d_in[3]; a.b_gate = (const float*)d_in[4];
    a.gla_norm_w = (const float*)d_in[5]; a.gmlp_ln_g = (const float*)d_in[6]; a.gmlp_ln_b = (const float*)d_in[7]; a.gmlp_w_s = (const float*)d_in[8]; a.gmlp_b_s = (const float*)d_in[9];
    a.w_branch = (const float*)d_in[10]; a.w_out = (const float*)d_in[11]; a.ln1_g = (const float*)d_in[12]; a.ln1_b = (const float*)d_in[13]; a.w_ff1 = (const float*)d_in[14];
    a.w_ff2 = (const float*)d_in[15]; a.ln2_g = (const float*)d_in[16]; a.ln2_b = (const float*)d_in[17]; a.out = (float*)d_out; a.ws = (unsigned char*)d_ws;
#if MK_PER_PHASE
    for (int ph = 0; ph < N_PHASES; ++ph) { a.ph_lo = ph; a.ph_hi = ph + 1; hipLaunchKernelGGL(fwd_mega, dim3(grid), dim3(NTHREADS), LDS_BYTES, stream, a); }
#else
    a.ph_lo = 0; a.ph_hi = N_PHASES;
    void* args[] = {&a};
    hipError_t e = hipLaunchCooperativeKernel((const void*)fwd_mega, dim3(grid), dim3(NTHREADS), args, LDS_BYTES, stream);
    if (e != hipSuccess) fprintf(stderr, "kernel_launch: cooperative launch failed: %s (grid %d)\n", hipGetErrorString(e), grid);
#endif
}
```

```cpp
#include <hip/hip_runtime.h>
#include <hip/hip_cooperative_groups.h>
#include <cstdio>
#include <cstdint>
namespace cg = cooperative_groups;

#define LAS __attribute__((address_space(3)))
typedef unsigned short bf16_t;
typedef short bf16x8 __attribute__((ext_vector_type(8)));
typedef short s16x4 __attribute__((ext_vector_type(4)));
typedef float f32x4 __attribute__((ext_vector_type(4)));
typedef float f32x2 __attribute__((ext_vector_type(2)));
typedef unsigned u32x4 __attribute__((ext_vector_type(4)));
typedef unsigned u32x2 __attribute__((ext_vector_type(2)));

constexpr int BATCH = 2, SEQ = 8192, M = BATCH * SEQ, D = 1024, DEPTH = 4, FF = 4096;
constexpr int IN_COLS = 7696, NP = 7936, C_LR = 7680;
constexpr int C_GQ = 0, C_GK = 512, C_GV = 1024, C_GG = 1536, C_GZU = 2048, C_GZV = 2560, C_MQ = 3072, C_MK = 3584, C_MV = 4096, C_GL = 4608;
constexpr int NWAVES = 8, NTHREADS = 512;
constexpr int LDS_BYTES = 147456;
constexpr float LN_EPS = 1e-5f, RMS_EPS = 1e-6f;
constexpr int PH_PER_LAYER = 11, N_PHASES = DEPTH * PH_PER_LAYER;

constexpr size_t MiB = 1u << 20;
constexpr size_t WS_WIN = 0, WS_GLR = 15 * MiB, WS_WBR = 16 * MiB, WS_WOUT = 19 * MiB, WS_W1 = 21 * MiB, WS_W2 = 29 * MiB;
constexpr size_t WS_XBF = 38 * MiB;
constexpr size_t WS_BR = 70 * MiB;
constexpr size_t WS_ST = 118 * MiB;
constexpr size_t WS_DEC = 150 * MiB;
constexpr size_t WS_KMEAN = WS_DEC + 512 * 1024;
constexpr size_t WS_VT = 151 * MiB;
constexpr size_t WS_MERGED = 167 * MiB;
constexpr size_t WS_PROJ = 200 * MiB;
constexpr size_t WS_END = 448 * MiB;

typedef __bf16 bf16x2_t __attribute__((ext_vector_type(2)));
__device__ __forceinline__ unsigned cvt_pk_bf16(float lo, float hi) { const f32x2 v = {lo, hi}; const bf16x2_t b = __builtin_convertvector(v, bf16x2_t); return __builtin_bit_cast(unsigned, b); }
__device__ __forceinline__ float bf2f(unsigned h) { return __builtin_bit_cast(float, h << 16); }
__device__ __forceinline__ float bflo(unsigned w) { return __builtin_bit_cast(float, w << 16); }
__device__ __forceinline__ float bfhi(unsigned w) { return __builtin_bit_cast(float, w & 0xffff0000u); }
__device__ __forceinline__ int otid() { int t = threadIdx.x; asm volatile("" : "+v"(t)); return t; }
__device__ __forceinline__ f32x4 mfma16(bf16x8 a, bf16x8 b, f32x4 c) { return __builtin_amdgcn_mfma_f32_16x16x32_bf16(a, b, c, 0, 0, 0); }

namespace pg8 {
constexpr int BM = 256, BK = 64, HALF = 128, HTB = HALF * BK * 2, NXCD = 8, WGM = 8;
__host__ __device__ __forceinline__ int lds_byte(int r, int c) { const int st = (r >> 4) * 2 + (c >> 5), rr = r & 15, cc = c & 31, ob = rr * 64 + cc * 2; return st * 1024 + (ob ^ (((ob >> 9) & 1) << 5)); }
__host__ __device__ __forceinline__ void stage_rc(int b, int& R, int& C) { const int st = b / 1024, sb = b % 1024, swz = sb ^ (((sb >> 9) & 1) << 5); R = (st >> 1) * 16 + swz / 64; C = (st & 1) * 32 + (swz % 64) / 2; }
__host__ __device__ __forceinline__ int perm32(int rho) { const int n = rho >> 4, i = rho & 15; return 8 * (i >> 2) + 4 * n + (i & 3); }

struct Unit { int pm, pn; };
struct Gemm { const bf16_t* A; const bf16_t* Bt; int M, N, K, lda; };

struct StaticOrder {
    int nM, nN, nwg, G, c;
    __device__ void init(int M_, int N_, int G_, int c_) { nM = M_ / BM; nN = N_ / BM; nwg = nM * nN; G = G_; c = c_; }
    __device__ bool next(int i, Unit& u) const {
        const long L = (long)i * G + c; if (L >= nwg) return false;
        int wgid = (int)L; { const int q = nwg / NXCD, r = nwg % NXCD, xcd = wgid % NXCD, off = wgid / NXCD; wgid = (xcd < r ? xcd * (q + 1) : r * (q + 1) + (xcd - r) * q) + off; }
        const int nig = WGM * nN, gid = wgid / nig, fm = gid * WGM, gsz = (nM - fm) < WGM ? (nM - fm) : WGM;
        u.pm = fm + ((wgid % nig) % gsz); u.pn = (wgid % nig) / gsz; return true;
    }
};
struct MergeOrder {
    int G, c;
    __device__ bool next(int i, Unit& u) const { const int t = (i / 3) * G + c; if (t >= 256) return false; const int br = i % 3; u.pm = br * 64 + (t >> 2); u.pn = br * 4 + (t & 3); return true; }
};

template <int ACT  > struct EpiStore {
    bf16_t* O; int ldc;
    __device__ __forceinline__ void operator()(const f32x4 (&acc)[2][2][4][2], const Unit& u, int wr, int wc, int fr, int fq) const {
        const int row0 = u.pm * BM + wr * 64 + fr, col0 = u.pn * BM + wc * 32 + 8 * fq;
#pragma unroll
        for (int ai = 0; ai < 2; ++ai)
#pragma unroll
            for (int m = 0; m < 4; ++m) { bf16_t* rowp = O + (size_t)(row0 + ai * HALF + m * 16) * ldc + col0;
#pragma unroll
                for (int bj = 0; bj < 2; ++bj) { f32x4 v0 = acc[ai][bj][m][0], v1 = acc[ai][bj][m][1];
                    if (ACT == 2) {
#pragma unroll
                        for (int e = 0; e < 4; ++e) { float a = fmaxf(v0[e], 0.f), b = fmaxf(v1[e], 0.f); v0[e] = a * a; v1[e] = b * b; } }
                    u32x4 w; w.x = cvt_pk_bf16(v0[0], v0[1]); w.y = cvt_pk_bf16(v0[2], v0[3]); w.z = cvt_pk_bf16(v1[0], v1[1]); w.w = cvt_pk_bf16(v1[2], v1[3]);
                    *(u32x4*)(rowp + bj * HALF) = w; } }
    }
};
struct EpiResid {
    const float* R; float* O; float alpha;
    __device__ __forceinline__ void operator()(const f32x4 (&acc)[2][2][4][2], const Unit& u, int wr, int wc, int fr, int fq) const {
        const int row0 = u.pm * BM + wr * 64 + fr, col0 = u.pn * BM + wc * 32 + 8 * fq;
#pragma unroll
        for (int ai = 0; ai < 2; ++ai)
#pragma unroll
            for (int m = 0; m < 4; ++m) { const size_t off = (size_t)(row0 + ai * HALF + m * 16) * 1024 + col0;
#pragma unroll
                for (int bj = 0; bj < 2; ++bj) { const f32x4 r0 = *(const f32x4*)(R + off + bj * HALF), r1 = *(const f32x4*)(R + off + bj * HALF + 4);
                    *(f32x4*)(O + off + bj * HALF) = r0 * alpha + acc[ai][bj][m][0]; *(f32x4*)(O + off + bj * HALF + 4) = r1 * alpha + acc[ai][bj][m][1]; } }
    }
};
struct EpiMerge {
    const bf16_t* proj; float* stash; bf16_t* merged;
    __device__ __forceinline__ void operator()(const f32x4 (&acc)[2][2][4][2], const Unit& u, int wr, int wc, int fr, int fq) const {
        const int br = u.pm >> 6, tm = u.pm & 63, tn = u.pn & 3;
        const int row0 = tm * BM + wr * 64 + fr, col0 = tn * BM + wc * 32 + 8 * fq;
#pragma unroll
        for (int ai = 0; ai < 2; ++ai)
#pragma unroll
            for (int m = 0; m < 4; ++m) { const int row = row0 + ai * HALF + m * 16;
#pragma unroll
                for (int bj = 0; bj < 2; ++bj) { const int col = col0 + bj * HALF;
                    const u32x4 gw = *(const u32x4*)(proj + (size_t)row * NP + C_GL + br * 1024 + col);
                    float g[8] = {bflo(gw.x), bfhi(gw.x), bflo(gw.y), bfhi(gw.y), bflo(gw.z), bfhi(gw.z), bflo(gw.w), bfhi(gw.w)};
                    f32x4 v0, v1;
#pragma unroll
                    for (int e = 0; e < 4; ++e) { v0[e] = acc[ai][bj][m][0][e] / (1.f + __expf(-g[e])); v1[e] = acc[ai][bj][m][1][e] / (1.f + __expf(-g[4 + e])); }
                    float* sp = stash + (size_t)row * (NP / 2) + col;
                    if (br == 0) { *(f32x4*)sp = v0; *(f32x4*)(sp + 4) = v1; }
                    else { v0 += *(const f32x4*)sp; v1 += *(const f32x4*)(sp + 4);
                        if (br == 1) { *(f32x4*)sp = v0; *(f32x4*)(sp + 4) = v1; }
                        else { u32x4 w; w.x = cvt_pk_bf16(v0[0], v0[1]); w.y = cvt_pk_bf16(v0[2], v0[3]); w.z = cvt_pk_bf16(v1[0], v1[1]); w.w = cvt_pk_bf16(v1[2], v1[3]);
                            *(u32x4*)(merged + (size_t)row * 1024 + col) = w; } } } }
    }
};

template <class Epi, class Sched>
__device__ __forceinline__ void gemm_phase(LAS unsigned char* lds, const Gemm g, const Sched& S, const Epi& E) {
    const int tid = otid(), wid = __builtin_amdgcn_readfirstlane(tid >> 6), lane = tid & 63, wr = wid >> 2, wc = wid & 3, fr = lane & 15, fq = lane >> 4;
    const int K = g.K, nt = K / BK, lda = g.lda;
    unsigned voffA[2], voffB[2];
#pragma unroll
    for (int i = 0; i < 2; ++i) { int R, C; stage_rc(tid * 16 + i * 8192, R, C); const int Rb = (R & ~31) + perm32(R & 31);
        voffA[i] = (unsigned)(R * lda + C) * 2u; voffB[i] = (unsigned)(Rb * K + C) * 2u; }
    const size_t kstep = (size_t)(BK * 2);
    const size_t hstepA = (size_t)HALF * lda * 2, hstepB = (size_t)HALF * K * 2;
    const size_t tstepA = 2 * hstepA, tstepB = 2 * hstepB;
    const unsigned ldsw = (unsigned)wid * 1024u;
    const int aoff = lds_byte(wr * 64 + fr, fq * 8), boff = lds_byte(wc * 32 + fr, fq * 8);
#define PG8_SA(b, h) (((b) * 2 + (h)) * HTB)
#define PG8_SB(b, h) ((4 + (b) * 2 + (h)) * HTB)
#define PG8_STAGE(bufoff, gbase, voff) do { _Pragma("unroll") for (int _i = 0; _i < 2; ++_i) \
        __builtin_amdgcn_global_load_lds((const unsigned*)((const char*)(gbase) + (voff)[_i]), (LAS unsigned*)(lds + (bufoff) + ldsw + _i * 8192), 16, 0, 0); } while (0)
#define PG8_LDA(dst, b, h) do { _Pragma("unroll") for (int m = 0; m < 4; ++m) _Pragma("unroll") for (int k = 0; k < 2; ++k) dst[m][k] = *(const LAS bf16x8*)(lds + PG8_SA(b, h) + aoff + m * 2048 + k * 1024); } while (0)
#define PG8_LDB(dst, b, h) do { _Pragma("unroll") for (int n = 0; n < 2; ++n) _Pragma("unroll") for (int k = 0; k < 2; ++k) dst[n][k] = *(const LAS bf16x8*)(lds + PG8_SB(b, h) + boff + n * 2048 + k * 1024); } while (0)
#define PG8_MMA(ai, bj, At, Bt) do { __builtin_amdgcn_s_setprio(1); _Pragma("unroll") for (int m = 0; m < 4; ++m) _Pragma("unroll") for (int n = 0; n < 2; ++n) _Pragma("unroll") for (int k = 0; k < 2; ++k) \
        acc[ai][bj][m][n] = __builtin_amdgcn_mfma_f32_16x16x32_bf16(Bt[n][k], At[m][k], acc[ai][bj][m][n], 0, 0, 0); __builtin_amdgcn_s_setprio(0); } while (0)
#define PG8_WAIT_V(n) asm volatile("s_waitcnt vmcnt(" #n ")" ::: "memory")
#define PG8_WAIT_L(n) asm volatile("s_waitcnt lgkmcnt(" #n ")" ::: "memory")
#define PG8_BAR __builtin_amdgcn_s_barrier()
#define PG8_SCHED __builtin_amdgcn_sched_barrier(0)
    Unit cur, nxt; int ui = 0;
    if (!S.next(0, cur)) return;
    f32x4 acc[2][2][4][2];
#pragma unroll
    for (int a = 0; a < 2; ++a)
#pragma unroll
        for (int b = 0; b < 2; ++b)
#pragma unroll
            for (int m = 0; m < 4; ++m)
#pragma unroll
                for (int n = 0; n < 2; ++n) acc[a][b][m][n] = (f32x4){0.f, 0.f, 0.f, 0.f};
    bf16x8 At[4][2], B0[2][2], B1[2][2];
    const char* cA = (const char*)g.A + (size_t)cur.pm * tstepA; const char* cB = (const char*)g.Bt + (size_t)cur.pn * tstepB;
    PG8_STAGE(PG8_SB(0, 0), cB, voffB); PG8_STAGE(PG8_SB(0, 1), cB + hstepB, voffB); PG8_STAGE(PG8_SA(0, 0), cA, voffA); PG8_STAGE(PG8_SA(0, 1), cA + hstepA, voffA);
    if (wr == 1) PG8_BAR;
    PG8_WAIT_V(2); PG8_BAR;
    PG8_STAGE(PG8_SB(1, 0), cB + kstep, voffB); PG8_STAGE(PG8_SA(1, 0), cA + kstep, voffA); PG8_STAGE(PG8_SB(1, 1), cB + hstepB + kstep, voffB);
    PG8_WAIT_V(6); PG8_BAR;
    for (;;) {
        const bool has_next = S.next(ui + 1, nxt);
        const char* nA = has_next ? (const char*)g.A + (size_t)nxt.pm * tstepA : cA; const char* nB = has_next ? (const char*)g.Bt + (size_t)nxt.pn * tstepB : cB;
        for (int t = 0; t < nt; t += 2) {
            const bool last = (t == nt - 2);
            const char* a1 = cA + (size_t)(t + 1) * kstep;
            const char* a2 = last ? nA : cA + (size_t)(t + 2) * kstep; const char* b2 = last ? nB : cB + (size_t)(t + 2) * kstep;
            const char* a3 = a2 + kstep; const char* b3 = b2 + kstep;
            PG8_LDB(B0, 0, 0); PG8_LDB(B1, 0, 1); PG8_SCHED; PG8_LDA(At, 0, 0); PG8_STAGE(PG8_SA(1, 1), a1 + hstepA, voffA);
            PG8_WAIT_V(8); PG8_WAIT_L(0); PG8_BAR; PG8_MMA(0, 0, At, B0); PG8_MMA(0, 1, At, B1); PG8_BAR; PG8_SCHED;
            PG8_LDA(At, 0, 1); PG8_STAGE(PG8_SB(0, 0), b2, voffB); PG8_STAGE(PG8_SB(0, 1), b2 + hstepB, voffB); PG8_STAGE(PG8_SA(0, 0), a2, voffA);
            PG8_WAIT_V(8); PG8_WAIT_L(0); PG8_BAR; PG8_MMA(1, 0, At, B0); PG8_MMA(1, 1, At, B1); PG8_BAR; PG8_SCHED;
            PG8_LDB(B0, 1, 0); PG8_LDB(B1, 1, 1); PG8_SCHED; PG8_LDA(At, 1, 0); PG8_STAGE(PG8_SA(0, 1), a2 + hstepA, voffA);
            PG8_WAIT_V(8); PG8_WAIT_L(0); PG8_BAR; PG8_MMA(0, 0, At, B0); PG8_MMA(0, 1, At, B1); PG8_BAR; PG8_SCHED;
            PG8_LDA(At, 1, 1); PG8_STAGE(PG8_SB(1, 0), b3, voffB); PG8_STAGE(PG8_SB(1, 1), b3 + hstepB, voffB); PG8_STAGE(PG8_SA(1, 0), a3, voffA);
            PG8_WAIT_V(8); PG8_WAIT_L(0); PG8_BAR; PG8_MMA(1, 0, At, B0); PG8_MMA(1, 1, At, B1); PG8_BAR; PG8_SCHED;
        }
        if (wr == 0) PG8_BAR;
        E(acc, cur, wr, wc, fr, fq);
        if (!has_next) break;
#pragma unroll
        for (int a = 0; a < 2; ++a)
#pragma unroll
            for (int b = 0; b < 2; ++b)
#pragma unroll
                for (int m = 0; m < 4; ++m)
#pragma unroll
                    for (int n = 0; n < 2; ++n) acc[a][b][m][n] = (f32x4){0.f, 0.f, 0.f, 0.f};
        cur = nxt; cA = nA; cB = nB; ++ui;
        if (wr == 1) PG8_BAR;
    }
    PG8_WAIT_V(0);
    PG8_BAR;
#undef PG8_SA
#undef PG8_SB
#undef PG8_STAGE
#undef PG8_LDA
#undef PG8_LDB
#undef PG8_MMA
#undef PG8_WAIT_V
#undef PG8_WAIT_L
#undef PG8_BAR
#undef PG8_SCHED
}
}

struct Args {
    const float* x; const int* pos; const float* w_in; const float* w_gate_up; const float* b_gate; const float* gla_norm_w; const float* gmlp_ln_g; const float* gmlp_ln_b;
    const float* gmlp_w_s; const float* gmlp_b_s; const float* w_branch; const float* w_out; const float* ln1_g; const float* ln1_b; const float* w_ff1; const float* w_ff2;
    const float* ln2_g; const float* ln2_b; float* out; unsigned char* ws; int ph_lo, ph_hi;
};

__device__ __forceinline__ float wave_sum(float v) {
#pragma unroll
    for (int o = 1; o < 64; o <<= 1) v += __shfl_xor(v, o);
    return v;
}

__device__ __forceinline__ void transpose_item(const float* W, int ldw, int col0, int K, int nblk, bf16_t* WT, int row_off, LAS float* scr, int item, int lane) {
    const int kb = item / nblk, nb = item % nblk, k0 = 64 * kb, n0 = 32 * nb;
#pragma unroll 8
    for (int i = 0; i < 32; ++i) { const int kk = 2 * i + (lane >> 5); scr[kk * 33 + (lane & 31)] = W[(size_t)(k0 + kk) * ldw + col0 + n0 + (lane & 31)]; }
    asm volatile("s_waitcnt lgkmcnt(0)" ::: "memory");
    const int c = lane & 7;
#pragma unroll
    for (int j = 0; j < 4; ++j) { const int n = (lane >> 3) + 8 * j; const LAS float* s = scr + (8 * c) * 33 + n;
        u32x4 o; o.x = cvt_pk_bf16(s[0 * 33], s[1 * 33]); o.y = cvt_pk_bf16(s[2 * 33], s[3 * 33]); o.z = cvt_pk_bf16(s[4 * 33], s[5 * 33]); o.w = cvt_pk_bf16(s[6 * 33], s[7 * 33]);
        *(u32x4*)(WT + (size_t)(row_off + n0 + n) * K + k0 + 8 * c) = o; }
    asm volatile("s_waitcnt lgkmcnt(0)" ::: "memory");
}

__device__ __forceinline__ void phase_prep(const Args& a, int l, LAS unsigned char* lds, int G) {
    const int tid = otid(), lane = tid & 63, wave = tid >> 6;
    LAS float* scr = (LAS float*)(lds + wave * 16384);
    const int gw = blockIdx.x * NWAVES + wave, NGW = G * NWAVES;
    bf16_t* WinT = (bf16_t*)(a.ws + WS_WIN); bf16_t* WbrT = (bf16_t*)(a.ws + WS_WBR); bf16_t* WoutT = (bf16_t*)(a.ws + WS_WOUT); bf16_t* W1T = (bf16_t*)(a.ws + WS_W1); bf16_t* W2T = (bf16_t*)(a.ws + WS_W2);
    const float* win = a.w_in + (size_t)l * D * IN_COLS;
    constexpr int I_IN_A = 16 * 64, I_IN_B = 16 * 176, I_BR = 8 * 32, I_OUT = 16 * 32, I_1 = 16 * 128, I_2 = 64 * 32;
    constexpr int NITEMS = I_IN_A + I_IN_B + 3 * I_BR + I_OUT + I_1 + I_2;
    for (int it = gw; it < NITEMS; it += NGW) {
        int r = it;
        if (r < I_IN_A) { transpose_item(win, IN_COLS, 0, D, 64, WinT, 0, scr, r, lane); continue; } r -= I_IN_A;
        if (r < I_IN_B) { transpose_item(win, IN_COLS, 2064, D, 176, WinT, 2048, scr, r, lane); continue; } r -= I_IN_B;
        if (r < 3 * I_BR) { const int br = r / I_BR; transpose_item(a.w_branch + ((size_t)l * 3 + br) * 512 * 1024, 1024, 0, 512, 32, WbrT, br * 1024, scr, r % I_BR, lane); continue; } r -= 3 * I_BR;
        if (r < I_OUT) { transpose_item(a.w_out + (size_t)l * D * D, D, 0, D, 32, WoutT, 0, scr, r, lane); continue; } r -= I_OUT;
        if (r < I_1) { transpose_item(a.w_ff1 + (size_t)l * D * FF, FF, 0, D, 128, W1T, 0, scr, r, lane); continue; } r -= I_1;
        transpose_item(a.w_ff2 + (size_t)l * FF * D, D, 0, FF, 32, W2T, 0, scr, r, lane);
    }
    { bf16_t* glrT = (bf16_t*)(a.ws + WS_GLR);
      for (int e = blockIdx.x * NTHREADS + tid; e < 16 * 1024; e += G * NTHREADS) { const int n = e >> 10, k = e & 1023; glrT[e] = (bf16_t)(cvt_pk_bf16(win[(size_t)k * IN_COLS + 2048 + n], 0.f) & 0xffffu); } }
    if (l == 0) {
        bf16_t* xbf = (bf16_t*)(a.ws + WS_XBF);
        for (size_t e = (size_t)(blockIdx.x * NTHREADS + tid) * 8; e < (size_t)M * D; e += (size_t)G * NTHREADS * 8) {
            const f32x4 v0 = *(const f32x4*)(a.x + e), v1 = *(const f32x4*)(a.x + e + 4);
            u32x4 w; w.x = cvt_pk_bf16(v0[0], v0[1]); w.y = cvt_pk_bf16(v0[2], v0[3]); w.z = cvt_pk_bf16(v1[0], v1[1]); w.w = cvt_pk_bf16(v1[2], v1[3]);
            *(u32x4*)(xbf + e) = w; }
    }
}

__device__ __forceinline__ void gla_bcum(const Args& a, int l, LAS unsigned char* lds, int m0, int h, float (&c)[16], float& bend) {
    const int tid = otid(), lane = tid & 63, wave = tid >> 6, fr = lane & 15, fq = lane >> 4;
    LAS float* lr = (LAS float*)lds; LAS float* tot = (LAS float*)(lds + 4352);
    const bf16_t* xbf = (const bf16_t*)(a.ws + WS_XBF); const bf16_t* glrT = (const bf16_t*)(a.ws + WS_GLR);
    if (tid < 128) {
        const int s = tid >> 1, hf = tid & 1;
        const u32x4 w = *(const u32x4*)((const bf16_t*)(a.ws + WS_PROJ) + (size_t)(m0 + s) * NP + C_LR + hf * 8);
        LAS float* lp = lr + s * 17 + hf * 8;
        lp[0] = bflo(w.x); lp[1] = bfhi(w.x); lp[2] = bflo(w.y); lp[3] = bfhi(w.y); lp[4] = bflo(w.z); lp[5] = bfhi(w.z); lp[6] = bflo(w.w); lp[7] = bfhi(w.w);
    }
    __syncthreads();
    const int d = tid & 127, g = tid >> 7, col = h * 128 + d;
    float wu[16];
#pragma unroll
    for (int r = 0; r < 16; ++r) wu[r] = a.w_gate_up[((size_t)l * 16 + r) * 512 + col];
    const float bg = a.b_gate[(size_t)l * 512 + col];
    float run = 0.f;
#pragma unroll
    for (int i = 0; i < 16; ++i) { const int s = g * 16 + i; float z = bg;
#pragma unroll
        for (int r = 0; r < 16; ++r) z += lr[s * 17 + r] * wu[r];
        const float la = (fminf(z, 0.f) - log1pf(__expf(-fabsf(z)))) * (1.f / 16.f);
        run += la; c[i] = run; }
    tot[g * 128 + d] = run;
    __syncthreads();
    float pre = 0.f, all = 0.f;
#pragma unroll
    for (int gg = 0; gg < 4; ++gg) { const float t = tot[gg * 128 + d]; all += t; if (gg < g) pre += t; }
#pragma unroll
    for (int i = 0; i < 16; ++i) c[i] += pre;
    bend = all;
}

__device__ __forceinline__ void gla_kv_unit(const Args& a, int l, LAS unsigned char* lds, int unit) {
    const int h = unit & 3, n = (unit >> 2) & 127, b = unit >> 9, m0 = b * SEQ + n * 64;
    const int tid = otid(), lane = tid & 63, wave = tid >> 6, fr = lane & 15, fq = lane >> 4;
    const bf16_t* proj = (const bf16_t*)(a.ws + WS_PROJ);
    float c[16], bend; gla_bcum(a, l, lds, m0, h, c, bend);
    const int d = tid & 127, g = tid >> 7, col = h * 128 + d;
    LAS unsigned char* keT = lds + 8192; LAS unsigned char* vT = lds + 8192 + 128 * 144;
    unsigned kw[8], vw[8];
#pragma unroll
    for (int i = 0; i < 16; i += 2) { const size_t r0 = (size_t)(m0 + g * 16 + i) * NP, r1 = r0 + NP;
        const float k0 = bf2f(proj[r0 + C_GK + col]) * __expf(bend - c[i]), k1 = bf2f(proj[r1 + C_GK + col]) * __expf(bend - c[i + 1]);
        kw[i >> 1] = cvt_pk_bf16(k0, k1); vw[i >> 1] = (unsigned)proj[r0 + C_GV + col] | ((unsigned)proj[r1 + C_GV + col] << 16); }
    *(LAS u32x4*)(keT + d * 144 + g * 32) = (u32x4){kw[0], kw[1], kw[2], kw[3]}; *(LAS u32x4*)(keT + d * 144 + g * 32 + 16) = (u32x4){kw[4], kw[5], kw[6], kw[7]};
    *(LAS u32x4*)(vT + d * 144 + g * 32) = (u32x4){vw[0], vw[1], vw[2], vw[3]}; *(LAS u32x4*)(vT + d * 144 + g * 32 + 16) = (u32x4){vw[4], vw[5], vw[6], vw[7]};
    const int bh = b * 4 + h;
    if (g == 0) ((float*)(a.ws + WS_DEC))[((size_t)bh * 128 + n) * 128 + d] = __expf(bend);
    __syncthreads();
    bf16_t* ST = (bf16_t*)(a.ws + WS_ST) + ((size_t)bh * 128 + n) * 16384;
    bf16x8 af[2];
#pragma unroll
    for (int kk = 0; kk < 2; ++kk) af[kk] = *(const LAS bf16x8*)(keT + (wave * 16 + fr) * 144 + kk * 64 + fq * 16);
#pragma unroll
    for (int dvt = 0; dvt < 8; ++dvt) { f32x4 acc = {0.f, 0.f, 0.f, 0.f};
#pragma unroll
        for (int kk = 0; kk < 2; ++kk) { const bf16x8 bv = *(const LAS bf16x8*)(vT + (dvt * 16 + fr) * 144 + kk * 64 + fq * 16); acc = mfma16(af[kk], bv, acc); }
        u32x2 w; w.x = cvt_pk_bf16(acc[0], acc[1]); w.y = cvt_pk_bf16(acc[2], acc[3]);
        *(u32x2*)(ST + (size_t)(dvt * 16 + fr) * 128 + wave * 16 + 4 * fq) = w; }
    __syncthreads();
}

__device__ __forceinline__ void gla_scan(const Args& a, int G) {
    const int tid = otid();
    for (int e = blockIdx.x * NTHREADS + tid; e < 8 * 128 * 64; e += G * NTHREADS) {
        const int dkp = e & 63, dv = (e >> 6) & 127, bh = e >> 13;
        unsigned* st = (unsigned*)(a.ws + WS_ST) + ((size_t)bh * 128 * 16384 + (size_t)dv * 128) / 2 + dkp;
        const f32x2* dec = (const f32x2*)(a.ws + WS_DEC) + ((size_t)bh * 128 * 128) / 2 + dkp;
        float s0 = 0.f, s1 = 0.f;
#pragma unroll 8
        for (int n = 0; n < 128; ++n) { const unsigned kv = st[(size_t)n * 8192]; const f32x2 dc = dec[n * 64];
            st[(size_t)n * 8192] = cvt_pk_bf16(s0, s1);
            s0 = dc.x * s0 + bflo(kv); s1 = dc.y * s1 + bfhi(kv); }
    }
}

__device__ __forceinline__ void gla_out_unit(const Args& a, int l, LAS unsigned char* lds, int unit) {
    const int h = unit & 3, n = (unit >> 2) & 127, b = unit >> 9, m0 = b * SEQ + n * 64;
    const int tid = otid(), lane = tid & 63, wave = tid >> 6, fr = lane & 15, fq = lane >> 4;
    const bf16_t* proj = (const bf16_t*)(a.ws + WS_PROJ);
    float c[16], bend; gla_bcum(a, l, lds, m0, h, c, bend);
    const int d = tid & 127, g = tid >> 7, col = h * 128 + d;
    LAS unsigned char* qd = lds + 8192;
    LAS unsigned char* ki = qd + 64 * 272;
    LAS unsigned char* vT = ki + 64 * 272;
    LAS unsigned char* at = vT + 128 * 144;
    LAS float* ssq = (LAS float*)(at + 64 * 144);
    unsigned vw[8];
#pragma unroll
    for (int i = 0; i < 16; i += 2) { const size_t r0 = (size_t)(m0 + g * 16 + i) * NP, r1 = r0 + NP;
        const float e0 = __expf(c[i]), e1 = __expf(c[i + 1]);
        const float q0 = bf2f(proj[r0 + C_GQ + col]) * e0, q1 = bf2f(proj[r1 + C_GQ + col]) * e1;
        const float k0 = bf2f(proj[r0 + C_GK + col]) * 0.08838834764831845f / e0, k1 = bf2f(proj[r1 + C_GK + col]) * 0.08838834764831845f / e1;
        *(LAS bf16_t*)(qd + (g * 16 + i) * 272 + d * 2) = (bf16_t)(cvt_pk_bf16(q0, 0.f) & 0xffffu); *(LAS bf16_t*)(qd + (g * 16 + i + 1) * 272 + d * 2) = (bf16_t)(cvt_pk_bf16(q1, 0.f) & 0xffffu);
        *(LAS bf16_t*)(ki + (g * 16 + i) * 272 + d * 2) = (bf16_t)(cvt_pk_bf16(k0, 0.f) & 0xffffu); *(LAS bf16_t*)(ki + (g * 16 + i + 1) * 272 + d * 2) = (bf16_t)(cvt_pk_bf16(k1, 0.f) & 0xffffu);
        vw[i >> 1] = (unsigned)proj[r0 + C_GV + col] | ((unsigned)proj[r1 + C_GV + col] << 16); }
    *(LAS u32x4*)(vT + d * 144 + g * 32) = (u32x4){vw[0], vw[1], vw[2], vw[3]}; *(LAS u32x4*)(vT + d * 144 + g * 32 + 16) = (u32x4){vw[4], vw[5], vw[6], vw[7]};
    __syncthreads();
    { const int tt = wave >> 1;
      bf16x8 qf[4];
#pragma unroll
      for (int kk = 0; kk < 4; ++kk) qf[kk] = *(const LAS bf16x8*)(qd + (tt * 16 + fr) * 272 + kk * 64 + fq * 16);
#pragma unroll
      for (int s2 = 0; s2 < 2; ++s2) { const int stl = (wave & 1) * 2 + s2; f32x4 acc = {0.f, 0.f, 0.f, 0.f};
#pragma unroll
          for (int kk = 0; kk < 4; ++kk) { const bf16x8 kf = *(const LAS bf16x8*)(ki + (stl * 16 + fr) * 272 + kk * 64 + fq * 16); acc = mfma16(kf, qf[kk], acc); }
          const int t = tt * 16 + fr, s0 = stl * 16 + 4 * fq;
#pragma unroll
          for (int jj = 0; jj < 4; ++jj) if (s0 + jj > t) acc[jj] = 0.f;
          u32x2 w; w.x = cvt_pk_bf16(acc[0], acc[1]); w.y = cvt_pk_bf16(acc[2], acc[3]);
          *(LAS u32x2*)(at + t * 144 + s0 * 2) = w; } }
    __syncthreads();
    const int tt = wave & 3, dvh = wave >> 2, bh = b * 4 + h;
    const bf16_t* ST = (const bf16_t*)(a.ws + WS_ST) + ((size_t)bh * 128 + n) * 16384;
    bf16x8 atf[2], qf[4];
#pragma unroll
    for (int kk = 0; kk < 2; ++kk) atf[kk] = *(const LAS bf16x8*)(at + (tt * 16 + fr) * 144 + kk * 64 + fq * 16);
#pragma unroll
    for (int kk = 0; kk < 4; ++kk) qf[kk] = *(const LAS bf16x8*)(qd + (tt * 16 + fr) * 272 + kk * 64 + fq * 16);
    f32x4 o[4]; float sq = 0.f;
#pragma unroll
    for (int j = 0; j < 4; ++j) { const int dvt = dvh * 4 + j; f32x4 acc = {0.f, 0.f, 0.f, 0.f};
#pragma unroll
        for (int kk = 0; kk < 2; ++kk) { const bf16x8 vf = *(const LAS bf16x8*)(vT + (dvt * 16 + fr) * 144 + kk * 64 + fq * 16); acc = mfma16(vf, atf[kk], acc); }
        f32x4 acs = {0.f, 0.f, 0.f, 0.f};
#pragma unroll
        for (int kk = 0; kk < 4; ++kk) { const bf16x8 sf = *(const bf16x8*)(ST + (size_t)(dvt * 16 + fr) * 128 + kk * 32 + fq * 8); acs = mfma16(sf, qf[kk], acs); }
        acc += acs * 0.08838834764831845f;
        o[j] = acc; sq += acc[0] * acc[0] + acc[1] * acc[1] + acc[2] * acc[2] + acc[3] * acc[3]; }
    sq += __shfl_xor(sq, 16); sq += __shfl_xor(sq, 32);
    if (fq == 0) ssq[dvh * 64 + tt * 16 + fr] = sq;
    __syncthreads();
    const float rs = 1.f / sqrtf((ssq[tt * 16 + fr] + ssq[64 + tt * 16 + fr]) * (1.f / 128.f) + RMS_EPS);
    const int m = m0 + tt * 16 + fr;
    bf16_t* br0 = (bf16_t*)(a.ws + WS_BR);
#pragma unroll
    for (int j = 0; j < 4; ++j) { const int dv = (dvh * 4 + j) * 16 + 4 * fq;
        const f32x4 nw = *(const f32x4*)(a.gla_norm_w + (size_t)l * 128 + dv);
        const u32x2 gw = *(const u32x2*)(proj + (size_t)m * NP + C_GG + h * 128 + dv);
        const float gg[4] = {bflo(gw.x), bfhi(gw.x), bflo(gw.y), bfhi(gw.y)}; float r[4];
#pragma unroll
        for (int e = 0; e < 4; ++e) r[e] = o[j][e] * rs * nw[e] * (gg[e] / (1.f + __expf(-gg[e])));
        u32x2 w; w.x = cvt_pk_bf16(r[0], r[1]); w.y = cvt_pk_bf16(r[2], r[3]);
        *(u32x2*)(br0 + (size_t)m * 512 + h * 128 + dv) = w; }
    __syncthreads();
}

__device__ __forceinline__ float gelu_erf(float v) {
    const float av = fabsf(v), t = __builtin_amdgcn_rcpf(av * 0.2316418882f + 1.0f);
    float q = t * 0.5307027145f + (-0.7265760135f); q = q * t + 0.7107068705f; q = q * t + (-0.142248368f); q = q * t + 0.127414796f; q = q * t;
    const float e = __builtin_amdgcn_exp2f((v * v) * (-0.72134752044f));
    const float m = v * (q * e);
    return v < 0.f ? m : v - m;
}
__device__ __forceinline__ void gmlp_unit(const Args& a, int l, LAS unsigned char* lds, int unit) {
    const int g = unit & 3, nc = (unit >> 2) & 63, b = unit >> 8, m0 = b * SEQ + nc * 128;
    const int tid = otid(), lane = tid & 63, wave = tid >> 6, fr = lane & 15, fq = lane >> 4;
    const bf16_t* proj = (const bf16_t*)(a.ws + WS_PROJ);
    LAS float* stats = (LAS float*)lds;
    LAS unsigned char* vnT = lds + 1024;
    LAS unsigned char* wm = vnT + 128 * 272;
    { const int tok = tid >> 2, part = tid & 3; const bf16_t* vp = proj + (size_t)(m0 + tok) * NP + C_GZV + part * 128;
      float s = 0.f, s2 = 0.f;
#pragma unroll 4
      for (int j = 0; j < 16; ++j) { const u32x4 w = *(const u32x4*)(vp + j * 8); const unsigned ww[4] = {w.x, w.y, w.z, w.w};
#pragma unroll
          for (int e = 0; e < 4; ++e) { const float g0 = gelu_erf(bflo(ww[e])), g1 = gelu_erf(bfhi(ww[e])); s += g0 + g1; s2 += g0 * g0 + g1 * g1; } }
      s += __shfl_xor(s, 1); s += __shfl_xor(s, 2); s2 += __shfl_xor(s2, 1); s2 += __shfl_xor(s2, 2);
      const float mean = s * (1.f / 512.f), var = fmaxf(s2 * (1.f / 512.f) - mean * mean, 0.f);
      if (part == 0) { stats[tok * 2] = mean; stats[tok * 2 + 1] = 1.f / sqrtf(var + LN_EPS); } }
    { const int t = tid >> 2, sq4 = (tid & 3) * 32; const float* wp = a.gmlp_w_s + (((size_t)l * 4 + g) * 128 + t) * 128 + sq4;
#pragma unroll
      for (int j = 0; j < 4; ++j) { const f32x4 w0 = *(const f32x4*)(wp + j * 8), w1 = *(const f32x4*)(wp + j * 8 + 4); float v[8] = {w0[0], w0[1], w0[2], w0[3], w1[0], w1[1], w1[2], w1[3]};
#pragma unroll
          for (int e = 0; e < 8; ++e) if (sq4 + j * 8 + e > t) v[e] = 0.f;
          *(LAS u32x4*)(wm + t * 272 + (sq4 + j * 8) * 2) = (u32x4){cvt_pk_bf16(v[0], v[1]), cvt_pk_bf16(v[2], v[3]), cvt_pk_bf16(v[4], v[5]), cvt_pk_bf16(v[6], v[7])}; } }
    __syncthreads();
    { const int cch = tid & 127, sg = tid >> 7; const float lg = a.gmlp_ln_g[(size_t)l * 512 + g * 128 + cch], lb = a.gmlp_ln_b[(size_t)l * 512 + g * 128 + cch];
#pragma unroll
      for (int j = 0; j < 4; ++j) { unsigned w[4];
#pragma unroll
          for (int e = 0; e < 4; ++e) { const int s0 = sg * 32 + j * 8 + e * 2;
              const float v0 = gelu_erf(bf2f(proj[(size_t)(m0 + s0) * NP + C_GZV + g * 128 + cch])), v1 = gelu_erf(bf2f(proj[(size_t)(m0 + s0 + 1) * NP + C_GZV + g * 128 + cch]));
              w[e] = cvt_pk_bf16((v0 - stats[s0 * 2]) * stats[s0 * 2 + 1] * lg + lb, (v1 - stats[s0 * 2 + 2]) * stats[s0 * 2 + 3] * lg + lb); }
          *(LAS u32x4*)(vnT + cch * 272 + (sg * 32 + j * 8) * 2) = (u32x4){w[0], w[1], w[2], w[3]}; } }
    __syncthreads();
    const int nk = ((wave * 16 + 15) >> 5) + 1;
    bf16x8 wf[4];
#pragma unroll
    for (int kk = 0; kk < 4; ++kk) wf[kk] = *(const LAS bf16x8*)(wm + (wave * 16 + fr) * 272 + kk * 64 + fq * 16);
    const int t = wave * 16 + fr, m = m0 + t;
    const float bs = a.gmlp_b_s[((size_t)l * 4 + g) * 128 + t];
    bf16_t* br1 = (bf16_t*)(a.ws + WS_BR) + (size_t)M * 512;
#pragma unroll
    for (int ct = 0; ct < 8; ++ct) { f32x4 acc = {0.f, 0.f, 0.f, 0.f};
#pragma unroll
        for (int kk = 0; kk < 4; ++kk) if (kk < nk) { const bf16x8 vf = *(const LAS bf16x8*)(vnT + (ct * 16 + fr) * 272 + kk * 64 + fq * 16); acc = mfma16(vf, wf[kk], acc); }
        const int cc = g * 128 + ct * 16 + 4 * fq;
        const u32x2 uw = *(const u32x2*)(proj + (size_t)m * NP + C_GZU + cc);
        const float u0 = gelu_erf(bflo(uw.x)), u1 = gelu_erf(bfhi(uw.x)), u2 = gelu_erf(bflo(uw.y)), u3 = gelu_erf(bfhi(uw.y));
        u32x2 w; w.x = cvt_pk_bf16(u0 * (acc[0] + bs), u1 * (acc[1] + bs)); w.y = cvt_pk_bf16(u2 * (acc[2] + bs), u3 * (acc[3] + bs));
        *(u32x2*)(br1 + (size_t)m * 512 + cc) = w; }
    __syncthreads();
}

__device__ __forceinline__ void moba_prep_unit(const Args& a, LAS unsigned char* lds, int unit) {
    const int blk = unit & 31, h = (unit >> 5) & 3, b = unit >> 7, m0 = b * SEQ + blk * 256;
    const int tid = otid();
    bf16_t* proj = (bf16_t*)(a.ws + WS_PROJ);
#pragma unroll 2
    for (int it = 0; it < 8; ++it) { const int item = tid + it * NTHREADS, tok = item >> 4, i = item & 15; const size_t m = (size_t)(m0 + tok);
        const float inv = exp2f(-(float)i * (18.931568569324174f / 16.f));
        const float ang = (float)a.pos[m] * inv; float sn, cs; sincosf(ang, &sn, &cs);
        bf16_t* kp = proj + m * NP + C_MK + h * 128 + i; bf16_t* qp = proj + m * NP + C_MQ + h * 128 + i;
        const float k1 = bf2f(kp[0]), k2 = bf2f(kp[16]), q1 = bf2f(qp[0]), q2 = bf2f(qp[16]);
        const unsigned kw = cvt_pk_bf16(k1 * cs - k2 * sn, k2 * cs + k1 * sn), qw = cvt_pk_bf16(q1 * cs - q2 * sn, q2 * cs + q1 * sn);
        kp[0] = (bf16_t)(kw & 0xffffu); kp[16] = (bf16_t)(kw >> 16); qp[0] = (bf16_t)(qw & 0xffffu); qp[16] = (bf16_t)(qw >> 16); }
    __threadfence_block();
    __syncthreads();
    { const int d = tid & 127, kg = tid >> 7; LAS float* red = (LAS float*)lds; float s = 0.f;
#pragma unroll 8
      for (int j = 0; j < 64; ++j) s += bf2f(proj[(size_t)(m0 + kg * 64 + j) * NP + C_MK + h * 128 + d]);
      red[kg * 128 + d] = s;
      __syncthreads();
      if (kg == 0) ((float*)(a.ws + WS_KMEAN))[((size_t)(b * 4 + h) * 32 + blk) * 128 + d] = (red[d] + red[128 + d] + red[256 + d] + red[384 + d]) * (1.f / 256.f);
      __syncthreads(); }
    { LAS unsigned char* tT = lds + 4096;
#pragma unroll 2
      for (int it = 0; it < 8; ++it) { const int p = tid + it * NTHREADS, key = p >> 4, pc = p & 15;
          const u32x4 w = *(const u32x4*)(proj + (size_t)(m0 + key) * NP + C_MV + h * 128 + pc * 8); const unsigned ww[4] = {w.x, w.y, w.z, w.w};
#pragma unroll
          for (int e = 0; e < 4; ++e) { *(LAS bf16_t*)(tT + (pc * 8 + 2 * e) * 528 + key * 2) = (bf16_t)(ww[e] & 0xffffu); *(LAS bf16_t*)(tT + (pc * 8 + 2 * e + 1) * 528 + key * 2) = (bf16_t)(ww[e] >> 16); } }
      __syncthreads();
      bf16_t* VT = (bf16_t*)(a.ws + WS_VT) + (size_t)(b * 4 + h) * 128 * SEQ + blk * 256;
#pragma unroll 2
      for (int it = 0; it < 8; ++it) { const int p = tid + it * NTHREADS, dv = p >> 5, pc = p & 31;
          *(u32x4*)(VT + (size_t)dv * SEQ + pc * 8) = *(const LAS u32x4*)(tT + dv * 528 + pc * 16); }
      __syncthreads(); }
}

__device__ __forceinline__ void moba_attn_unit(const Args& a, LAS unsigned char* lds, int b, int h, int qt) {
    const int tid = otid(), lane = tid & 63, wave = tid >> 6, fr = lane & 15, fq = lane >> 4;
    const int q0 = qt * 128, own = q0 >> 8, bs = own * 256, m0 = b * SEQ + q0, bh = b * 4 + h;
    const bf16_t* proj = (const bf16_t*)(a.ws + WS_PROJ);
    LAS float* km = (LAS float*)lds;
    LAS float* sc = (LAS float*)(lds + 16384);
    LAS unsigned* rmask = (LAS unsigned*)(lds + 33280);
    LAS int* tlist = (LAS int*)(lds + 33792);
    LAS unsigned char* Ks = lds + 34816;
    LAS unsigned char* Vs = lds + 34816 + 64 * 272;
    const float* kmg = (const float*)(a.ws + WS_KMEAN) + (size_t)bh * 32 * 128;
    for (int e = tid; e < own * 128; e += NTHREADS) km[e] = kmg[e];
    __syncthreads();
    if (own > 3) {
        const int row = tid >> 2, part = tid & 3; const bf16_t* qp = proj + (size_t)(m0 + row) * NP + C_MQ + h * 128;
        float s8[8];
#pragma unroll
        for (int jj = 0; jj < 8; ++jj) s8[jj] = 0.f;
#pragma unroll 2
        for (int dc = 0; dc < 16; ++dc) { const u32x4 w = *(const u32x4*)(qp + dc * 8); const float qv[8] = {bflo(w.x), bfhi(w.x), bflo(w.y), bfhi(w.y), bflo(w.z), bfhi(w.z), bflo(w.w), bfhi(w.w)};
#pragma unroll
            for (int jj = 0; jj < 8; ++jj) { const int j = part + 4 * jj; if (j < own) {
#pragma unroll
                for (int e = 0; e < 8; ++e) s8[jj] += qv[e] * km[j * 128 + dc * 8 + e]; } } }
#pragma unroll
        for (int jj = 0; jj < 8; ++jj) { const int j = part + 4 * jj; if (j < own) sc[row * 33 + j] = s8[jj]; }
    }
    __syncthreads();
    if (tid < 128) { unsigned mk;
        if (own <= 3) mk = (1u << own) - 1u;
        else { float b0 = -INFINITY, b1 = -INFINITY, b2 = -INFINITY; int i0 = 0, i1 = 0, i2 = 0;
            for (int j = 0; j < own; ++j) { const float v = sc[tid * 33 + j];
                if (v > b0) { b2 = b1; i2 = i1; b1 = b0; i1 = i0; b0 = v; i0 = j; } else if (v > b1) { b2 = b1; i2 = i1; b1 = v; i1 = j; } else if (v > b2) { b2 = v; i2 = j; } }
            mk = (1u << i0) | (1u << i1) | (1u << i2); }
        rmask[tid] = mk; }
    __syncthreads();
    unsigned bun = rmask[lane] | rmask[lane + 64];
#pragma unroll
    for (int o = 1; o < 64; o <<= 1) bun |= __shfl_xor(bun, o);
    bun = __builtin_amdgcn_readfirstlane(bun);
    const int r = wave * 16 + fr; const unsigned mymask = rmask[r];
    unsigned wmask = mymask;
#pragma unroll
    for (int o = 1; o < 16; o <<= 1) wmask |= __shfl_xor(wmask, o);
    wmask = __builtin_amdgcn_readfirstlane(wmask);
    const int n_own = ((q0 - bs) >> 6) + 2, ntiles = n_own + 4 * __builtin_popcount(bun);
    if (tid == 0) { int k = 0; for (int i = 0; i < n_own; ++i) tlist[k++] = bs + i * 64;
        for (int j = 0; j < own; ++j) if ((bun >> j) & 1u) { for (int i = 0; i < 4; ++i) tlist[k++] = j * 256 + i * 64; } }
    bf16x8 qf[4];
#pragma unroll
    for (int kk = 0; kk < 4; ++kk) qf[kk] = *(const bf16x8*)(proj + (size_t)(m0 + r) * NP + C_MQ + h * 128 + kk * 32 + fq * 8);
    const int qpos = q0 + r;
    f32x4 o[8];
#pragma unroll
    for (int j = 0; j < 8; ++j) o[j] = (f32x4){0.f, 0.f, 0.f, 0.f};
    float mrun = -INFINITY, lrun = 0.f;
    const bf16_t* kbase = proj + (size_t)(b * SEQ) * NP + C_MK + h * 128;
    const bf16_t* vbase = (const bf16_t*)(a.ws + WS_VT) + (size_t)bh * 128 * SEQ;
    __syncthreads();
    u32x4 kreg[2], vreg[2];
    { const int kp0 = tlist[0];
#pragma unroll
      for (int i = 0; i < 2; ++i) { const int p = tid + i * NTHREADS; kreg[i] = *(const u32x4*)(kbase + (size_t)(kp0 + (p >> 4)) * NP + (p & 15) * 8); vreg[i] = *(const u32x4*)(vbase + (size_t)(p >> 3) * SEQ + kp0 + (p & 7) * 8); } }
    const float SC = 0.08838834764831845f * 1.4426950408889634f;
    for (int it = 0; it < ntiles; ++it) {
        const int kp0 = tlist[it];
        __syncthreads();
#pragma unroll
        for (int i = 0; i < 2; ++i) { const int p = tid + i * NTHREADS; *(LAS u32x4*)(Ks + (p >> 4) * 272 + (p & 15) * 16) = kreg[i]; *(LAS u32x4*)(Vs + (p >> 3) * 144 + (p & 7) * 16) = vreg[i]; }
        __syncthreads();
        if (it + 1 < ntiles) { const int kn = tlist[it + 1];
#pragma unroll
            for (int i = 0; i < 2; ++i) { const int p = tid + i * NTHREADS; kreg[i] = *(const u32x4*)(kbase + (size_t)(kn + (p >> 4)) * NP + (p & 15) * 8); vreg[i] = *(const u32x4*)(vbase + (size_t)(p >> 3) * SEQ + kn + (p & 7) * 8); } }
        const int kblk = kp0 >> 8; const bool isown = (kblk == own);
        const bool active = isown ? (kp0 <= q0 + wave * 16 + 15) : (((wmask >> kblk) & 1u) != 0u);
        if (active) {
            f32x4 st[4];
#pragma unroll
            for (int kt = 0; kt < 4; ++kt) { f32x4 acc = {0.f, 0.f, 0.f, 0.f};
#pragma unroll
                for (int kk = 0; kk < 4; ++kk) { const bf16x8 kf = *(const LAS bf16x8*)(Ks + (kt * 16 + fr) * 272 + kk * 64 + fq * 16); acc = mfma16(kf, qf[kk], acc); }
                st[kt] = acc * SC; }
            if (isown) {
#pragma unroll
                for (int kt = 0; kt < 4; ++kt)
#pragma unroll
                    for (int jj = 0; jj < 4; ++jj) if (kp0 + kt * 16 + 4 * fq + jj > qpos) st[kt][jj] = -INFINITY;
            } else if (!((mymask >> kblk) & 1u)) {
#pragma unroll
                for (int kt = 0; kt < 4; ++kt) st[kt] = (f32x4){-INFINITY, -INFINITY, -INFINITY, -INFINITY};
            }
            float mx = -INFINITY;
#pragma unroll
            for (int kt = 0; kt < 4; ++kt) mx = fmaxf(mx, fmaxf(fmaxf(st[kt][0], st[kt][1]), fmaxf(st[kt][2], st[kt][3])));
            mx = fmaxf(mx, __shfl_xor(mx, 16)); mx = fmaxf(mx, __shfl_xor(mx, 32));
            const float mnew = fmaxf(mrun, mx);
            const float msafe = (mnew == -INFINITY) ? 0.f : mnew;
            const float alpha = __builtin_amdgcn_exp2f(mrun - msafe);
            float ls = 0.f;
#pragma unroll
            for (int kt = 0; kt < 4; ++kt)
#pragma unroll
                for (int jj = 0; jj < 4; ++jj) { const float p = __builtin_amdgcn_exp2f(st[kt][jj] - msafe); st[kt][jj] = p; ls += p; }
            ls += __shfl_xor(ls, 16); ls += __shfl_xor(ls, 32);
            lrun = lrun * alpha + ls; mrun = mnew;
            bf16x8 pf[2];
#pragma unroll
            for (int k2 = 0; k2 < 2; ++k2) { const u32x4 w = {cvt_pk_bf16(st[2 * k2][0], st[2 * k2][1]), cvt_pk_bf16(st[2 * k2][2], st[2 * k2][3]), cvt_pk_bf16(st[2 * k2 + 1][0], st[2 * k2 + 1][1]), cvt_pk_bf16(st[2 * k2 + 1][2], st[2 * k2 + 1][3])};
                pf[k2] = __builtin_bit_cast(bf16x8, w); }
#pragma unroll
            for (int dvt = 0; dvt < 8; ++dvt) { f32x4 acc = o[dvt] * alpha;
#pragma unroll
                for (int k2 = 0; k2 < 2; ++k2) { const u32x2 v0 = *(const LAS u32x2*)(Vs + (dvt * 16 + fr) * 144 + (32 * k2 + 4 * fq) * 2), v1 = *(const LAS u32x2*)(Vs + (dvt * 16 + fr) * 144 + (32 * k2 + 16 + 4 * fq) * 2);
                    const u32x4 vw = {v0.x, v0.y, v1.x, v1.y};
                    acc = mfma16(__builtin_bit_cast(bf16x8, vw), pf[k2], acc); }
                o[dvt] = acc; }
        }
    }
    const float il = 1.f / lrun;
    bf16_t* br2 = (bf16_t*)(a.ws + WS_BR) + (size_t)2 * M * 512;
#pragma unroll
    for (int dvt = 0; dvt < 8; ++dvt) { u32x2 w; w.x = cvt_pk_bf16(o[dvt][0] * il, o[dvt][1] * il); w.y = cvt_pk_bf16(o[dvt][2] * il, o[dvt][3] * il);
        *(u32x2*)(br2 + (size_t)(m0 + r) * 512 + h * 128 + dvt * 16 + 4 * fq) = w; }
    __syncthreads();
}

__device__ __forceinline__ void phase_ln(const Args& a, const float* gam, const float* bet, int G) {
    const int tid = otid(), lane = tid & 63, wave = tid >> 6;
    bf16_t* xbf = (bf16_t*)(a.ws + WS_XBF);
    f32x4 gv[4], bv[4];
#pragma unroll
    for (int j = 0; j < 4; ++j) { gv[j] = *(const f32x4*)(gam + 4 * lane + 256 * j); bv[j] = *(const f32x4*)(bet + 4 * lane + 256 * j); }
    for (int m = blockIdx.x * NWAVES + wave; m < M; m += G * NWAVES) {
        f32x4* xr = (f32x4*)(a.out + (size_t)m * D) + lane;
        f32x4 v[4]; float s = 0.f;
#pragma unroll
        for (int j = 0; j < 4; ++j) { v[j] = xr[64 * j]; s += (v[j][0] + v[j][1]) + (v[j][2] + v[j][3]); }
        const float mean = wave_sum(s) * (1.f / D); float s2 = 0.f;
#pragma unroll
        for (int j = 0; j < 4; ++j) { v[j] = v[j] - mean; s2 += (v[j][0] * v[j][0] + v[j][1] * v[j][1]) + (v[j][2] * v[j][2] + v[j][3] * v[j][3]); }
        const float rstd = 1.f / sqrtf(wave_sum(s2) * (1.f / D) + LN_EPS);
        u32x2* o8 = (u32x2*)(xbf + (size_t)m * D) + lane;
#pragma unroll
        for (int j = 0; j < 4; ++j) { const f32x4 y = v[j] * rstd * gv[j] + bv[j]; xr[64 * j] = y; o8[64 * j] = (u32x2){cvt_pk_bf16(y[0], y[1]), cvt_pk_bf16(y[2], y[3])}; }
    }
}

__global__ void __launch_bounds__(NTHREADS, 2) fwd_mega(Args a) {
    extern __shared__ __attribute__((aligned(16))) unsigned char lds_raw[];
    LAS unsigned char* lds = (LAS unsigned char*)lds_raw;
    cg::grid_group grid = cg::this_grid();
    const int G = gridDim.x, bid = blockIdx.x;
    const float ALPHA = 1.6817928305074290f;
    bf16_t* xbf = (bf16_t*)(a.ws + WS_XBF); bf16_t* proj = (bf16_t*)(a.ws + WS_PROJ);
    for (int ph = a.ph_lo; ph < a.ph_hi; ++ph) {
        const int l = ph / PH_PER_LAYER, k = ph % PH_PER_LAYER;
        switch (k) {
        case 0: if (l == 0) phase_prep(a, 0, lds, G); break;
        case 1: { pg8::Gemm g{xbf, (const bf16_t*)(a.ws + WS_WIN), M, NP, D, D}; pg8::StaticOrder S; S.init(M, NP, G, bid);
                  pg8::EpiStore<0> E{proj, NP}; pg8::gemm_phase(lds, g, S, E); } break;
        case 2: {
                  for (int u = bid; u < 1792; u += G) { if (u < 256) moba_prep_unit(a, lds, u); else if (u < 768) gmlp_unit(a, l, lds, u - 256); else gla_kv_unit(a, l, lds, u - 768); } } break;
        case 3: { gla_scan(a, G);
                  for (int i = 0;; ++i) { const int u = i * G + bid; if (u >= 512) break;
                      int qt, bh; if (u < 256) { qt = 63 - (u >> 3); bh = u & 7; } else { qt = (u - 256) >> 3; bh = u & 7; }
                      moba_attn_unit(a, lds, bh >> 2, bh & 3, qt); } } break;
        case 4: { for (int u = bid; u < 1024; u += G) gla_out_unit(a, l, lds, u); } break;
        case 5: { pg8::Gemm g{(const bf16_t*)(a.ws + WS_BR), (const bf16_t*)(a.ws + WS_WBR), 3 * M, 3 * D, 512, 512}; pg8::MergeOrder S{G, bid};
                  pg8::EpiMerge E{proj, (float*)(a.ws + WS_PROJ), (bf16_t*)(a.ws + WS_MERGED)}; pg8::gemm_phase(lds, g, S, E); } break;
        case 6: { pg8::Gemm g{(const bf16_t*)(a.ws + WS_MERGED), (const bf16_t*)(a.ws + WS_WOUT), M, D, D, D}; pg8::StaticOrder S; S.init(M, D, G, bid);
                  pg8::EpiResid E{l == 0 ? a.x : a.out, a.out, ALPHA}; pg8::gemm_phase(lds, g, S, E); } break;
        case 7: phase_ln(a, a.ln1_g + (size_t)l * D, a.ln1_b + (size_t)l * D, G); break;
        case 8: { pg8::Gemm g{xbf, (const bf16_t*)(a.ws + WS_W1), M, FF, D, D}; pg8::StaticOrder S; S.init(M, FF, G, bid);
                  pg8::EpiStore<2> E{proj, FF}; pg8::gemm_phase(lds, g, S, E); } break;
        case 9: { pg8::Gemm g{proj, (const bf16_t*)(a.ws + WS_W2), M, D, FF, FF}; pg8::StaticOrder S; S.init(M, D, G, bid);
                  pg8::EpiResid E{a.out, a.out, ALPHA}; pg8::gemm_phase(lds, g, S, E); } break;
        default: phase_ln(a, a.ln2_g + (size_t)l * D, a.ln2_b + (size_t)l * D, G); if (l + 1 < DEPTH) phase_prep(a, l + 1, lds, G); break;
        }
        if (ph + 1 < a.ph_hi && !(ph % PH_PER_LAYER == 0 && ph > 0)) grid.sync();
    }
}

#ifndef MK_PER_PHASE
#define MK_PER_PHASE 0
#endif
extern "C" void kernel_launch(void* const* d_in, const int* in_sizes, int n_in, void* d_out, int out_size, void* d_ws, size_t ws_size, hipStream_t stream) {
    static int grid = 0;
    if (grid == 0) {
        if (n_in != 18 || out_size != M * D || ws_size < WS_END) { fprintf(stderr, "kernel_launch: unexpected problem (n_in %d out %d ws %zu)\n", n_in, out_size, ws_size); grid = -1; return; }
        int dev = 0, cus = 0, per_cu = 0;
        if (hipGetDevice(&dev) != hipSuccess || hipDeviceGetAttribute(&cus, hipDeviceAttributeMultiprocessorCount, dev) != hipSuccess) { grid = -1; return; }
        if (hipFuncSetAttribute((const void*)fwd_mega, hipFuncAttributeMaxDynamicSharedMemorySize, LDS_BYTES) != hipSuccess) { fprintf(stderr, "kernel_launch: hipFuncSetAttribute failed\n"); grid = -1; return; }
        if (hipOccupancyMaxActiveBlocksPerMultiprocessor(&per_cu, (const void*)fwd_mega, NTHREADS, LDS_BYTES) != hipSuccess || per_cu < 1) { fprintf(stderr, "kernel_launch: occupancy query says %d\n", per_cu); per_cu = 1; }
        (void)hipGetLastError();
        grid = cus;
    }
    if (grid < 0) return;
    Args a{};
    a.x = (const float*)d_in[0]; a.pos = (const int*)d_in[1]; a.w_in = (const float*)d_in[2]; a.w_gate_up = (const float*)d_in[3]; a.b_gate = (const float*)d_in[4];
    a.gla_norm_w = (const float*)d_in[5]; a.gmlp_ln_g = (const float*)d_in[6]; a.gmlp_ln_b = (const float*)d_in[7]; a.gmlp_w_s = (const float*)d_in[8]; a.gmlp_b_s = (const float*)d_in[9];
    a.w_branch = (const float*)d_in[10]; a.w_out = (const float*)d_in[11]; a.ln1_g = (const float*)d_in[12]; a.ln1_b = (const float*)d_in[13]; a.w_ff1 = (const float*)d_in[14];
    a.w_ff2 = (const float*)d_in[15]; a.ln2_g = (const float*)d_in[16]; a.ln2_b = (const float*)d_in[17]; a.out = (float*)d_out; a.ws = (unsigned char*)d_ws;
#if MK_PER_PHASE
    for (int ph = 0; ph < N_PHASES; ++ph) { a.ph_lo = ph; a.ph_hi = ph + 1; hipLaunchKernelGGL(fwd_mega, dim3(grid), dim3(NTHREADS), LDS_BYTES, stream, a); }
#else
    a.ph_lo = 0; a.ph_hi = N_PHASES;
    void* args[] = {&a};
    hipError_t e = hipLaunchCooperativeKernel((const void*)fwd_mega, dim3(grid), dim3(NTHREADS), args, LDS_BYTES, stream);
    if (e != hipSuccess) fprintf(stderr, "kernel_launch: cooperative launch failed: %s (grid %d)\n", hipGetErrorString(e), grid);
#endif
}
```

```cpp
#include <hip/hip_runtime.h>
#include <hip/hip_cooperative_groups.h>
#include <cstdio>
#include <cstdint>
namespace cg = cooperative_groups;

#define LAS __attribute__((address_space(3)))
typedef unsigned short bf16_t;
typedef short bf16x8 __attribute__((ext_vector_type(8)));
typedef short s16x4 __attribute__((ext_vector_type(4)));
typedef float f32x4 __attribute__((ext_vector_type(4)));
typedef float f32x2 __attribute__((ext_vector_type(2)));
typedef unsigned u32x4 __attribute__((ext_vector_type(4)));
typedef unsigned u32x2 __attribute__((ext_vector_type(2)));

constexpr int BATCH = 2, SEQ = 8192, M = BATCH * SEQ, D = 1024, DEPTH = 4, FF = 4096;
constexpr int IN_COLS = 7696, NP = 7936, C_LR = 7680;
constexpr int C_GQ = 0, C_GK = 512, C_GV = 1024, C_GG = 1536, C_GZU = 2048, C_GZV = 2560, C_MQ = 3072, C_MK = 3584, C_MV = 4096, C_GL = 4608;
constexpr int NWAVES = 8, NTHREADS = 512;
constexpr int LDS_BYTES = 147456;
constexpr float LN_EPS = 1e-5f, RMS_EPS = 1e-6f;
constexpr int PH_PER_LAYER = 11, N_PHASES = DEPTH * PH_PER_LAYER;

constexpr size_t MiB = 1u << 20;
constexpr size_t WS_WIN = 0, WS_GLR = 15 * MiB, WS_WBR = 16 * MiB, WS_WOUT = 19 * MiB, WS_W1 = 21 * MiB, WS_W2 = 29 * MiB;
constexpr size_t WS_XBF = 38 * MiB;
constexpr size_t WS_BR = 70 * MiB;
constexpr size_t WS_ST = 118 * MiB;
constexpr size_t WS_DEC = 150 * MiB;
constexpr size_t WS_KMEAN = WS_DEC + 512 * 1024;
constexpr size_t WS_VT = 151 * MiB;
constexpr size_t WS_MERGED = 167 * MiB;
constexpr size_t WS_PROJ = 200 * MiB;
constexpr size_t WS_CTL = 448 * MiB, CTL_BYTES = 16384;
constexpr size_t WS_END = 449 * MiB;

typedef __bf16 bf16x2_t __attribute__((ext_vector_type(2)));
__device__ __forceinline__ unsigned cvt_pk_bf16(float lo, float hi) { const f32x2 v = {lo, hi}; const bf16x2_t b = __builtin_convertvector(v, bf16x2_t); return __builtin_bit_cast(unsigned, b); }
__device__ __forceinline__ float bf2f(unsigned h) { return __builtin_bit_cast(float, h << 16); }
__device__ __forceinline__ float bflo(unsigned w) { return __builtin_bit_cast(float, w << 16); }
__device__ __forceinline__ float bfhi(unsigned w) { return __builtin_bit_cast(float, w & 0xffff0000u); }
__device__ __forceinline__ int otid() { int t = threadIdx.x; asm volatile("" : "+v"(t)); return t; }
__device__ __forceinline__ f32x4 mfma16(bf16x8 a, bf16x8 b, f32x4 c) { return __builtin_amdgcn_mfma_f32_16x16x32_bf16(a, b, c, 0, 0, 0); }

namespace pg8 {
constexpr int BM = 256, BK = 64, HALF = 128, HTB = HALF * BK * 2, NXCD = 8, WGM = 8;
__host__ __device__ __forceinline__ int lds_byte(int r, int c) { const int st = (r >> 4) * 2 + (c >> 5), rr = r & 15, cc = c & 31, ob = rr * 64 + cc * 2; return st * 1024 + (ob ^ (((ob >> 9) & 1) << 5)); }
__host__ __device__ __forceinline__ void stage_rc(int b, int& R, int& C) { const int st = b / 1024, sb = b % 1024, swz = sb ^ (((sb >> 9) & 1) << 5); R = (st >> 1) * 16 + swz / 64; C = (st & 1) * 32 + (swz % 64) / 2; }
__host__ __device__ __forceinline__ int perm32(int rho) { const int n = rho >> 4, i = rho & 15; return 8 * (i >> 2) + 4 * n + (i & 3); }

struct Unit { int pm, pn; };
struct Gemm { const bf16_t* A; const bf16_t* Bt; int M, N, K, lda; };

struct StaticOrder {
    int nM, nN, nwg, G, c;
    __device__ void init(int M_, int N_, int G_, int c_) { nM = M_ / BM; nN = N_ / BM; nwg = nM * nN; G = G_; c = c_; }
    __device__ bool next(int i, Unit& u) const {
        const long L = (long)i * G + c; if (L >= nwg) return false;
        int wgid = (int)L; { const int q = nwg / NXCD, r = nwg % NXCD, xcd = wgid % NXCD, off = wgid / NXCD; wgid = (xcd < r ? xcd * (q + 1) : r * (q + 1) + (xcd - r) * q) + off; }
        const int nig = WGM * nN, gid = wgid / nig, fm = gid * WGM, gsz = (nM - fm) < WGM ? (nM - fm) : WGM;
        u.pm = fm + ((wgid % nig) % gsz); u.pn = (wgid % nig) / gsz; return true;
    }
};
struct MergeOrder {
    int G, c;
    __device__ bool next(int i, Unit& u) const { const int t = (i / 3) * G + c; if (t >= 256) return false; const int br = i % 3; u.pm = br * 64 + (t >> 2); u.pn = br * 4 + (t & 3); return true; }
};

template <int ACT  > struct EpiStore {
    bf16_t* O; int ldc;
    __device__ __forceinline__ void operator()(const f32x4 (&acc)[2][2][4][2], const Unit& u, int wr, int wc, int fr, int fq) const {
        const int row0 = u.pm * BM + wr * 64 + fr, col0 = u.pn * BM + wc * 32 + 8 * fq;
#pragma unroll
        for (int ai = 0; ai < 2; ++ai)
#pragma unroll
            for (int m = 0; m < 4; ++m) { bf16_t* rowp = O + (size_t)(row0 + ai * HALF + m * 16) * ldc + col0;
#pragma unroll
                for (int bj = 0; bj < 2; ++bj) { f32x4 v0 = acc[ai][bj][m][0], v1 = acc[ai][bj][m][1];
                    if (ACT == 2) {
#pragma unroll
                        for (int e = 0; e < 4; ++e) { float a = fmaxf(v0[e], 0.f), b = fmaxf(v1[e], 0.f); v0[e] = a * a; v1[e] = b * b; } }
                    u32x4 w; w.x = cvt_pk_bf16(v0[0], v0[1]); w.y = cvt_pk_bf16(v0[2], v0[3]); w.z = cvt_pk_bf16(v1[0], v1[1]); w.w = cvt_pk_bf16(v1[2], v1[3]);
                    *(u32x4*)(rowp + bj * HALF) = w; } }
    }
};
struct EpiResid {
    const float* R; float* O; float alpha;
    __device__ __forceinline__ void operator()(const f32x4 (&acc)[2][2][4][2], const Unit& u, int wr, int wc, int fr, int fq) const {
        const int row0 = u.pm * BM + wr * 64 + fr, col0 = u.pn * BM + wc * 32 + 8 * fq;
#pragma unroll
        for (int ai = 0; ai < 2; ++ai)
#pragma unroll
            for (int m = 0; m < 4; ++m) { const size_t off = (size_t)(row0 + ai * HALF + m * 16) * 1024 + col0;
#pragma unroll
                for (int bj = 0; bj < 2; ++bj) { const f32x4 r0 = *(const f32x4*)(R + off + bj * HALF), r1 = *(const f32x4*)(R + off + bj * HALF + 4);
                    *(f32x4*)(O + off + bj * HALF) = r0 * alpha + acc[ai][bj][m][0]; *(f32x4*)(O + off + bj * HALF + 4) = r1 * alpha + acc[ai][bj][m][1]; } }
    }
};
struct EpiMerge {
    const bf16_t* proj; float* stash; bf16_t* merged;
    __device__ __forceinline__ void operator()(const f32x4 (&acc)[2][2][4][2], const Unit& u, int wr, int wc, int fr, int fq) const {
        const int br = u.pm >> 6, tm = u.pm & 63, tn = u.pn & 3;
        const int row0 = tm * BM + wr * 64 + fr, col0 = tn * BM + wc * 32 + 8 * fq;
#pragma unroll
        for (int ai = 0; ai < 2; ++ai)
#pragma unroll
            for (int m = 0; m < 4; ++m) { const int row = row0 + ai * HALF + m * 16;
#pragma unroll
                for (int bj = 0; bj < 2; ++bj) { const int col = col0 + bj * HALF;
                    const u32x4 gw = *(const u32x4*)(proj + (size_t)row * NP + C_GL + br * 1024 + col);
                    float g[8] = {bflo(gw.x), bfhi(gw.x), bflo(gw.y), bfhi(gw.y), bflo(gw.z), bfhi(gw.z), bflo(gw.w), bfhi(gw.w)};
                    f32x4 v0, v1;
#pragma unroll
                    for (int e = 0; e < 4; ++e) { v0[e] = acc[ai][bj][m][0][e] / (1.f + __expf(-g[e])); v1[e] = acc[ai][bj][m][1][e] / (1.f + __expf(-g[4 + e])); }
                    float* sp = stash + (size_t)row * (NP / 2) + col;
                    if (br == 0) { *(f32x4*)sp = v0; *(f32x4*)(sp + 4) = v1; }
                    else { v0 += *(const f32x4*)sp; v1 += *(const f32x4*)(sp + 4);
                        if (br == 1) { *(f32x4*)sp = v0; *(f32x4*)(sp + 4) = v1; }
                        else { u32x4 w; w.x = cvt_pk_bf16(v0[0], v0[1]); w.y = cvt_pk_bf16(v0[2], v0[3]); w.z = cvt_pk_bf16(v1[0], v1[1]); w.w = cvt_pk_bf16(v1[2], v1[3]);
                            *(u32x4*)(merged + (size_t)row * 1024 + col) = w; } } } }
    }
};

template <class Epi, class Sched>
__device__ __forceinline__ void gemm_phase(LAS unsigned char* lds, const Gemm g, const Sched& S, const Epi& E) {
    const int tid = otid(), wid = __builtin_amdgcn_readfirstlane(tid >> 6), lane = tid & 63, wr = wid >> 2, wc = wid & 3, fr = lane & 15, fq = lane >> 4;
    const int K = g.K, nt = K / BK, lda = g.lda;
    unsigned voffA[2], voffB[2];
#pragma unroll
    for (int i = 0; i < 2; ++i) { int R, C; stage_rc(tid * 16 + i * 8192, R, C); const int Rb = (R & ~31) + perm32(R & 31);
        voffA[i] = (unsigned)(R * lda + C) * 2u; voffB[i] = (unsigned)(Rb * K + C) * 2u; }
    const size_t kstep = (size_t)(BK * 2);
    const size_t hstepA = (size_t)HALF * lda * 2, hstepB = (size_t)HALF * K * 2;
    const size_t tstepA = 2 * hstepA, tstepB = 2 * hstepB;
    const unsigned ldsw = (unsigned)wid * 1024u;
    const int aoff = lds_byte(wr * 64 + fr, fq * 8), boff = lds_byte(wc * 32 + fr, fq * 8);
#define PG8_SA(b, h) (((b) * 2 + (h)) * HTB)
#define PG8_SB(b, h) ((4 + (b) * 2 + (h)) * HTB)
#define PG8_STAGE(bufoff, gbase, voff) do { _Pragma("unroll") for (int _i = 0; _i < 2; ++_i) \
        __builtin_amdgcn_global_load_lds((const unsigned*)((const char*)(gbase) + (voff)[_i]), (LAS unsigned*)(lds + (bufoff) + ldsw + _i * 8192), 16, 0, 0); } while (0)
#define PG8_LDA(dst, b, h) do { _Pragma("unroll") for (int m = 0; m < 4; ++m) _Pragma("unroll") for (int k = 0; k < 2; ++k) dst[m][k] = *(const LAS bf16x8*)(lds + PG8_SA(b, h) + aoff + m * 2048 + k * 1024); } while (0)
#define PG8_LDB(dst, b, h) do { _Pragma("unroll") for (int n = 0; n < 2; ++n) _Pragma("unroll") for (int k = 0; k < 2; ++k) dst[n][k] = *(const LAS bf16x8*)(lds + PG8_SB(b, h) + boff + n * 2048 + k * 1024); } while (0)
#define PG8_MMA(ai, bj, At, Bt) do { __builtin_amdgcn_s_setprio(1); _Pragma("unroll") for (int m = 0; m < 4; ++m) _Pragma("unroll") for (int n = 0; n < 2; ++n) _Pragma("unroll") for (int k = 0; k < 2; ++k) \
        acc[ai][bj][m][n] = __builtin_amdgcn_mfma_f32_16x16x32_bf16(Bt[n][k], At[m][k], acc[ai][bj][m][n], 0, 0, 0); __builtin_amdgcn_s_setprio(0); } while (0)
#define PG8_WAIT_V(n) asm volatile("s_waitcnt vmcnt(" #n ")" ::: "memory")
#define PG8_WAIT_L(n) asm volatile("s_waitcnt lgkmcnt(" #n ")" ::: "memory")
#define PG8_BAR __builtin_amdgcn_s_barrier()
#define PG8_SCHED __builtin_amdgcn_sched_barrier(0)
    Unit cur, nxt; int ui = 0;
    if (!S.next(0, cur)) return;
    f32x4 acc[2][2][4][2];
#pragma unroll
    for (int a = 0; a < 2; ++a)
#pragma unroll
        for (int b = 0; b < 2; ++b)
#pragma unroll
            for (int m = 0; m < 4; ++m)
#pragma unroll
                for (int n = 0; n < 2; ++n) acc[a][b][m][n] = (f32x4){0.f, 0.f, 0.f, 0.f};
    bf16x8 At[4][2], B0[2][2], B1[2][2];
    const char* cA = (const char*)g.A + (size_t)cur.pm * tstepA; const char* cB = (const char*)g.Bt + (size_t)cur.pn * tstepB;
    PG8_STAGE(PG8_SB(0, 0), cB, voffB); PG8_STAGE(PG8_SB(0, 1), cB + hstepB, voffB); PG8_STAGE(PG8_SA(0, 0), cA, voffA); PG8_STAGE(PG8_SA(0, 1), cA + hstepA, voffA);
    if (wr == 1) PG8_BAR;
    PG8_WAIT_V(2); PG8_BAR;
    PG8_STAGE(PG8_SB(1, 0), cB + kstep, voffB); PG8_STAGE(PG8_SA(1, 0), cA + kstep, voffA); PG8_STAGE(PG8_SB(1, 1), cB + hstepB + kstep, voffB);
    PG8_WAIT_V(6); PG8_BAR;
    for (;;) {
        const bool has_next = S.next(ui + 1, nxt);
        const char* nA = has_next ? (const char*)g.A + (size_t)nxt.pm * tstepA : cA; const char* nB = has_next ? (const char*)g.Bt + (size_t)nxt.pn * tstepB : cB;
        for (int t = 0; t < nt; t += 2) {
            const bool last = (t == nt - 2);
            const char* a1 = cA + (size_t)(t + 1) * kstep;
            const char* a2 = last ? nA : cA + (size_t)(t + 2) * kstep; const char* b2 = last ? nB : cB + (size_t)(t + 2) * kstep;
            const char* a3 = a2 + kstep; const char* b3 = b2 + kstep;
            PG8_LDB(B0, 0, 0); PG8_LDB(B1, 0, 1); PG8_SCHED; PG8_LDA(At, 0, 0); PG8_STAGE(PG8_SA(1, 1), a1 + hstepA, voffA);
            PG8_WAIT_V(8); PG8_WAIT_L(0); PG8_BAR; PG8_MMA(0, 0, At, B0); PG8_MMA(0, 1, At, B1); PG8_BAR; PG8_SCHED;
            PG8_LDA(At, 0, 1); PG8_STAGE(PG8_SB(0, 0), b2, voffB); PG8_STAGE(PG8_SB(0, 1), b2 + hstepB, voffB); PG8_STAGE(PG8_SA(0, 0), a2, voffA);
            PG8_WAIT_V(8); PG8_WAIT_L(0); PG8_BAR; PG8_MMA(1, 0, At, B0); PG8_MMA(1, 1, At, B1); PG8_BAR; PG8_SCHED;
            PG8_LDB(B0, 1, 0); PG8_LDB(B1, 1, 1); PG8_SCHED; PG8_LDA(At, 1, 0); PG8_STAGE(PG8_SA(0, 1), a2 + hstepA, voffA);
            PG8_WAIT_V(8); PG8_WAIT_L(0); PG8_BAR; PG8_MMA(0, 0, At, B0); PG8_MMA(0, 1, At, B1); PG8_BAR; PG8_SCHED;
            PG8_LDA(At, 1, 1); PG8_STAGE(PG8_SB(1, 0), b3, voffB); PG8_STAGE(PG8_SB(1, 1), b3 + hstepB, voffB); PG8_STAGE(PG8_SA(1, 0), a3, voffA);
            PG8_WAIT_V(8); PG8_WAIT_L(0); PG8_BAR; PG8_MMA(1, 0, At, B0); PG8_MMA(1, 1, At, B1); PG8_BAR; PG8_SCHED;
        }
        if (wr == 0) PG8_BAR;
        E(acc, cur, wr, wc, fr, fq);
        if (!has_next) break;
#pragma unroll
        for (int a = 0; a < 2; ++a)
#pragma unroll
            for (int b = 0; b < 2; ++b)
#pragma unroll
                for (int m = 0; m < 4; ++m)
#pragma unroll
                    for (int n = 0; n < 2; ++n) acc[a][b][m][n] = (f32x4){0.f, 0.f, 0.f, 0.f};
        cur = nxt; cA = nA; cB = nB; ++ui;
        if (wr == 1) PG8_BAR;
    }
    PG8_WAIT_V(0);
    PG8_BAR;
#undef PG8_SA
#undef PG8_SB
#undef PG8_STAGE
#undef PG8_LDA
#undef PG8_LDB
#undef PG8_MMA
#undef PG8_WAIT_V
#undef PG8_WAIT_L
#undef PG8_BAR
#undef PG8_SCHED
}
}


#define XB_TMO      128
#define XB_XCNT(j)  (256  + 64 * (j))
#define XB_XSUB(j)  (1280 + 64 * (j))
#define XB_XGEN(j)  (2304 + 64 * (j))
#define XB_TOP      3328
#define XB_TOPGEN   3392
#define XCD_BAR_WORDS 3456
#define XB_SPIN_CAP (1u << 18)
__device__ __forceinline__ unsigned xb_ld(unsigned* p)              { return __hip_atomic_load(p, __ATOMIC_RELAXED, __HIP_MEMORY_SCOPE_AGENT); }
__device__ __forceinline__ unsigned xb_add(unsigned* p, unsigned v) { return __hip_atomic_fetch_add(p, v, __ATOMIC_RELAXED, __HIP_MEMORY_SCOPE_AGENT); }
__device__ __forceinline__ unsigned xb_xcc_id() { return (unsigned)__builtin_amdgcn_s_getreg((3 << 11) | 20) & 0xFu; }
#define XB_SPIN(cond, bar) do { unsigned _sp = 0; while (cond) { __builtin_amdgcn_s_sleep(1); \
    if ((++_sp & 255u) == 0u) { if (xb_ld(&(bar)[XB_TMO])) break; if (_sp > XB_SPIN_CAP) { atomicAdd(&(bar)[XB_TMO], 1u); break; } } } } while (0)
struct XcdBarrier { unsigned* bar; unsigned x; volatile LAS unsigned* st; };
__device__ __forceinline__ XcdBarrier xcd_barrier_post(unsigned* bar, volatile LAS unsigned* st) {
    XcdBarrier b; b.bar = bar; b.x = xb_xcc_id(); b.st = st;
    if (threadIdx.x == 0) (void)xb_add(&bar[XB_XCNT(b.x)], 1u);
    return b;
}
__device__ __forceinline__ void xcd_barrier_complete(unsigned* bar, unsigned x, unsigned& nloc, unsigned& nx) {
    const unsigned G = gridDim.x * gridDim.y * gridDim.z;
    unsigned sum, cnt, mine, sp = 0u;
    for (;;) {
        sum = 0u; cnt = 0u; mine = 0u;
#pragma unroll
        for (unsigned j = 0; j < 16; ++j) { const unsigned c = xb_ld(&bar[XB_XCNT(j)]); sum += c; cnt += (c > 0u) ? 1u : 0u; mine = (j == x) ? c : mine; }
        if (sum == G) break;
        __builtin_amdgcn_s_sleep(1);
        if ((++sp & 255u) == 0u) { if (xb_ld(&bar[XB_TMO])) break; if (sp > XB_SPIN_CAP) { atomicAdd(&bar[XB_TMO], 1u); break; } }
    }
    nloc = mine > 0u ? mine : 1u; nx = cnt > 0u ? cnt : 1u;
}
__device__ __forceinline__ void xcd_barrier(const XcdBarrier& b) {
    asm volatile("s_waitcnt vmcnt(0)" ::: "memory");
    __syncthreads();
    if (threadIdx.x == 0) {
        unsigned* bar = b.bar;
        __builtin_amdgcn_s_waitcnt(0);
        unsigned nloc = b.st[0], nx = b.st[1];
        if (nloc == 0u) { xcd_barrier_complete(bar, b.x, nloc, nx); b.st[0] = nloc; b.st[1] = nx; }
        const unsigned old = xb_add(&bar[XB_XSUB(b.x)], 1u);
        const unsigned gen = old / nloc;
        if (old + 1u == (gen + 1u) * nloc) {
            __builtin_amdgcn_fence(__ATOMIC_RELEASE, "agent");
            asm volatile("s_waitcnt vmcnt(0)" ::: "memory");
            const unsigned og = xb_add(&bar[XB_TOP], 1u);
            const unsigned tg = og / nx;
            if (og + 1u == (tg + 1u) * nx) xb_add(&bar[XB_TOPGEN], 1u);
            else XB_SPIN(xb_ld(&bar[XB_TOPGEN]) == tg, bar);
            __builtin_amdgcn_fence(__ATOMIC_ACQUIRE, "agent");
            xb_add(&bar[XB_XGEN(b.x)], 1u);
            asm volatile("s_waitcnt vmcnt(0)" ::: "memory");
        } else {
            XB_SPIN(xb_ld(&bar[XB_XGEN(b.x)]) == gen, bar);
            __builtin_amdgcn_fence(__ATOMIC_ACQUIRE, "agent");
            asm volatile("s_waitcnt vmcnt(0)" ::: "memory");
        }
    }
    __syncthreads();
}

struct Args {
    const float* x; const int* pos; const float* w_in; const float* w_gate_up; const float* b_gate; const float* gla_norm_w; const float* gmlp_ln_g; const float* gmlp_ln_b;
    const float* gmlp_w_s; const float* gmlp_b_s; const float* w_branch; const float* w_out; const float* ln1_g; const float* ln1_b; const float* w_ff1; const float* w_ff2;
    const float* ln2_g; const float* ln2_b; float* out; unsigned char* ws; int ph_lo, ph_hi;
};

__device__ __forceinline__ float wave_sum(float v) {
#pragma unroll
    for (int o = 1; o < 64; o <<= 1) v += __shfl_xor(v, o);
    return v;
}

__device__ __forceinline__ void transpose_item(const float* W, int ldw, int col0, int K, int nblk, bf16_t* WT, int row_off, LAS float* scr, int item, int lane) {
    const int kb = item / nblk, nb = item % nblk, k0 = 64 * kb, n0 = 32 * nb;
#pragma unroll 8
    for (int i = 0; i < 32; ++i) { const int kk = 2 * i + (lane >> 5); scr[kk * 33 + (lane & 31)] = W[(size_t)(k0 + kk) * ldw + col0 + n0 + (lane & 31)]; }
    asm volatile("s_waitcnt lgkmcnt(0)" ::: "memory");
    const int c = lane & 7;
#pragma unroll
    for (int j = 0; j < 4; ++j) { const int n = (lane >> 3) + 8 * j; const LAS float* s = scr + (8 * c) * 33 + n;
        u32x4 o; o.x = cvt_pk_bf16(s[0 * 33], s[1 * 33]); o.y = cvt_pk_bf16(s[2 * 33], s[3 * 33]); o.z = cvt_pk_bf16(s[4 * 33], s[5 * 33]); o.w = cvt_pk_bf16(s[6 * 33], s[7 * 33]);
        *(u32x4*)(WT + (size_t)(row_off + n0 + n) * K + k0 + 8 * c) = o; }
    asm volatile("s_waitcnt lgkmcnt(0)" ::: "memory");
}

__device__ __forceinline__ void phase_prep(const Args& a, int l, LAS unsigned char* lds, int G) {
    const int tid = otid(), lane = tid & 63, wave = tid >> 6;
    LAS float* scr = (LAS float*)(lds + wave * 16384);
    const int gw = blockIdx.x * NWAVES + wave, NGW = G * NWAVES;
    bf16_t* WinT = (bf16_t*)(a.ws + WS_WIN); bf16_t* WbrT = (bf16_t*)(a.ws + WS_WBR); bf16_t* WoutT = (bf16_t*)(a.ws + WS_WOUT); bf16_t* W1T = (bf16_t*)(a.ws + WS_W1); bf16_t* W2T = (bf16_t*)(a.ws + WS_W2);
    const float* win = a.w_in + (size_t)l * D * IN_COLS;
    constexpr int I_IN_A = 16 * 64, I_IN_B = 16 * 176, I_BR = 8 * 32, I_OUT = 16 * 32, I_1 = 16 * 128, I_2 = 64 * 32;
    constexpr int NITEMS = I_IN_A + I_IN_B + 3 * I_BR + I_OUT + I_1 + I_2;
    for (int it = gw; it < NITEMS; it += NGW) {
        int r = it;
        if (r < I_IN_A) { transpose_item(win, IN_COLS, 0, D, 64, WinT, 0, scr, r, lane); continue; } r -= I_IN_A;
        if (r < I_IN_B) { transpose_item(win, IN_COLS, 2064, D, 176, WinT, 2048, scr, r, lane); continue; } r -= I_IN_B;
        if (r < 3 * I_BR) { const int br = r / I_BR; transpose_item(a.w_branch + ((size_t)l * 3 + br) * 512 * 1024, 1024, 0, 512, 32, WbrT, br * 1024, scr, r % I_BR, lane); continue; } r -= 3 * I_BR;
        if (r < I_OUT) { transpose_item(a.w_out + (size_t)l * D * D, D, 0, D, 32, WoutT, 0, scr, r, lane); continue; } r -= I_OUT;
        if (r < I_1) { transpose_item(a.w_ff1 + (size_t)l * D * FF, FF, 0, D, 128, W1T, 0, scr, r, lane); continue; } r -= I_1;
        transpose_item(a.w_ff2 + (size_t)l * FF * D, D, 0, FF, 32, W2T, 0, scr, r, lane);
    }
    { bf16_t* glrT = (bf16_t*)(a.ws + WS_GLR);
      for (int e = blockIdx.x * NTHREADS + tid; e < 16 * 1024; e += G * NTHREADS) { const int n = e >> 10, k = e & 1023; glrT[e] = (bf16_t)(cvt_pk_bf16(win[(size_t)k * IN_COLS + 2048 + n], 0.f) & 0xffffu); } }
    if (l == 0) {
        bf16_t* xbf = (bf16_t*)(a.ws + WS_XBF);
        for (size_t e = (size_t)(blockIdx.x * NTHREADS + tid) * 8; e < (size_t)M * D; e += (size_t)G * NTHREADS * 8) {
            const f32x4 v0 = *(const f32x4*)(a.x + e), v1 = *(const f32x4*)(a.x + e + 4);
            u32x4 w; w.x = cvt_pk_bf16(v0[0], v0[1]); w.y = cvt_pk_bf16(v0[2], v0[3]); w.z = cvt_pk_bf16(v1[0], v1[1]); w.w = cvt_pk_bf16(v1[2], v1[3]);
            *(u32x4*)(xbf + e) = w; }
    }
}

__device__ __forceinline__ void gla_bcum(const Args& a, int l, LAS unsigned char* lds, int m0, int h, float (&c)[16], float& bend) {
    const int tid = otid(), lane = tid & 63, wave = tid >> 6, fr = lane & 15, fq = lane >> 4;
    LAS float* lr = (LAS float*)lds; LAS float* tot = (LAS float*)(lds + 4352);
    const bf16_t* xbf = (const bf16_t*)(a.ws + WS_XBF); const bf16_t* glrT = (const bf16_t*)(a.ws + WS_GLR);
    if (tid < 128) {
        const int s = tid >> 1, hf = tid & 1;
        const u32x4 w = *(const u32x4*)((const bf16_t*)(a.ws + WS_PROJ) + (size_t)(m0 + s) * NP + C_LR + hf * 8);
        LAS float* lp = lr + s * 17 + hf * 8;
        lp[0] = bflo(w.x); lp[1] = bfhi(w.x); lp[2] = bflo(w.y); lp[3] = bfhi(w.y); lp[4] = bflo(w.z); lp[5] = bfhi(w.z); lp[6] = bflo(w.w); lp[7] = bfhi(w.w);
    }
    __syncthreads();
    const int d = tid & 127, g = tid >> 7, col = h * 128 + d;
    float wu[16];
#pragma unroll
    for (int r = 0; r < 16; ++r) wu[r] = a.w_gate_up[((size_t)l * 16 + r) * 512 + col];
    const float bg = a.b_gate[(size_t)l * 512 + col];
    float run = 0.f;
#pragma unroll
    for (int i = 0; i < 16; ++i) { const int s = g * 16 + i; float z = bg;
#pragma unroll
        for (int r = 0; r < 16; ++r) z += lr[s * 17 + r] * wu[r];
        const float la = (fminf(z, 0.f) - log1pf(__expf(-fabsf(z)))) * (1.f / 16.f);
        run += la; c[i] = run; }
    tot[g * 128 + d] = run;
    __syncthreads();
    float pre = 0.f, all = 0.f;
#pragma unroll
    for (int gg = 0; gg < 4; ++gg) { const float t = tot[gg * 128 + d]; all += t; if (gg < g) pre += t; }
#pragma unroll
    for (int i = 0; i < 16; ++i) c[i] += pre;
    bend = all;
}

__device__ __forceinline__ void gla_kv_unit(const Args& a, int l, LAS unsigned char* lds, int unit) {
    const int h = unit & 3, n = (unit >> 2) & 127, b = unit >> 9, m0 = b * SEQ + n * 64;
    const int tid = otid(), lane = tid & 63, wave = tid >> 6, fr = lane & 15, fq = lane >> 4;
    const bf16_t* proj = (const bf16_t*)(a.ws + WS_PROJ);
    float c[16], bend; gla_bcum(a, l, lds, m0, h, c, bend);
    const int d = tid & 127, g = tid >> 7, col = h * 128 + d;
    LAS unsigned char* keT = lds + 8192; LAS unsigned char* vT = lds + 8192 + 128 * 144;
    unsigned kw[8], vw[8];
#pragma unroll
    for (int i = 0; i < 16; i += 2) { const size_t r0 = (size_t)(m0 + g * 16 + i) * NP, r1 = r0 + NP;
        const float k0 = bf2f(proj[r0 + C_GK + col]) * __expf(bend - c[i]), k1 = bf2f(proj[r1 + C_GK + col]) * __expf(bend - c[i + 1]);
        kw[i >> 1] = cvt_pk_bf16(k0, k1); vw[i >> 1] = (unsigned)proj[r0 + C_GV + col] | ((unsigned)proj[r1 + C_GV + col] << 16); }
    *(LAS u32x4*)(keT + d * 144 + g * 32) = (u32x4){kw[0], kw[1], kw[2], kw[3]}; *(LAS u32x4*)(keT + d * 144 + g * 32 + 16) = (u32x4){kw[4], kw[5], kw[6], kw[7]};
    *(LAS u32x4*)(vT + d * 144 + g * 32) = (u32x4){vw[0], vw[1], vw[2], vw[3]}; *(LAS u32x4*)(vT + d * 144 + g * 32 + 16) = (u32x4){vw[4], vw[5], vw[6], vw[7]};
    const int bh = b * 4 + h;
    if (g == 0) ((float*)(a.ws + WS_DEC))[((size_t)bh * 128 + n) * 128 + d] = __expf(bend);
    __syncthreads();
    bf16_t* ST = (bf16_t*)(a.ws + WS_ST) + ((size_t)bh * 128 + n) * 16384;
    bf16x8 af[2];
#pragma unroll
    for (int kk = 0; kk < 2; ++kk) af[kk] = *(const LAS bf16x8*)(keT + (wave * 16 + fr) * 144 + kk * 64 + fq * 16);
#pragma unroll
    for (int dvt = 0; dvt < 8; ++dvt) { f32x4 acc = {0.f, 0.f, 0.f, 0.f};
#pragma unroll
        for (int kk = 0; kk < 2; ++kk) { const bf16x8 bv = *(const LAS bf16x8*)(vT + (dvt * 16 + fr) * 144 + kk * 64 + fq * 16); acc = mfma16(af[kk], bv, acc); }
        u32x2 w; w.x = cvt_pk_bf16(acc[0], acc[1]); w.y = cvt_pk_bf16(acc[2], acc[3]);
        *(u32x2*)(ST + (size_t)(dvt * 16 + fr) * 128 + wave * 16 + 4 * fq) = w; }
    __syncthreads();
}

__device__ __forceinline__ void gla_scan(const Args& a, int G) {
    const int tid = otid();
    for (int e = blockIdx.x * NTHREADS + tid; e < 8 * 128 * 64; e += G * NTHREADS) {
        const int dkp = e & 63, dv = (e >> 6) & 127, bh = e >> 13;
        unsigned* st = (unsigned*)(a.ws + WS_ST) + ((size_t)bh * 128 * 16384 + (size_t)dv * 128) / 2 + dkp;
        const f32x2* dec = (const f32x2*)(a.ws + WS_DEC) + ((size_t)bh * 128 * 128) / 2 + dkp;
        float s0 = 0.f, s1 = 0.f;
#pragma unroll 8
        for (int n = 0; n < 128; ++n) { const unsigned kv = st[(size_t)n * 8192]; const f32x2 dc = dec[n * 64];
            st[(size_t)n * 8192] = cvt_pk_bf16(s0, s1);
            s0 = dc.x * s0 + bflo(kv); s1 = dc.y * s1 + bfhi(kv); }
    }
}

__device__ __forceinline__ void gla_out_unit(const Args& a, int l, LAS unsigned char* lds, int unit) {
    const int h = unit & 3, n = (unit >> 2) & 127, b = unit >> 9, m0 = b * SEQ + n * 64;
    const int tid = otid(), lane = tid & 63, wave = tid >> 6, fr = lane & 15, fq = lane >> 4;
    const bf16_t* proj = (const bf16_t*)(a.ws + WS_PROJ);
    float c[16], bend; gla_bcum(a, l, lds, m0, h, c, bend);
    const int d = tid & 127, g = tid >> 7, col = h * 128 + d;
    LAS unsigned char* qd = lds + 8192;
    LAS unsigned char* ki = qd + 64 * 272;
    LAS unsigned char* vT = ki + 64 * 272;
    LAS unsigned char* at = vT + 128 * 144;
    LAS float* ssq = (LAS float*)(at + 64 * 144);
    unsigned vw[8];
#pragma unroll
    for (int i = 0; i < 16; i += 2) { const size_t r0 = (size_t)(m0 + g * 16 + i) * NP, r1 = r0 + NP;
        const float e0 = __expf(c[i]), e1 = __expf(c[i + 1]);
        const float q0 = bf2f(proj[r0 + C_GQ + col]) * e0, q1 = bf2f(proj[r1 + C_GQ + col]) * e1;
        const float k0 = bf2f(proj[r0 + C_GK + col]) * 0.08838834764831845f / e0, k1 = bf2f(proj[r1 + C_GK + col]) * 0.08838834764831845f / e1;
        *(LAS bf16_t*)(qd + (g * 16 + i) * 272 + d * 2) = (bf16_t)(cvt_pk_bf16(q0, 0.f) & 0xffffu); *(LAS bf16_t*)(qd + (g * 16 + i + 1) * 272 + d * 2) = (bf16_t)(cvt_pk_bf16(q1, 0.f) & 0xffffu);
        *(LAS bf16_t*)(ki + (g * 16 + i) * 272 + d * 2) = (bf16_t)(cvt_pk_bf16(k0, 0.f) & 0xffffu); *(LAS bf16_t*)(ki + (g * 16 + i + 1) * 272 + d * 2) = (bf16_t)(cvt_pk_bf16(k1, 0.f) & 0xffffu);
        vw[i >> 1] = (unsigned)proj[r0 + C_GV + col] | ((unsigned)proj[r1 + C_GV + col] << 16); }
    *(LAS u32x4*)(vT + d * 144 + g * 32) = (u32x4){vw[0], vw[1], vw[2], vw[3]}; *(LAS u32x4*)(vT + d * 144 + g * 32 + 16) = (u32x4){vw[4], vw[5], vw[6], vw[7]};
    __syncthreads();
    { const int tt = wave >> 1;
      bf16x8 qf[4];
#pragma unroll
      for (int kk = 0; kk < 4; ++kk) qf[kk] = *(const LAS bf16x8*)(qd + (tt * 16 + fr) * 272 + kk * 64 + fq * 16);
#pragma unroll
      for (int s2 = 0; s2 < 2; ++s2) { const int stl = (wave & 1) * 2 + s2; f32x4 acc = {0.f, 0.f, 0.f, 0.f};
#pragma unroll
          for (int kk = 0; kk < 4; ++kk) { const bf16x8 kf = *(const LAS bf16x8*)(ki + (stl * 16 + fr) * 272 + kk * 64 + fq * 16); acc = mfma16(kf, qf[kk], acc); }
          const int t = tt * 16 + fr, s0 = stl * 16 + 4 * fq;
#pragma unroll
          for (int jj = 0; jj < 4; ++jj) if (s0 + jj > t) acc[jj] = 0.f;
          u32x2 w; w.x = cvt_pk_bf16(acc[0], acc[1]); w.y = cvt_pk_bf16(acc[2], acc[3]);
          *(LAS u32x2*)(at + t * 144 + s0 * 2) = w; } }
    __syncthreads();
    const int tt = wave & 3, dvh = wave >> 2, bh = b * 4 + h;
    const bf16_t* ST = (const bf16_t*)(a.ws + WS_ST) + ((size_t)bh * 128 + n) * 16384;
    bf16x8 atf[2], qf[4];
#pragma unroll
    for (int kk = 0; kk < 2; ++kk) atf[kk] = *(const LAS bf16x8*)(at + (tt * 16 + fr) * 144 + kk * 64 + fq * 16);
#pragma unroll
    for (int kk = 0; kk < 4; ++kk) qf[kk] = *(const LAS bf16x8*)(qd + (tt * 16 + fr) * 272 + kk * 64 + fq * 16);
    f32x4 o[4]; float sq = 0.f;
#pragma unroll
    for (int j = 0; j < 4; ++j) { const int dvt = dvh * 4 + j; f32x4 acc = {0.f, 0.f, 0.f, 0.f};
#pragma unroll
        for (int kk = 0; kk < 2; ++kk) { const bf16x8 vf = *(const LAS bf16x8*)(vT + (dvt * 16 + fr) * 144 + kk * 64 + fq * 16); acc = mfma16(vf, atf[kk], acc); }
        f32x4 acs = {0.f, 0.f, 0.f, 0.f};
#pragma unroll
        for (int kk = 0; kk < 4; ++kk) { const bf16x8 sf = *(const bf16x8*)(ST + (size_t)(dvt * 16 + fr) * 128 + kk * 32 + fq * 8); acs = mfma16(sf, qf[kk], acs); }
        acc += acs * 0.08838834764831845f;
        o[j] = acc; sq += acc[0] * acc[0] + acc[1] * acc[1] + acc[2] * acc[2] + acc[3] * acc[3]; }
    sq += __shfl_xor(sq, 16); sq += __shfl_xor(sq, 32);
    if (fq == 0) ssq[dvh * 64 + tt * 16 + fr] = sq;
    __syncthreads();
    const float rs = 1.f / sqrtf((ssq[tt * 16 + fr] + ssq[64 + tt * 16 + fr]) * (1.f / 128.f) + RMS_EPS);
    const int m = m0 + tt * 16 + fr;
    bf16_t* br0 = (bf16_t*)(a.ws + WS_BR);
#pragma unroll
    for (int j = 0; j < 4; ++j) { const int dv = (dvh * 4 + j) * 16 + 4 * fq;
        const f32x4 nw = *(const f32x4*)(a.gla_norm_w + (size_t)l * 128 + dv);
        const u32x2 gw = *(const u32x2*)(proj + (size_t)m * NP + C_GG + h * 128 + dv);
        const float gg[4] = {bflo(gw.x), bfhi(gw.x), bflo(gw.y), bfhi(gw.y)}; float r[4];
#pragma unroll
        for (int e = 0; e < 4; ++e) r[e] = o[j][e] * rs * nw[e] * (gg[e] / (1.f + __expf(-gg[e])));
        u32x2 w; w.x = cvt_pk_bf16(r[0], r[1]); w.y = cvt_pk_bf16(r[2], r[3]);
        *(u32x2*)(br0 + (size_t)m * 512 + h * 128 + dv) = w; }
    __syncthreads();
}

__device__ __forceinline__ float gelu_erf(float v) {
    const float av = fabsf(v), t = __builtin_amdgcn_rcpf(av * 0.2316418882f + 1.0f);
    float q = t * 0.5307027145f + (-0.7265760135f); q = q * t + 0.7107068705f; q = q * t + (-0.142248368f); q = q * t + 0.127414796f; q = q * t;
    const float e = __builtin_amdgcn_exp2f((v * v) * (-0.72134752044f));
    const float m = v * (q * e);
    return v < 0.f ? m : v - m;
}
__device__ __forceinline__ void gmlp_unit(const Args& a, int l, LAS unsigned char* lds, int unit) {
    const int g = unit & 3, nc = (unit >> 2) & 63, b = unit >> 8, m0 = b * SEQ + nc * 128;
    const int tid = otid(), lane = tid & 63, wave = tid >> 6, fr = lane & 15, fq = lane >> 4;
    const bf16_t* proj = (const bf16_t*)(a.ws + WS_PROJ);
    LAS float* stats = (LAS float*)lds;
    LAS unsigned char* vnT = lds + 1024;
    LAS unsigned char* wm = vnT + 128 * 272;
    { const int tok = tid >> 2, part = tid & 3; const bf16_t* vp = proj + (size_t)(m0 + tok) * NP + C_GZV + part * 128;
      float s = 0.f, s2 = 0.f;
#pragma unroll 4
      for (int j = 0; j < 16; ++j) { const u32x4 w = *(const u32x4*)(vp + j * 8); const unsigned ww[4] = {w.x, w.y, w.z, w.w};
#pragma unroll
          for (int e = 0; e < 4; ++e) { const float g0 = gelu_erf(bflo(ww[e])), g1 = gelu_erf(bfhi(ww[e])); s += g0 + g1; s2 += g0 * g0 + g1 * g1; } }
      s += __shfl_xor(s, 1); s += __shfl_xor(s, 2); s2 += __shfl_xor(s2, 1); s2 += __shfl_xor(s2, 2);
      const float mean = s * (1.f / 512.f), var = fmaxf(s2 * (1.f / 512.f) - mean * mean, 0.f);
      if (part == 0) { stats[tok * 2] = mean; stats[tok * 2 + 1] = 1.f / sqrtf(var + LN_EPS); } }
    { const int t = tid >> 2, sq4 = (tid & 3) * 32; const float* wp = a.gmlp_w_s + (((size_t)l * 4 + g) * 128 + t) * 128 + sq4;
#pragma unroll
      for (int j = 0; j < 4; ++j) { const f32x4 w0 = *(const f32x4*)(wp + j * 8), w1 = *(const f32x4*)(wp + j * 8 + 4); float v[8] = {w0[0], w0[1], w0[2], w0[3], w1[0], w1[1], w1[2], w1[3]};
#pragma unroll
          for (int e = 0; e < 8; ++e) if (sq4 + j * 8 + e > t) v[e] = 0.f;
          *(LAS u32x4*)(wm + t * 272 + (sq4 + j * 8) * 2) = (u32x4){cvt_pk_bf16(v[0], v[1]), cvt_pk_bf16(v[2], v[3]), cvt_pk_bf16(v[4], v[5]), cvt_pk_bf16(v[6], v[7])}; } }
    __syncthreads();
    { const int cch = tid & 127, sg = tid >> 7; const float lg = a.gmlp_ln_g[(size_t)l * 512 + g * 128 + cch], lb = a.gmlp_ln_b[(size_t)l * 512 + g * 128 + cch];
#pragma unroll
      for (int j = 0; j < 4; ++j) { unsigned w[4];
#pragma unroll
          for (int e = 0; e < 4; ++e) { const int s0 = sg * 32 + j * 8 + e * 2;
              const float v0 = gelu_erf(bf2f(proj[(size_t)(m0 + s0) * NP + C_GZV + g * 128 + cch])), v1 = gelu_erf(bf2f(proj[(size_t)(m0 + s0 + 1) * NP + C_GZV + g * 128 + cch]));
              w[e] = cvt_pk_bf16((v0 - stats[s0 * 2]) * stats[s0 * 2 + 1] * lg + lb, (v1 - stats[s0 * 2 + 2]) * stats[s0 * 2 + 3] * lg + lb); }
          *(LAS u32x4*)(vnT + cch * 272 + (sg * 32 + j * 8) * 2) = (u32x4){w[0], w[1], w[2], w[3]}; } }
    __syncthreads();
    const int nk = ((wave * 16 + 15) >> 5) + 1;
    bf16x8 wf[4];
#pragma unroll
    for (int kk = 0; kk < 4; ++kk) wf[kk] = *(const LAS bf16x8*)(wm + (wave * 16 + fr) * 272 + kk * 64 + fq * 16);
    const int t = wave * 16 + fr, m = m0 + t;
    const float bs = a.gmlp_b_s[((size_t)l * 4 + g) * 128 + t];
    bf16_t* br1 = (bf16_t*)(a.ws + WS_BR) + (size_t)M * 512;
#pragma unroll
    for (int ct = 0; ct < 8; ++ct) { f32x4 acc = {0.f, 0.f, 0.f, 0.f};
#pragma unroll
        for (int kk = 0; kk < 4; ++kk) if (kk < nk) { const bf16x8 vf = *(const LAS bf16x8*)(vnT + (ct * 16 + fr) * 272 + kk * 64 + fq * 16); acc = mfma16(vf, wf[kk], acc); }
        const int cc = g * 128 + ct * 16 + 4 * fq;
        const u32x2 uw = *(const u32x2*)(proj + (size_t)m * NP + C_GZU + cc);
        const float u0 = gelu_erf(bflo(uw.x)), u1 = gelu_erf(bfhi(uw.x)), u2 = gelu_erf(bflo(uw.y)), u3 = gelu_erf(bfhi(uw.y));
        u32x2 w; w.x = cvt_pk_bf16(u0 * (acc[0] + bs), u1 * (acc[1] + bs)); w.y = cvt_pk_bf16(u2 * (acc[2] + bs), u3 * (acc[3] + bs));
        *(u32x2*)(br1 + (size_t)m * 512 + cc) = w; }
    __syncthreads();
}

__device__ __forceinline__ void moba_prep_unit(const Args& a, LAS unsigned char* lds, int unit) {
    const int blk = unit & 31, h = (unit >> 5) & 3, b = unit >> 7, m0 = b * SEQ + blk * 256;
    const int tid = otid();
    bf16_t* proj = (bf16_t*)(a.ws + WS_PROJ);
#pragma unroll 2
    for (int it = 0; it < 8; ++it) { const int item = tid + it * NTHREADS, tok = item >> 4, i = item & 15; const size_t m = (size_t)(m0 + tok);
        const float inv = exp2f(-(float)i * (18.931568569324174f / 16.f));
        const float ang = (float)a.pos[m] * inv; float sn, cs; sincosf(ang, &sn, &cs);
        bf16_t* kp = proj + m * NP + C_MK + h * 128 + i; bf16_t* qp = proj + m * NP + C_MQ + h * 128 + i;
        const float k1 = bf2f(kp[0]), k2 = bf2f(kp[16]), q1 = bf2f(qp[0]), q2 = bf2f(qp[16]);
        const unsigned kw = cvt_pk_bf16(k1 * cs - k2 * sn, k2 * cs + k1 * sn), qw = cvt_pk_bf16(q1 * cs - q2 * sn, q2 * cs + q1 * sn);
        kp[0] = (bf16_t)(kw & 0xffffu); kp[16] = (bf16_t)(kw >> 16); qp[0] = (bf16_t)(qw & 0xffffu); qp[16] = (bf16_t)(qw >> 16); }
    __threadfence_block();
    __syncthreads();
    { const int d = tid & 127, kg = tid >> 7; LAS float* red = (LAS float*)lds; float s = 0.f;
#pragma unroll 8
      for (int j = 0; j < 64; ++j) s += bf2f(proj[(size_t)(m0 + kg * 64 + j) * NP + C_MK + h * 128 + d]);
      red[kg * 128 + d] = s;
      __syncthreads();
      if (kg == 0) ((float*)(a.ws + WS_KMEAN))[((size_t)(b * 4 + h) * 32 + blk) * 128 + d] = (red[d] + red[128 + d] + red[256 + d] + red[384 + d]) * (1.f / 256.f);
      __syncthreads(); }
    { LAS unsigned char* tT = lds + 4096;
#pragma unroll 2
      for (int it = 0; it < 8; ++it) { const int p = tid + it * NTHREADS, key = p >> 4, pc = p & 15;
          const u32x4 w = *(const u32x4*)(proj + (size_t)(m0 + key) * NP + C_MV + h * 128 + pc * 8); const unsigned ww[4] = {w.x, w.y, w.z, w.w};
#pragma unroll
          for (int e = 0; e < 4; ++e) { *(LAS bf16_t*)(tT + (pc * 8 + 2 * e) * 528 + key * 2) = (bf16_t)(ww[e] & 0xffffu); *(LAS bf16_t*)(tT + (pc * 8 + 2 * e + 1) * 528 + key * 2) = (bf16_t)(ww[e] >> 16); } }
      __syncthreads();
      bf16_t* VT = (bf16_t*)(a.ws + WS_VT) + (size_t)(b * 4 + h) * 128 * SEQ + blk * 256;
#pragma unroll 2
      for (int it = 0; it < 8; ++it) { const int p = tid + it * NTHREADS, dv = p >> 5, pc = p & 31;
          *(u32x4*)(VT + (size_t)dv * SEQ + pc * 8) = *(const LAS u32x4*)(tT + dv * 528 + pc * 16); }
      __syncthreads(); }
}

__device__ __forceinline__ void moba_attn_unit(const Args& a, LAS unsigned char* lds, int b, int h, int qt) {
    const int tid = otid(), lane = tid & 63, wave = tid >> 6, fr = lane & 15, fq = lane >> 4;
    const int q0 = qt * 128, own = q0 >> 8, bs = own * 256, m0 = b * SEQ + q0, bh = b * 4 + h;
    const bf16_t* proj = (const bf16_t*)(a.ws + WS_PROJ);
    LAS float* km = (LAS float*)lds;
    LAS float* sc = (LAS float*)(lds + 16384);
    LAS unsigned* rmask = (LAS unsigned*)(lds + 33280);
    LAS int* tlist = (LAS int*)(lds + 33792);
    LAS unsigned char* Ks = lds + 34816;
    LAS unsigned char* Vs = lds + 34816 + 64 * 272;
    const float* kmg = (const float*)(a.ws + WS_KMEAN) + (size_t)bh * 32 * 128;
    for (int e = tid; e < own * 128; e += NTHREADS) km[e] = kmg[e];
    __syncthreads();
    if (own > 3) {
        const int row = tid >> 2, part = tid & 3; const bf16_t* qp = proj + (size_t)(m0 + row) * NP + C_MQ + h * 128;
        float s8[8];
#pragma unroll
        for (int jj = 0; jj < 8; ++jj) s8[jj] = 0.f;
#pragma unroll 2
        for (int dc = 0; dc < 16; ++dc) { const u32x4 w = *(const u32x4*)(qp + dc * 8); const float qv[8] = {bflo(w.x), bfhi(w.x), bflo(w.y), bfhi(w.y), bflo(w.z), bfhi(w.z), bflo(w.w), bfhi(w.w)};
#pragma unroll
            for (int jj = 0; jj < 8; ++jj) { const int j = part + 4 * jj; if (j < own) {
#pragma unroll
                for (int e = 0; e < 8; ++e) s8[jj] += qv[e] * km[j * 128 + dc * 8 + e]; } } }
#pragma unroll
        for (int jj = 0; jj < 8; ++jj) { const int j = part + 4 * jj; if (j < own) sc[row * 33 + j] = s8[jj]; }
    }
    __syncthreads();
    if (tid < 128) { unsigned mk;
        if (own <= 3) mk = (1u << own) - 1u;
        else { float b0 = -INFINITY, b1 = -INFINITY, b2 = -INFINITY; int i0 = 0, i1 = 0, i2 = 0;
            for (int j = 0; j < own; ++j) { const float v = sc[tid * 33 + j];
                if (v > b0) { b2 = b1; i2 = i1; b1 = b0; i1 = i0; b0 = v; i0 = j; } else if (v > b1) { b2 = b1; i2 = i1; b1 = v; i1 = j; } else if (v > b2) { b2 = v; i2 = j; } }
            mk = (1u << i0) | (1u << i1) | (1u << i2); }
        rmask[tid] = mk; }
    __syncthreads();
    unsigned bun = rmask[lane] | rmask[lane + 64];
#pragma unroll
    for (int o = 1; o < 64; o <<= 1) bun |= __shfl_xor(bun, o);
    bun = __builtin_amdgcn_readfirstlane(bun);
    const int r = wave * 16 + fr; const unsigned mymask = rmask[r];
    unsigned wmask = mymask;
#pragma unroll
    for (int o = 1; o < 16; o <<= 1) wmask |= __shfl_xor(wmask, o);
    wmask = __builtin_amdgcn_readfirstlane(wmask);
    const int n_own = ((q0 - bs) >> 6) + 2, ntiles = n_own + 4 * __builtin_popcount(bun);
    if (tid == 0) { int k = 0; for (int i = 0; i < n_own; ++i) tlist[k++] = bs + i * 64;
        for (int j = 0; j < own; ++j) if ((bun >> j) & 1u) { for (int i = 0; i < 4; ++i) tlist[k++] = j * 256 + i * 64; } }
    bf16x8 qf[4];
#pragma unroll
    for (int kk = 0; kk < 4; ++kk) qf[kk] = *(const bf16x8*)(proj + (size_t)(m0 + r) * NP + C_MQ + h * 128 + kk * 32 + fq * 8);
    const int qpos = q0 + r;
    f32x4 o[8];
#pragma unroll
    for (int j = 0; j < 8; ++j) o[j] = (f32x4){0.f, 0.f, 0.f, 0.f};
    float mrun = -INFINITY, lrun = 0.f;
    const bf16_t* kbase = proj + (size_t)(b * SEQ) * NP + C_MK + h * 128;
    const bf16_t* vbase = (const bf16_t*)(a.ws + WS_VT) + (size_t)bh * 128 * SEQ;
    __syncthreads();
    u32x4 kreg[2], vreg[2];
    { const int kp0 = tlist[0];
#pragma unroll
      for (int i = 0; i < 2; ++i) { const int p = tid + i * NTHREADS; kreg[i] = *(const u32x4*)(kbase + (size_t)(kp0 + (p >> 4)) * NP + (p & 15) * 8); vreg[i] = *(const u32x4*)(vbase + (size_t)(p >> 3) * SEQ + kp0 + (p & 7) * 8); } }
    const float SC = 0.08838834764831845f * 1.4426950408889634f;
    for (int it = 0; it < ntiles; ++it) {
        const int kp0 = tlist[it];
        __syncthreads();
#pragma unroll
        for (int i = 0; i < 2; ++i) { const int p = tid + i * NTHREADS; *(LAS u32x4*)(Ks + (p >> 4) * 272 + (p & 15) * 16) = kreg[i]; *(LAS u32x4*)(Vs + (p >> 3) * 144 + (p & 7) * 16) = vreg[i]; }
        __syncthreads();
        if (it + 1 < ntiles) { const int kn = tlist[it + 1];
#pragma unroll
            for (int i = 0; i < 2; ++i) { const int p = tid + i * NTHREADS; kreg[i] = *(const u32x4*)(kbase + (size_t)(kn + (p >> 4)) * NP + (p & 15) * 8); vreg[i] = *(const u32x4*)(vbase + (size_t)(p >> 3) * SEQ + kn + (p & 7) * 8); } }
        const int kblk = kp0 >> 8; const bool isown = (kblk == own);
        const bool active = isown ? (kp0 <= q0 + wave * 16 + 15) : (((wmask >> kblk) & 1u) != 0u);
        if (active) {
            f32x4 st[4];
#pragma unroll
            for (int kt = 0; kt < 4; ++kt) { f32x4 acc = {0.f, 0.f, 0.f, 0.f};
#pragma unroll
                for (int kk = 0; kk < 4; ++kk) { const bf16x8 kf = *(const LAS bf16x8*)(Ks + (kt * 16 + fr) * 272 + kk * 64 + fq * 16); acc = mfma16(kf, qf[kk], acc); }
                st[kt] = acc * SC; }
            if (isown) {
#pragma unroll
                for (int kt = 0; kt < 4; ++kt)
#pragma unroll
                    for (int jj = 0; jj < 4; ++jj) if (kp0 + kt * 16 + 4 * fq + jj > qpos) st[kt][jj] = -INFINITY;
            } else if (!((mymask >> kblk) & 1u)) {
#pragma unroll
                for (int kt = 0; kt < 4; ++kt) st[kt] = (f32x4){-INFINITY, -INFINITY, -INFINITY, -INFINITY};
            }
            float mx = -INFINITY;
#pragma unroll
            for (int kt = 0; kt < 4; ++kt) mx = fmaxf(mx, fmaxf(fmaxf(st[kt][0], st[kt][1]), fmaxf(st[kt][2], st[kt][3])));
            mx = fmaxf(mx, __shfl_xor(mx, 16)); mx = fmaxf(mx, __shfl_xor(mx, 32));
            const float mnew = fmaxf(mrun, mx);
            const float msafe = (mnew == -INFINITY) ? 0.f : mnew;
            const float alpha = __builtin_amdgcn_exp2f(mrun - msafe);
            float ls = 0.f;
#pragma unroll
            for (int kt = 0; kt < 4; ++kt)
#pragma unroll
                for (int jj = 0; jj < 4; ++jj) { const float p = __builtin_amdgcn_exp2f(st[kt][jj] - msafe); st[kt][jj] = p; ls += p; }
            ls += __shfl_xor(ls, 16); ls += __shfl_xor(ls, 32);
            lrun = lrun * alpha + ls; mrun = mnew;
            bf16x8 pf[2];
#pragma unroll
            for (int k2 = 0; k2 < 2; ++k2) { const u32x4 w = {cvt_pk_bf16(st[2 * k2][0], st[2 * k2][1]), cvt_pk_bf16(st[2 * k2][2], st[2 * k2][3]), cvt_pk_bf16(st[2 * k2 + 1][0], st[2 * k2 + 1][1]), cvt_pk_bf16(st[2 * k2 + 1][2], st[2 * k2 + 1][3])};
                pf[k2] = __builtin_bit_cast(bf16x8, w); }
#pragma unroll
            for (int dvt = 0; dvt < 8; ++dvt) { f32x4 acc = o[dvt] * alpha;
#pragma unroll
                for (int k2 = 0; k2 < 2; ++k2) { const u32x2 v0 = *(const LAS u32x2*)(Vs + (dvt * 16 + fr) * 144 + (32 * k2 + 4 * fq) * 2), v1 = *(const LAS u32x2*)(Vs + (dvt * 16 + fr) * 144 + (32 * k2 + 16 + 4 * fq) * 2);
                    const u32x4 vw = {v0.x, v0.y, v1.x, v1.y};
                    acc = mfma16(__builtin_bit_cast(bf16x8, vw), pf[k2], acc); }
                o[dvt] = acc; }
        }
    }
    const float il = 1.f / lrun;
    bf16_t* br2 = (bf16_t*)(a.ws + WS_BR) + (size_t)2 * M * 512;
#pragma unroll
    for (int dvt = 0; dvt < 8; ++dvt) { u32x2 w; w.x = cvt_pk_bf16(o[dvt][0] * il, o[dvt][1] * il); w.y = cvt_pk_bf16(o[dvt][2] * il, o[dvt][3] * il);
        *(u32x2*)(br2 + (size_t)(m0 + r) * 512 + h * 128 + dvt * 16 + 4 * fq) = w; }
    __syncthreads();
}

__device__ __forceinline__ void phase_ln(const Args& a, const float* gam, const float* bet, int G) {
    const int tid = otid(), lane = tid & 63, wave = tid >> 6;
    bf16_t* xbf = (bf16_t*)(a.ws + WS_XBF);
    f32x4 gv[4], bv[4];
#pragma unroll
    for (int j = 0; j < 4; ++j) { gv[j] = *(const f32x4*)(gam + 4 * lane + 256 * j); bv[j] = *(const f32x4*)(bet + 4 * lane + 256 * j); }
    for (int m = blockIdx.x * NWAVES + wave; m < M; m += G * NWAVES) {
        f32x4* xr = (f32x4*)(a.out + (size_t)m * D) + lane;
        f32x4 v[4]; float s = 0.f;
#pragma unroll
        for (int j = 0; j < 4; ++j) { v[j] = xr[64 * j]; s += (v[j][0] + v[j][1]) + (v[j][2] + v[j][3]); }
        const float mean = wave_sum(s) * (1.f / D); float s2 = 0.f;
#pragma unroll
        for (int j = 0; j < 4; ++j) { v[j] = v[j] - mean; s2 += (v[j][0] * v[j][0] + v[j][1] * v[j][1]) + (v[j][2] * v[j][2] + v[j][3] * v[j][3]); }
        const float rstd = 1.f / sqrtf(wave_sum(s2) * (1.f / D) + LN_EPS);
        u32x2* o8 = (u32x2*)(xbf + (size_t)m * D) + lane;
#pragma unroll
        for (int j = 0; j < 4; ++j) { const f32x4 y = v[j] * rstd * gv[j] + bv[j]; xr[64 * j] = y; o8[64 * j] = (u32x2){cvt_pk_bf16(y[0], y[1]), cvt_pk_bf16(y[2], y[3])}; }
    }
}

__global__ void __launch_bounds__(NTHREADS, 2) fwd_mega(Args a) {
    extern __shared__ __attribute__((aligned(16))) unsigned char lds_raw[];
    LAS unsigned char* lds = (LAS unsigned char*)lds_raw;
    cg::grid_group grid = cg::this_grid();
    volatile LAS unsigned* bst = (volatile LAS unsigned*)(lds + LDS_BYTES - 64);
    if (threadIdx.x == 0) { bst[0] = 0u; bst[1] = 0u; }
    __syncthreads();
    XcdBarrier xbar = xcd_barrier_post((unsigned*)(a.ws + WS_CTL), bst);
    const int G = gridDim.x, bid = blockIdx.x;
    const float ALPHA = 1.6817928305074290f;
    bf16_t* xbf = (bf16_t*)(a.ws + WS_XBF); bf16_t* proj = (bf16_t*)(a.ws + WS_PROJ);
    for (int ph = a.ph_lo; ph < a.ph_hi; ++ph) {
        const int l = ph / PH_PER_LAYER, k = ph % PH_PER_LAYER;
        switch (k) {
        case 0: if (l == 0) phase_prep(a, 0, lds, G); break;
        case 1: { pg8::Gemm g{xbf, (const bf16_t*)(a.ws + WS_WIN), M, NP, D, D}; pg8::StaticOrder S; S.init(M, NP, G, bid);
                  pg8::EpiStore<0> E{proj, NP}; pg8::gemm_phase(lds, g, S, E); } break;
        case 2: {
                  for (int u = bid; u < 1792; u += G) { if (u < 256) moba_prep_unit(a, lds, u); else if (u < 768) gmlp_unit(a, l, lds, u - 256); else gla_kv_unit(a, l, lds, u - 768); } } break;
        case 3: { gla_scan(a, G);
                  for (int i = 0;; ++i) { const int u = i * G + bid; if (u >= 512) break;
                      int qt, bh; if (u < 256) { qt = 63 - (u >> 3); bh = u & 7; } else { qt = (u - 256) >> 3; bh = u & 7; }
                      moba_attn_unit(a, lds, bh >> 2, bh & 3, qt); } } break;
        case 4: { for (int u = bid; u < 1024; u += G) gla_out_unit(a, l, lds, u); } break;
        case 5: { pg8::Gemm g{(const bf16_t*)(a.ws + WS_BR), (const bf16_t*)(a.ws + WS_WBR), 3 * M, 3 * D, 512, 512}; pg8::MergeOrder S{G, bid};
                  pg8::EpiMerge E{proj, (float*)(a.ws + WS_PROJ), (bf16_t*)(a.ws + WS_MERGED)}; pg8::gemm_phase(lds, g, S, E); } break;
        case 6: { pg8::Gemm g{(const bf16_t*)(a.ws + WS_MERGED), (const bf16_t*)(a.ws + WS_WOUT), M, D, D, D}; pg8::StaticOrder S; S.init(M, D, G, bid);
                  pg8::EpiResid E{l == 0 ? a.x : a.out, a.out, ALPHA}; pg8::gemm_phase(lds, g, S, E); } break;
        case 7: phase_ln(a, a.ln1_g + (size_t)l * D, a.ln1_b + (size_t)l * D, G); break;
        case 8: { pg8::Gemm g{xbf, (const bf16_t*)(a.ws + WS_W1), M, FF, D, D}; pg8::StaticOrder S; S.init(M, FF, G, bid);
                  pg8::EpiStore<2> E{proj, FF}; pg8::gemm_phase(lds, g, S, E); } break;
        case 9: { pg8::Gemm g{proj, (const bf16_t*)(a.ws + WS_W2), M, D, FF, FF}; pg8::StaticOrder S; S.init(M, D, G, bid);
                  pg8::EpiResid E{a.out, a.out, ALPHA}; pg8::gemm_phase(lds, g, S, E); } break;
        default: phase_ln(a, a.ln2_g + (size_t)l * D, a.ln2_b + (size_t)l * D, G); if (l + 1 < DEPTH) phase_prep(a, l + 1, lds, G); break;
        }
        if (ph + 1 < a.ph_hi && !(ph % PH_PER_LAYER == 0 && ph > 0)) { if (ph == 0) grid.sync(); else xcd_barrier(xbar); }
    }
}

#ifndef MK_PER_PHASE
#define MK_PER_PHASE 0
#endif
extern "C" void kernel_launch(void* const* d_in, const int* in_sizes, int n_in, void* d_out, int out_size, void* d_ws, size_t ws_size, hipStream_t stream) {
    static int grid = 0;
    if (grid == 0) {
        if (n_in != 18 || out_size != M * D || ws_size < WS_END) { fprintf(stderr, "kernel_launch: unexpected problem (n_in %d out %d ws %zu)\n", n_in, out_size, ws_size); grid = -1; return; }
        int dev = 0, cus = 0, per_cu = 0;
        if (hipGetDevice(&dev) != hipSuccess || hipDeviceGetAttribute(&cus, hipDeviceAttributeMultiprocessorCount, dev) != hipSuccess) { grid = -1; return; }
        if (hipFuncSetAttribute((const void*)fwd_mega, hipFuncAttributeMaxDynamicSharedMemorySize, LDS_BYTES) != hipSuccess) { fprintf(stderr, "kernel_launch: hipFuncSetAttribute failed\n"); grid = -1; return; }
        if (hipOccupancyMaxActiveBlocksPerMultiprocessor(&per_cu, (const void*)fwd_mega, NTHREADS, LDS_BYTES) != hipSuccess || per_cu < 1) { fprintf(stderr, "kernel_launch: occupancy query says %d\n", per_cu); per_cu = 1; }
        (void)hipGetLastError();
        grid = cus;
    }
    if (grid < 0) return;
    Args a{};
    a.x = (const float*)d_in[0]; a.pos = (const int*)d_in[1]; a.w_in = (const float*)d_in[2]; a.w_gate_up = (const float*)d_in[3]; a.b_gate = (const float*)d_in[4];
    a.gla_norm_w = (const float*)d_in[5]; a.gmlp_ln_g = (const float*)d_in[6]; a.gmlp_ln_b = (const float*)d_in[7]; a.gmlp_w_s = (const float*)d_in[8]; a.gmlp_b_s = (const float*)d_in[9];
    a.w_branch = (const float*)d_in[10]; a.w_out = (const float*)d_in[11]; a.ln1_g = (const float*)d_in[12]; a.ln1_b = (const float*)d_in[13]; a.w_ff1 = (const float*)d_in[14];
    a.w_ff2 = (const float*)d_in[15]; a.ln2_g = (const float*)d_in[16]; a.ln2_b = (const float*)d_in[17]; a.out = (float*)d_out; a.ws = (unsigned char*)d_ws;
    if (hipMemsetAsync((char*)d_ws + WS_CTL, 0, CTL_BYTES, stream) != hipSuccess) { fprintf(stderr, "kernel_launch: memset of barrier words failed\n"); return; }
#if MK_PER_PHASE
    for (int ph = 0; ph < N_PHASES; ++ph) { a.ph_lo = ph; a.ph_hi = ph + 1; hipLaunchKernelGGL(fwd_mega, dim3(grid), dim3(NTHREADS), LDS_BYTES, stream, a); }
#else
    a.ph_lo = 0; a.ph_hi = N_PHASES;
    void* args[] = {&a};
    hipError_t e = hipLaunchCooperativeKernel((const void*)fwd_mega, dim3(grid), dim3(NTHREADS), args, LDS_BYTES, stream);
    if (e != hipSuccess) fprintf(stderr, "kernel_launch: cooperative launch failed: %s (grid %d)\n", hipGetErrorString(e), grid);
#endif
}
```

```cpp
#include <hip/hip_runtime.h>
#include <hip/hip_cooperative_groups.h>
#include <cstdio>
#include <cstdint>
namespace cg = cooperative_groups;

#define LAS __attribute__((address_space(3)))
typedef unsigned short bf16_t;
typedef short bf16x8 __attribute__((ext_vector_type(8)));
typedef short s16x4 __attribute__((ext_vector_type(4)));
typedef float f32x4 __attribute__((ext_vector_type(4)));
typedef float f32x2 __attribute__((ext_vector_type(2)));
typedef unsigned u32x4 __attribute__((ext_vector_type(4)));
typedef unsigned u32x2 __attribute__((ext_vector_type(2)));

constexpr int BATCH = 2, SEQ = 8192, M = BATCH * SEQ, D = 1024, DEPTH = 4, FF = 4096;
constexpr int IN_COLS = 7696, NP = 7936, C_LR = 7680;
constexpr int C_GQ = 0, C_GK = 512, C_GV = 1024, C_GG = 1536, C_GZU = 2048, C_GZV = 2560, C_MQ = 3072, C_MK = 3584, C_MV = 4096, C_GL = 4608;
constexpr int NWAVES = 8, NTHREADS = 512;
constexpr int LDS_BYTES = 147456;
constexpr float LN_EPS = 1e-5f, RMS_EPS = 1e-6f;
constexpr int PH_PER_LAYER = 12, N_PHASES = DEPTH * PH_PER_LAYER;

constexpr size_t MiB = 1u << 20;
constexpr size_t WS_WIN = 0, WS_GLR = 15 * MiB, WS_WBR = 16 * MiB, WS_WOUT = 19 * MiB, WS_W1 = 21 * MiB, WS_W2 = 29 * MiB;
constexpr size_t WS_XBF = 38 * MiB;
constexpr size_t WS_BR = 70 * MiB;
constexpr size_t WS_ST = 118 * MiB;
constexpr size_t WS_DEC = 150 * MiB;
constexpr size_t WS_KMEAN = WS_DEC + 512 * 1024;
constexpr size_t WS_VT = 151 * MiB;
constexpr size_t WS_MERGED = 167 * MiB;
constexpr size_t WS_PROJ = 200 * MiB;
constexpr size_t WS_CTL = 448 * MiB, CTL_BYTES = 16384;
constexpr size_t WS_ML = 449 * MiB;
constexpr size_t WS_LIST = 451 * MiB;
constexpr size_t WS_END = 459 * MiB;

typedef __bf16 bf16x2_t __attribute__((ext_vector_type(2)));
__device__ __forceinline__ unsigned cvt_pk_bf16(float lo, float hi) { const f32x2 v = {lo, hi}; const bf16x2_t b = __builtin_convertvector(v, bf16x2_t); return __builtin_bit_cast(unsigned, b); }
__device__ __forceinline__ float bf2f(unsigned h) { return __builtin_bit_cast(float, h << 16); }
__device__ __forceinline__ float bflo(unsigned w) { return __builtin_bit_cast(float, w << 16); }
__device__ __forceinline__ float bfhi(unsigned w) { return __builtin_bit_cast(float, w & 0xffff0000u); }
__device__ __forceinline__ int otid() { int t = threadIdx.x; asm volatile("" : "+v"(t)); return t; }
__device__ __forceinline__ f32x4 mfma16(bf16x8 a, bf16x8 b, f32x4 c) { return __builtin_amdgcn_mfma_f32_16x16x32_bf16(a, b, c, 0, 0, 0); }

namespace pg8 {
constexpr int BM = 256, BK = 64, HALF = 128, HTB = HALF * BK * 2, NXCD = 8, WGM = 8;
__host__ __device__ __forceinline__ int lds_byte(int r, int c) { const int st = (r >> 4) * 2 + (c >> 5), rr = r & 15, cc = c & 31, ob = rr * 64 + cc * 2; return st * 1024 + (ob ^ (((ob >> 9) & 1) << 5)); }
__host__ __device__ __forceinline__ void stage_rc(int b, int& R, int& C) { const int st = b / 1024, sb = b % 1024, swz = sb ^ (((sb >> 9) & 1) << 5); R = (st >> 1) * 16 + swz / 64; C = (st & 1) * 32 + (swz % 64) / 2; }
__host__ __device__ __forceinline__ int perm32(int rho) { const int n = rho >> 4, i = rho & 15; return 8 * (i >> 2) + 4 * n + (i & 3); }

struct Unit { int pm, pn; };
struct Gemm { const bf16_t* A; const bf16_t* Bt; int M, N, K, lda; };

struct StaticOrder {
    int nM, nN, nwg, G, c;
    __device__ void init(int M_, int N_, int G_, int c_) { nM = M_ / BM; nN = N_ / BM; nwg = nM * nN; G = G_; c = c_; }
    __device__ bool next(int i, Unit& u) const {
        const long L = (long)i * G + c; if (L >= nwg) return false;
        int wgid = (int)L; { const int q = nwg / NXCD, r = nwg % NXCD, xcd = wgid % NXCD, off = wgid / NXCD; wgid = (xcd < r ? xcd * (q + 1) : r * (q + 1) + (xcd - r) * q) + off; }
        const int nig = WGM * nN, gid = wgid / nig, fm = gid * WGM, gsz = (nM - fm) < WGM ? (nM - fm) : WGM;
        u.pm = fm + ((wgid % nig) % gsz); u.pn = (wgid % nig) / gsz; return true;
    }
};
struct MergeOrder {
    int G, c;
    __device__ bool next(int i, Unit& u) const { const int t = (i / 3) * G + c; if (t >= 256) return false; const int br = i % 3; u.pm = br * 64 + (t >> 2); u.pn = br * 4 + (t & 3); return true; }
};

template <int ACT  > struct EpiStore {
    bf16_t* O; int ldc;
    __device__ __forceinline__ void operator()(const f32x4 (&acc)[2][2][4][2], const Unit& u, int wr, int wc, int fr, int fq) const {
        const int row0 = u.pm * BM + wr * 64 + fr, col0 = u.pn * BM + wc * 32 + 8 * fq;
#pragma unroll
        for (int ai = 0; ai < 2; ++ai)
#pragma unroll
            for (int m = 0; m < 4; ++m) { bf16_t* rowp = O + (size_t)(row0 + ai * HALF + m * 16) * ldc + col0;
#pragma unroll
                for (int bj = 0; bj < 2; ++bj) { f32x4 v0 = acc[ai][bj][m][0], v1 = acc[ai][bj][m][1];
                    if (ACT == 2) {
#pragma unroll
                        for (int e = 0; e < 4; ++e) { float a = fmaxf(v0[e], 0.f), b = fmaxf(v1[e], 0.f); v0[e] = a * a; v1[e] = b * b; } }
                    u32x4 w; w.x = cvt_pk_bf16(v0[0], v0[1]); w.y = cvt_pk_bf16(v0[2], v0[3]); w.z = cvt_pk_bf16(v1[0], v1[1]); w.w = cvt_pk_bf16(v1[2], v1[3]);
                    *(u32x4*)(rowp + bj * HALF) = w; } }
    }
};
struct EpiResid {
    const float* R; float* O; float alpha;
    __device__ __forceinline__ void operator()(const f32x4 (&acc)[2][2][4][2], const Unit& u, int wr, int wc, int fr, int fq) const {
        const int row0 = u.pm * BM + wr * 64 + fr, col0 = u.pn * BM + wc * 32 + 8 * fq;
#pragma unroll
        for (int ai = 0; ai < 2; ++ai)
#pragma unroll
            for (int m = 0; m < 4; ++m) { const size_t off = (size_t)(row0 + ai * HALF + m * 16) * 1024 + col0;
#pragma unroll
                for (int bj = 0; bj < 2; ++bj) { const f32x4 r0 = *(const f32x4*)(R + off + bj * HALF), r1 = *(const f32x4*)(R + off + bj * HALF + 4);
                    *(f32x4*)(O + off + bj * HALF) = r0 * alpha + acc[ai][bj][m][0]; *(f32x4*)(O + off + bj * HALF + 4) = r1 * alpha + acc[ai][bj][m][1]; } }
    }
};
struct EpiMerge {
    const bf16_t* proj; float* stash; bf16_t* merged;
    __device__ __forceinline__ void operator()(const f32x4 (&acc)[2][2][4][2], const Unit& u, int wr, int wc, int fr, int fq) const {
        const int br = u.pm >> 6, tm = u.pm & 63, tn = u.pn & 3;
        const int row0 = tm * BM + wr * 64 + fr, col0 = tn * BM + wc * 32 + 8 * fq;
#pragma unroll
        for (int ai = 0; ai < 2; ++ai)
#pragma unroll
            for (int m = 0; m < 4; ++m) { const int row = row0 + ai * HALF + m * 16;
#pragma unroll
                for (int bj = 0; bj < 2; ++bj) { const int col = col0 + bj * HALF;
                    const u32x4 gw = *(const u32x4*)(proj + (size_t)row * NP + C_GL + br * 1024 + col);
                    float g[8] = {bflo(gw.x), bfhi(gw.x), bflo(gw.y), bfhi(gw.y), bflo(gw.z), bfhi(gw.z), bflo(gw.w), bfhi(gw.w)};
                    f32x4 v0, v1;
#pragma unroll
                    for (int e = 0; e < 4; ++e) { v0[e] = acc[ai][bj][m][0][e] / (1.f + __expf(-g[e])); v1[e] = acc[ai][bj][m][1][e] / (1.f + __expf(-g[4 + e])); }
                    float* sp = stash + (size_t)row * (NP / 2) + col;
                    if (br == 0) { *(f32x4*)sp = v0; *(f32x4*)(sp + 4) = v1; }
                    else { v0 += *(const f32x4*)sp; v1 += *(const f32x4*)(sp + 4);
                        if (br == 1) { *(f32x4*)sp = v0; *(f32x4*)(sp + 4) = v1; }
                        else { u32x4 w; w.x = cvt_pk_bf16(v0[0], v0[1]); w.y = cvt_pk_bf16(v0[2], v0[3]); w.z = cvt_pk_bf16(v1[0], v1[1]); w.w = cvt_pk_bf16(v1[2], v1[3]);
                            *(u32x4*)(merged + (size_t)row * 1024 + col) = w; } } } }
    }
};

template <class Epi, class Sched>
__device__ __forceinline__ void gemm_phase(LAS unsigned char* lds, const Gemm g, const Sched& S, const Epi& E) {
    const int tid = otid(), wid = __builtin_amdgcn_readfirstlane(tid >> 6), lane = tid & 63, wr = wid >> 2, wc = wid & 3, fr = lane & 15, fq = lane >> 4;
    const int K = g.K, nt = K / BK, lda = g.lda;
    unsigned voffA[2], voffB[2];
#pragma unroll
    for (int i = 0; i < 2; ++i) { int R, C; stage_rc(tid * 16 + i * 8192, R, C); const int Rb = (R & ~31) + perm32(R & 31);
        voffA[i] = (unsigned)(R * lda + C) * 2u; voffB[i] = (unsigned)(Rb * K + C) * 2u; }
    const size_t kstep = (size_t)(BK * 2);
    const size_t hstepA = (size_t)HALF * lda * 2, hstepB = (size_t)HALF * K * 2;
    const size_t tstepA = 2 * hstepA, tstepB = 2 * hstepB;
    const unsigned ldsw = (unsigned)wid * 1024u;
    const int aoff = lds_byte(wr * 64 + fr, fq * 8), boff = lds_byte(wc * 32 + fr, fq * 8);
#define PG8_SA(b, h) (((b) * 2 + (h)) * HTB)
#define PG8_SB(b, h) ((4 + (b) * 2 + (h)) * HTB)
#define PG8_STAGE(bufoff, gbase, voff) do { _Pragma("unroll") for (int _i = 0; _i < 2; ++_i) \
        __builtin_amdgcn_global_load_lds((const unsigned*)((const char*)(gbase) + (voff)[_i]), (LAS unsigned*)(lds + (bufoff) + ldsw + _i * 8192), 16, 0, 0); } while (0)
#define PG8_LDA(dst, b, h) do { _Pragma("unroll") for (int m = 0; m < 4; ++m) _Pragma("unroll") for (int k = 0; k < 2; ++k) dst[m][k] = *(const LAS bf16x8*)(lds + PG8_SA(b, h) + aoff + m * 2048 + k * 1024); } while (0)
#define PG8_LDB(dst, b, h) do { _Pragma("unroll") for (int n = 0; n < 2; ++n) _Pragma("unroll") for (int k = 0; k < 2; ++k) dst[n][k] = *(const LAS bf16x8*)(lds + PG8_SB(b, h) + boff + n * 2048 + k * 1024); } while (0)
#define PG8_MMA(ai, bj, At, Bt) do { __builtin_amdgcn_s_setprio(1); _Pragma("unroll") for (int m = 0; m < 4; ++m) _Pragma("unroll") for (int n = 0; n < 2; ++n) _Pragma("unroll") for (int k = 0; k < 2; ++k) \
        acc[ai][bj][m][n] = __builtin_amdgcn_mfma_f32_16x16x32_bf16(Bt[n][k], At[m][k], acc[ai][bj][m][n], 0, 0, 0); __builtin_amdgcn_s_setprio(0); } while (0)
#define PG8_WAIT_V(n) asm volatile("s_waitcnt vmcnt(" #n ")" ::: "memory")
#define PG8_WAIT_L(n) asm volatile("s_waitcnt lgkmcnt(" #n ")" ::: "memory")
#define PG8_BAR __builtin_amdgcn_s_barrier()
#define PG8_SCHED __builtin_amdgcn_sched_barrier(0)
    Unit cur, nxt; int ui = 0;
    if (!S.next(0, cur)) return;
    f32x4 acc[2][2][4][2];
#pragma unroll
    for (int a = 0; a < 2; ++a)
#pragma unroll
        for (int b = 0; b < 2; ++b)
#pragma unroll
            for (int m = 0; m < 4; ++m)
#pragma unroll
                for (int n = 0; n < 2; ++n) acc[a][b][m][n] = (f32x4){0.f, 0.f, 0.f, 0.f};
    bf16x8 At[4][2], B0[2][2], B1[2][2];
    const char* cA = (const char*)g.A + (size_t)cur.pm * tstepA; const char* cB = (const char*)g.Bt + (size_t)cur.pn * tstepB;
    PG8_STAGE(PG8_SB(0, 0), cB, voffB); PG8_STAGE(PG8_SB(0, 1), cB + hstepB, voffB); PG8_STAGE(PG8_SA(0, 0), cA, voffA); PG8_STAGE(PG8_SA(0, 1), cA + hstepA, voffA);
    if (wr == 1) PG8_BAR;
    PG8_WAIT_V(2); PG8_BAR;
    PG8_STAGE(PG8_SB(1, 0), cB + kstep, voffB); PG8_STAGE(PG8_SA(1, 0), cA + kstep, voffA); PG8_STAGE(PG8_SB(1, 1), cB + hstepB + kstep, voffB);
    PG8_WAIT_V(6); PG8_BAR;
    for (;;) {
        const bool has_next = S.next(ui + 1, nxt);
        const char* nA = has_next ? (const char*)g.A + (size_t)nxt.pm * tstepA : cA; const char* nB = has_next ? (const char*)g.Bt + (size_t)nxt.pn * tstepB : cB;
        for (int t = 0; t < nt; t += 2) {
            const bool last = (t == nt - 2);
            const char* a1 = cA + (size_t)(t + 1) * kstep;
            const char* a2 = last ? nA : cA + (size_t)(t + 2) * kstep; const char* b2 = last ? nB : cB + (size_t)(t + 2) * kstep;
            const char* a3 = a2 + kstep; const char* b3 = b2 + kstep;
            PG8_LDB(B0, 0, 0); PG8_LDB(B1, 0, 1); PG8_SCHED; PG8_LDA(At, 0, 0); PG8_STAGE(PG8_SA(1, 1), a1 + hstepA, voffA);
            PG8_WAIT_V(8); PG8_WAIT_L(0); PG8_BAR; PG8_MMA(0, 0, At, B0); PG8_MMA(0, 1, At, B1); PG8_BAR; PG8_SCHED;
            PG8_LDA(At, 0, 1); PG8_STAGE(PG8_SB(0, 0), b2, voffB); PG8_STAGE(PG8_SB(0, 1), b2 + hstepB, voffB); PG8_STAGE(PG8_SA(0, 0), a2, voffA);
            PG8_WAIT_V(8); PG8_WAIT_L(0); PG8_BAR; PG8_MMA(1, 0, At, B0); PG8_MMA(1, 1, At, B1); PG8_BAR; PG8_SCHED;
            PG8_LDB(B0, 1, 0); PG8_LDB(B1, 1, 1); PG8_SCHED; PG8_LDA(At, 1, 0); PG8_STAGE(PG8_SA(0, 1), a2 + hstepA, voffA);
            PG8_WAIT_V(8); PG8_WAIT_L(0); PG8_BAR; PG8_MMA(0, 0, At, B0); PG8_MMA(0, 1, At, B1); PG8_BAR; PG8_SCHED;
            PG8_LDA(At, 1, 1); PG8_STAGE(PG8_SB(1, 0), b3, voffB); PG8_STAGE(PG8_SB(1, 1), b3 + hstepB, voffB); PG8_STAGE(PG8_SA(1, 0), a3, voffA);
            PG8_WAIT_V(8); PG8_WAIT_L(0); PG8_BAR; PG8_MMA(1, 0, At, B0); PG8_MMA(1, 1, At, B1); PG8_BAR; PG8_SCHED;
        }
        if (wr == 0) PG8_BAR;
        E(acc, cur, wr, wc, fr, fq);
        if (!has_next) break;
#pragma unroll
        for (int a = 0; a < 2; ++a)
#pragma unroll
            for (int b = 0; b < 2; ++b)
#pragma unroll
                for (int m = 0; m < 4; ++m)
#pragma unroll
                    for (int n = 0; n < 2; ++n) acc[a][b][m][n] = (f32x4){0.f, 0.f, 0.f, 0.f};
        cur = nxt; cA = nA; cB = nB; ++ui;
        if (wr == 1) PG8_BAR;
    }
    PG8_WAIT_V(0);
    PG8_BAR;
#undef PG8_SA
#undef PG8_SB
#undef PG8_STAGE
#undef PG8_LDA
#undef PG8_LDB
#undef PG8_MMA
#undef PG8_WAIT_V
#undef PG8_WAIT_L
#undef PG8_BAR
#undef PG8_SCHED
}
}


#define XB_TMO      128
#define XB_XCNT(j)  (256  + 64 * (j))
#define XB_XSUB(j)  (1280 + 64 * (j))
#define XB_XGEN(j)  (2304 + 64 * (j))
#define XB_TOP      3328
#define XB_TOPGEN   3392
#define XCD_BAR_WORDS 3456
#define XB_SPIN_CAP (1u << 18)
__device__ __forceinline__ unsigned xb_ld(unsigned* p)              { return __hip_atomic_load(p, __ATOMIC_RELAXED, __HIP_MEMORY_SCOPE_AGENT); }
__device__ __forceinline__ unsigned xb_add(unsigned* p, unsigned v) { return __hip_atomic_fetch_add(p, v, __ATOMIC_RELAXED, __HIP_MEMORY_SCOPE_AGENT); }
__device__ __forceinline__ unsigned xb_xcc_id() { return (unsigned)__builtin_amdgcn_s_getreg((3 << 11) | 20) & 0xFu; }
#define XB_SPIN(cond, bar) do { unsigned _sp = 0; while (cond) { __builtin_amdgcn_s_sleep(1); \
    if ((++_sp & 255u) == 0u) { if (xb_ld(&(bar)[XB_TMO])) break; if (_sp > XB_SPIN_CAP) { atomicAdd(&(bar)[XB_TMO], 1u); break; } } } } while (0)
struct XcdBarrier { unsigned* bar; unsigned x; volatile LAS unsigned* st; };
__device__ __forceinline__ XcdBarrier xcd_barrier_post(unsigned* bar, volatile LAS unsigned* st) {
    XcdBarrier b; b.bar = bar; b.x = xb_xcc_id(); b.st = st;
    if (threadIdx.x == 0) (void)xb_add(&bar[XB_XCNT(b.x)], 1u);
    return b;
}
__device__ __forceinline__ void xcd_barrier_complete(unsigned* bar, unsigned x, unsigned& nloc, unsigned& nx) {
    const unsigned G = gridDim.x * gridDim.y * gridDim.z;
    unsigned sum, cnt, mine, sp = 0u;
    for (;;) {
        sum = 0u; cnt = 0u; mine = 0u;
#pragma unroll
        for (unsigned j = 0; j < 16; ++j) { const unsigned c = xb_ld(&bar[XB_XCNT(j)]); sum += c; cnt += (c > 0u) ? 1u : 0u; mine = (j == x) ? c : mine; }
        if (sum == G) break;
        __builtin_amdgcn_s_sleep(1);
        if ((++sp & 255u) == 0u) { if (xb_ld(&bar[XB_TMO])) break; if (sp > XB_SPIN_CAP) { atomicAdd(&bar[XB_TMO], 1u); break; } }
    }
    nloc = mine > 0u ? mine : 1u; nx = cnt > 0u ? cnt : 1u;
}
__device__ __forceinline__ void xcd_barrier(const XcdBarrier& b) {
    asm volatile("s_waitcnt vmcnt(0)" ::: "memory");
    __syncthreads();
    if (threadIdx.x == 0) {
        unsigned* bar = b.bar;
        __builtin_amdgcn_s_waitcnt(0);
        unsigned nloc = b.st[0], nx = b.st[1];
        if (nloc == 0u) { xcd_barrier_complete(bar, b.x, nloc, nx); b.st[0] = nloc; b.st[1] = nx; }
        const unsigned old = xb_add(&bar[XB_XSUB(b.x)], 1u);
        const unsigned gen = old / nloc;
        if (old + 1u == (gen + 1u) * nloc) {
            __builtin_amdgcn_fence(__ATOMIC_RELEASE, "agent");
            asm volatile("s_waitcnt vmcnt(0)" ::: "memory");
            const unsigned og = xb_add(&bar[XB_TOP], 1u);
            const unsigned tg = og / nx;
            if (og + 1u == (tg + 1u) * nx) xb_add(&bar[XB_TOPGEN], 1u);
            else XB_SPIN(xb_ld(&bar[XB_TOPGEN]) == tg, bar);
            __builtin_amdgcn_fence(__ATOMIC_ACQUIRE, "agent");
            xb_add(&bar[XB_XGEN(b.x)], 1u);
            asm volatile("s_waitcnt vmcnt(0)" ::: "memory");
        } else {
            XB_SPIN(xb_ld(&bar[XB_XGEN(b.x)]) == gen, bar);
            __builtin_amdgcn_fence(__ATOMIC_ACQUIRE, "agent");
            asm volatile("s_waitcnt vmcnt(0)" ::: "memory");
        }
    }
    __syncthreads();
}

struct Args {
    const float* x; const int* pos; const float* w_in; const float* w_gate_up; const float* b_gate; const float* gla_norm_w; const float* gmlp_ln_g; const float* gmlp_ln_b;
    const float* gmlp_w_s; const float* gmlp_b_s; const float* w_branch; const float* w_out; const float* ln1_g; const float* ln1_b; const float* w_ff1; const float* w_ff2;
    const float* ln2_g; const float* ln2_b; float* out; unsigned char* ws; int ph_lo, ph_hi;
};

__device__ __forceinline__ float wave_sum(float v) {
#pragma unroll
    for (int o = 1; o < 64; o <<= 1) v += __shfl_xor(v, o);
    return v;
}

__device__ __forceinline__ void transpose_item(const float* W, int ldw, int col0, int K, int nblk, bf16_t* WT, int row_off, LAS float* scr, int item, int lane) {
    const int kb = item / nblk, nb = item % nblk, k0 = 64 * kb, n0 = 32 * nb;
#pragma unroll 8
    for (int i = 0; i < 32; ++i) { const int kk = 2 * i + (lane >> 5); scr[kk * 33 + (lane & 31)] = W[(size_t)(k0 + kk) * ldw + col0 + n0 + (lane & 31)]; }
    asm volatile("s_waitcnt lgkmcnt(0)" ::: "memory");
    const int c = lane & 7;
#pragma unroll
    for (int j = 0; j < 4; ++j) { const int n = (lane >> 3) + 8 * j; const LAS float* s = scr + (8 * c) * 33 + n;
        u32x4 o; o.x = cvt_pk_bf16(s[0 * 33], s[1 * 33]); o.y = cvt_pk_bf16(s[2 * 33], s[3 * 33]); o.z = cvt_pk_bf16(s[4 * 33], s[5 * 33]); o.w = cvt_pk_bf16(s[6 * 33], s[7 * 33]);
        *(u32x4*)(WT + (size_t)(row_off + n0 + n) * K + k0 + 8 * c) = o; }
    asm volatile("s_waitcnt lgkmcnt(0)" ::: "memory");
}

__device__ __forceinline__ void phase_prep(const Args& a, int l, LAS unsigned char* lds, int G) {
    const int tid = otid(), lane = tid & 63, wave = tid >> 6;
    LAS float* scr = (LAS float*)(lds + wave * 16384);
    const int gw = blockIdx.x * NWAVES + wave, NGW = G * NWAVES;
    bf16_t* WinT = (bf16_t*)(a.ws + WS_WIN); bf16_t* WbrT = (bf16_t*)(a.ws + WS_WBR); bf16_t* WoutT = (bf16_t*)(a.ws + WS_WOUT); bf16_t* W1T = (bf16_t*)(a.ws + WS_W1); bf16_t* W2T = (bf16_t*)(a.ws + WS_W2);
    const float* win = a.w_in + (size_t)l * D * IN_COLS;
    constexpr int I_IN_A = 16 * 64, I_IN_B = 16 * 176, I_BR = 8 * 32, I_OUT = 16 * 32, I_1 = 16 * 128, I_2 = 64 * 32;
    constexpr int NITEMS = I_IN_A + I_IN_B + 3 * I_BR + I_OUT + I_1 + I_2;
    for (int it = gw; it < NITEMS; it += NGW) {
        int r = it;
        if (r < I_IN_A) { transpose_item(win, IN_COLS, 0, D, 64, WinT, 0, scr, r, lane); continue; } r -= I_IN_A;
        if (r < I_IN_B) { transpose_item(win, IN_COLS, 2064, D, 176, WinT, 2048, scr, r, lane); continue; } r -= I_IN_B;
        if (r < 3 * I_BR) { const int br = r / I_BR; transpose_item(a.w_branch + ((size_t)l * 3 + br) * 512 * 1024, 1024, 0, 512, 32, WbrT, br * 1024, scr, r % I_BR, lane); continue; } r -= 3 * I_BR;
        if (r < I_OUT) { transpose_item(a.w_out + (size_t)l * D * D, D, 0, D, 32, WoutT, 0, scr, r, lane); continue; } r -= I_OUT;
        if (r < I_1) { transpose_item(a.w_ff1 + (size_t)l * D * FF, FF, 0, D, 128, W1T, 0, scr, r, lane); continue; } r -= I_1;
        transpose_item(a.w_ff2 + (size_t)l * FF * D, D, 0, FF, 32, W2T, 0, scr, r, lane);
    }
    { bf16_t* glrT = (bf16_t*)(a.ws + WS_GLR);
      const int e = blockIdx.x * NTHREADS + tid;
      if (e < 16 * 1024) { const int n = e >> 10, k = e & 1023; glrT[e] = (bf16_t)(cvt_pk_bf16(win[(size_t)k * IN_COLS + 2048 + n], 0.f) & 0xffffu); } }
    if (l == 0) {
        bf16_t* xbf = (bf16_t*)(a.ws + WS_XBF);
        for (size_t e = (size_t)(blockIdx.x * NTHREADS + tid) * 8; e < (size_t)M * D; e += (size_t)G * NTHREADS * 8) {
            const f32x4 v0 = *(const f32x4*)(a.x + e), v1 = *(const f32x4*)(a.x + e + 4);
            u32x4 w; w.x = cvt_pk_bf16(v0[0], v0[1]); w.y = cvt_pk_bf16(v0[2], v0[3]); w.z = cvt_pk_bf16(v1[0], v1[1]); w.w = cvt_pk_bf16(v1[2], v1[3]);
            *(u32x4*)(xbf + e) = w; }
    }
}

__device__ __forceinline__ void gla_bcum(const Args& a, int l, LAS unsigned char* lds, int m0, int h, float (&c)[16], float& bend) {
    const int tid = otid(), lane = tid & 63, wave = tid >> 6, fr = lane & 15, fq = lane >> 4;
    LAS float* lr = (LAS float*)lds; LAS float* tot = (LAS float*)(lds + 4352);
    const bf16_t* xbf = (const bf16_t*)(a.ws + WS_XBF); const bf16_t* glrT = (const bf16_t*)(a.ws + WS_GLR);
    if (tid < 128) {
        const int s = tid >> 1, hf = tid & 1;
        const u32x4 w = *(const u32x4*)((const bf16_t*)(a.ws + WS_PROJ) + (size_t)(m0 + s) * NP + C_LR + hf * 8);
        LAS float* lp = lr + s * 17 + hf * 8;
        lp[0] = bflo(w.x); lp[1] = bfhi(w.x); lp[2] = bflo(w.y); lp[3] = bfhi(w.y); lp[4] = bflo(w.z); lp[5] = bfhi(w.z); lp[6] = bflo(w.w); lp[7] = bfhi(w.w);
    }
    __syncthreads();
    const int d = tid & 127, g = tid >> 7, col = h * 128 + d;
    float wu[16];
#pragma unroll
    for (int r = 0; r < 16; ++r) wu[r] = a.w_gate_up[((size_t)l * 16 + r) * 512 + col];
    const float bg = a.b_gate[(size_t)l * 512 + col];
    float run = 0.f;
#pragma unroll
    for (int i = 0; i < 16; ++i) { const int s = g * 16 + i; float z = bg;
#pragma unroll
        for (int r = 0; r < 16; ++r) z += lr[s * 17 + r] * wu[r];
        const float la = (fminf(z, 0.f) - log1pf(__expf(-fabsf(z)))) * (1.f / 16.f);
        run += la; c[i] = run; }
    tot[g * 128 + d] = run;
    __syncthreads();
    float pre = 0.f, all = 0.f;
#pragma unroll
    for (int gg = 0; gg < 4; ++gg) { const float t = tot[gg * 128 + d]; all += t; if (gg < g) pre += t; }
#pragma unroll
    for (int i = 0; i < 16; ++i) c[i] += pre;
    bend = all;
}

__device__ __forceinline__ void gla_kv_unit(const Args& a, int l, LAS unsigned char* lds, int unit) {
    const int h = unit & 3, n = (unit >> 2) & 127, b = unit >> 9, m0 = b * SEQ + n * 64;
    const int tid = otid(), lane = tid & 63, wave = tid >> 6, fr = lane & 15, fq = lane >> 4;
    const bf16_t* proj = (const bf16_t*)(a.ws + WS_PROJ);
    float c[16], bend; gla_bcum(a, l, lds, m0, h, c, bend);
    const int d = tid & 127, g = tid >> 7, col = h * 128 + d;
    LAS unsigned char* keT = lds + 8192; LAS unsigned char* vT = lds + 8192 + 128 * 144;
    unsigned kw[8], vw[8];
#pragma unroll
    for (int i = 0; i < 16; i += 2) { const size_t r0 = (size_t)(m0 + g * 16 + i) * NP, r1 = r0 + NP;
        const float k0 = bf2f(proj[r0 + C_GK + col]) * __expf(bend - c[i]), k1 = bf2f(proj[r1 + C_GK + col]) * __expf(bend - c[i + 1]);
        kw[i >> 1] = cvt_pk_bf16(k0, k1); vw[i >> 1] = (unsigned)proj[r0 + C_GV + col] | ((unsigned)proj[r1 + C_GV + col] << 16); }
    *(LAS u32x4*)(keT + d * 144 + g * 32) = (u32x4){kw[0], kw[1], kw[2], kw[3]}; *(LAS u32x4*)(keT + d * 144 + g * 32 + 16) = (u32x4){kw[4], kw[5], kw[6], kw[7]};
    *(LAS u32x4*)(vT + d * 144 + g * 32) = (u32x4){vw[0], vw[1], vw[2], vw[3]}; *(LAS u32x4*)(vT + d * 144 + g * 32 + 16) = (u32x4){vw[4], vw[5], vw[6], vw[7]};
    const int bh = b * 4 + h;
    if (g == 0) ((float*)(a.ws + WS_DEC))[((size_t)bh * 128 + n) * 128 + d] = __expf(bend);
    __syncthreads();
    bf16_t* ST = (bf16_t*)(a.ws + WS_ST) + ((size_t)bh * 128 + n) * 16384;
    bf16x8 af[2];
#pragma unroll
    for (int kk = 0; kk < 2; ++kk) af[kk] = *(const LAS bf16x8*)(keT + (wave * 16 + fr) * 144 + kk * 64 + fq * 16);
#pragma unroll
    for (int dvt = 0; dvt < 8; ++dvt) { f32x4 acc = {0.f, 0.f, 0.f, 0.f};
#pragma unroll
        for (int kk = 0; kk < 2; ++kk) { const bf16x8 bv = *(const LAS bf16x8*)(vT + (dvt * 16 + fr) * 144 + kk * 64 + fq * 16); acc = mfma16(af[kk], bv, acc); }
        u32x2 w; w.x = cvt_pk_bf16(acc[0], acc[1]); w.y = cvt_pk_bf16(acc[2], acc[3]);
        *(u32x2*)(ST + (size_t)(dvt * 16 + fr) * 128 + wave * 16 + 4 * fq) = w; }
    __syncthreads();
}

__device__ __forceinline__ void gla_scan(const Args& a, int G) {
    const int tid = otid();
    for (int e = blockIdx.x * NTHREADS + tid; e < 8 * 128 * 64; e += G * NTHREADS) {
        const int dkp = e & 63, dv = (e >> 6) & 127, bh = e >> 13;
        unsigned* st = (unsigned*)(a.ws + WS_ST) + ((size_t)bh * 128 * 16384 + (size_t)dv * 128) / 2 + dkp;
        const f32x2* dec = (const f32x2*)(a.ws + WS_DEC) + ((size_t)bh * 128 * 128) / 2 + dkp;
        float s0 = 0.f, s1 = 0.f;
#pragma unroll 8
        for (int n = 0; n < 128; ++n) { const unsigned kv = st[(size_t)n * 8192]; const f32x2 dc = dec[n * 64];
            st[(size_t)n * 8192] = cvt_pk_bf16(s0, s1);
            s0 = dc.x * s0 + bflo(kv); s1 = dc.y * s1 + bfhi(kv); }
    }
}

__device__ __forceinline__ void gla_out_unit(const Args& a, int l, LAS unsigned char* lds, int unit) {
    const int h = unit & 3, n = (unit >> 2) & 127, b = unit >> 9, m0 = b * SEQ + n * 64;
    const int tid = otid(), lane = tid & 63, wave = tid >> 6, fr = lane & 15, fq = lane >> 4;
    const bf16_t* proj = (const bf16_t*)(a.ws + WS_PROJ);
    float c[16], bend; gla_bcum(a, l, lds, m0, h, c, bend);
    const int d = tid & 127, g = tid >> 7, col = h * 128 + d;
    LAS unsigned char* qd = lds + 8192;
    LAS unsigned char* ki = qd + 64 * 272;
    LAS unsigned char* vT = ki + 64 * 272;
    LAS unsigned char* at = vT + 128 * 144;
    LAS float* ssq = (LAS float*)(at + 64 * 144);
    unsigned vw[8];
#pragma unroll
    for (int i = 0; i < 16; i += 2) { const size_t r0 = (size_t)(m0 + g * 16 + i) * NP, r1 = r0 + NP;
        const float e0 = __expf(c[i]), e1 = __expf(c[i + 1]);
        const float q0 = bf2f(proj[r0 + C_GQ + col]) * e0, q1 = bf2f(proj[r1 + C_GQ + col]) * e1;
        const float k0 = bf2f(proj[r0 + C_GK + col]) * 0.08838834764831845f / e0, k1 = bf2f(proj[r1 + C_GK + col]) * 0.08838834764831845f / e1;
        *(LAS bf16_t*)(qd + (g * 16 + i) * 272 + d * 2) = (bf16_t)(cvt_pk_bf16(q0, 0.f) & 0xffffu); *(LAS bf16_t*)(qd + (g * 16 + i + 1) * 272 + d * 2) = (bf16_t)(cvt_pk_bf16(q1, 0.f) & 0xffffu);
        *(LAS bf16_t*)(ki + (g * 16 + i) * 272 + d * 2) = (bf16_t)(cvt_pk_bf16(k0, 0.f) & 0xffffu); *(LAS bf16_t*)(ki + (g * 16 + i + 1) * 272 + d * 2) = (bf16_t)(cvt_pk_bf16(k1, 0.f) & 0xffffu);
        vw[i >> 1] = (unsigned)proj[r0 + C_GV + col] | ((unsigned)proj[r1 + C_GV + col] << 16); }
    *(LAS u32x4*)(vT + d * 144 + g * 32) = (u32x4){vw[0], vw[1], vw[2], vw[3]}; *(LAS u32x4*)(vT + d * 144 + g * 32 + 16) = (u32x4){vw[4], vw[5], vw[6], vw[7]};
    __syncthreads();
    { const int tt = wave >> 1;
      bf16x8 qf[4];
#pragma unroll
      for (int kk = 0; kk < 4; ++kk) qf[kk] = *(const LAS bf16x8*)(qd + (tt * 16 + fr) * 272 + kk * 64 + fq * 16);
#pragma unroll
      for (int s2 = 0; s2 < 2; ++s2) { const int stl = (wave & 1) * 2 + s2; f32x4 acc = {0.f, 0.f, 0.f, 0.f};
#pragma unroll
          for (int kk = 0; kk < 4; ++kk) { const bf16x8 kf = *(const LAS bf16x8*)(ki + (stl * 16 + fr) * 272 + kk * 64 + fq * 16); acc = mfma16(kf, qf[kk], acc); }
          const int t = tt * 16 + fr, s0 = stl * 16 + 4 * fq;
#pragma unroll
          for (int jj = 0; jj < 4; ++jj) if (s0 + jj > t) acc[jj] = 0.f;
          u32x2 w; w.x = cvt_pk_bf16(acc[0], acc[1]); w.y = cvt_pk_bf16(acc[2], acc[3]);
          *(LAS u32x2*)(at + t * 144 + s0 * 2) = w; } }
    __syncthreads();
    const int tt = wave & 3, dvh = wave >> 2, bh = b * 4 + h;
    const bf16_t* ST = (const bf16_t*)(a.ws + WS_ST) + ((size_t)bh * 128 + n) * 16384;
    bf16x8 atf[2], qf[4];
#pragma unroll
    for (int kk = 0; kk < 2; ++kk) atf[kk] = *(const LAS bf16x8*)(at + (tt * 16 + fr) * 144 + kk * 64 + fq * 16);
#pragma unroll
    for (int kk = 0; kk < 4; ++kk) qf[kk] = *(const LAS bf16x8*)(qd + (tt * 16 + fr) * 272 + kk * 64 + fq * 16);
    f32x4 o[4]; float sq = 0.f;
#pragma unroll
    for (int j = 0; j < 4; ++j) { const int dvt = dvh * 4 + j; f32x4 acc = {0.f, 0.f, 0.f, 0.f};
#pragma unroll
        for (int kk = 0; kk < 2; ++kk) { const bf16x8 vf = *(const LAS bf16x8*)(vT + (dvt * 16 + fr) * 144 + kk * 64 + fq * 16); acc = mfma16(vf, atf[kk], acc); }
        f32x4 acs = {0.f, 0.f, 0.f, 0.f};
#pragma unroll
        for (int kk = 0; kk < 4; ++kk) { const bf16x8 sf = *(const bf16x8*)(ST + (size_t)(dvt * 16 + fr) * 128 + kk * 32 + fq * 8); acs = mfma16(sf, qf[kk], acs); }
        acc += acs * 0.08838834764831845f;
        o[j] = acc; sq += acc[0] * acc[0] + acc[1] * acc[1] + acc[2] * acc[2] + acc[3] * acc[3]; }
    sq += __shfl_xor(sq, 16); sq += __shfl_xor(sq, 32);
    if (fq == 0) ssq[dvh * 64 + tt * 16 + fr] = sq;
    __syncthreads();
    const float rs = 1.f / sqrtf((ssq[tt * 16 + fr] + ssq[64 + tt * 16 + fr]) * (1.f / 128.f) + RMS_EPS);
    const int m = m0 + tt * 16 + fr;
    bf16_t* br0 = (bf16_t*)(a.ws + WS_BR);
#pragma unroll
    for (int j = 0; j < 4; ++j) { const int dv = (dvh * 4 + j) * 16 + 4 * fq;
        const f32x4 nw = *(const f32x4*)(a.gla_norm_w + (size_t)l * 128 + dv);
        const u32x2 gw = *(const u32x2*)(proj + (size_t)m * NP + C_GG + h * 128 + dv);
        const float gg[4] = {bflo(gw.x), bfhi(gw.x), bflo(gw.y), bfhi(gw.y)}; float r[4];
#pragma unroll
        for (int e = 0; e < 4; ++e) r[e] = o[j][e] * rs * nw[e] * (gg[e] / (1.f + __expf(-gg[e])));
        u32x2 w; w.x = cvt_pk_bf16(r[0], r[1]); w.y = cvt_pk_bf16(r[2], r[3]);
        *(u32x2*)(br0 + (size_t)m * 512 + h * 128 + dv) = w; }
    __syncthreads();
}

__device__ __forceinline__ float gelu_erf(float v) {
    const float av = fabsf(v), t = __builtin_amdgcn_rcpf(av * 0.2316418882f + 1.0f);
    float q = t * 0.5307027145f + (-0.7265760135f); q = q * t + 0.7107068705f; q = q * t + (-0.142248368f); q = q * t + 0.127414796f; q = q * t;
    const float e = __builtin_amdgcn_exp2f((v * v) * (-0.72134752044f));
    const float m = v * (q * e);
    return v < 0.f ? m : v - m;
}
__device__ __forceinline__ void gmlp_unit(const Args& a, int l, LAS unsigned char* lds, int unit) {
    const int g = unit & 3, nc = (unit >> 2) & 63, b = unit >> 8, m0 = b * SEQ + nc * 128;
    const int tid = otid(), lane = tid & 63, wave = tid >> 6, fr = lane & 15, fq = lane >> 4;
    const bf16_t* proj = (const bf16_t*)(a.ws + WS_PROJ);
    LAS float* stats = (LAS float*)lds;
    LAS unsigned char* vnT = lds + 1024;
    LAS unsigned char* wm = vnT + 128 * 272;
    { const int tok = tid >> 2, part = tid & 3; const bf16_t* vp = proj + (size_t)(m0 + tok) * NP + C_GZV + part * 128;
      float s = 0.f, s2 = 0.f;
#pragma unroll 4
      for (int j = 0; j < 16; ++j) { const u32x4 w = *(const u32x4*)(vp + j * 8); const unsigned ww[4] = {w.x, w.y, w.z, w.w};
#pragma unroll
          for (int e = 0; e < 4; ++e) { const float g0 = gelu_erf(bflo(ww[e])), g1 = gelu_erf(bfhi(ww[e])); s += g0 + g1; s2 += g0 * g0 + g1 * g1; } }
      s += __shfl_xor(s, 1); s += __shfl_xor(s, 2); s2 += __shfl_xor(s2, 1); s2 += __shfl_xor(s2, 2);
      const float mean = s * (1.f / 512.f), var = fmaxf(s2 * (1.f / 512.f) - mean * mean, 0.f);
      if (part == 0) { stats[tok * 2] = mean; stats[tok * 2 + 1] = 1.f / sqrtf(var + LN_EPS); } }
    { const int t = tid >> 2, sq4 = (tid & 3) * 32; const float* wp = a.gmlp_w_s + (((size_t)l * 4 + g) * 128 + t) * 128 + sq4;
#pragma unroll
      for (int j = 0; j < 4; ++j) { const f32x4 w0 = *(const f32x4*)(wp + j * 8), w1 = *(const f32x4*)(wp + j * 8 + 4); float v[8] = {w0[0], w0[1], w0[2], w0[3], w1[0], w1[1], w1[2], w1[3]};
#pragma unroll
          for (int e = 0; e < 8; ++e) if (sq4 + j * 8 + e > t) v[e] = 0.f;
          *(LAS u32x4*)(wm + t * 272 + (sq4 + j * 8) * 2) = (u32x4){cvt_pk_bf16(v[0], v[1]), cvt_pk_bf16(v[2], v[3]), cvt_pk_bf16(v[4], v[5]), cvt_pk_bf16(v[6], v[7])}; } }
    __syncthreads();
    { const int cch = tid & 127, sg = tid >> 7; const float lg = a.gmlp_ln_g[(size_t)l * 512 + g * 128 + cch], lb = a.gmlp_ln_b[(size_t)l * 512 + g * 128 + cch];
#pragma unroll
      for (int j = 0; j < 4; ++j) { unsigned w[4];
#pragma unroll
          for (int e = 0; e < 4; ++e) { const int s0 = sg * 32 + j * 8 + e * 2;
              const float v0 = gelu_erf(bf2f(proj[(size_t)(m0 + s0) * NP + C_GZV + g * 128 + cch])), v1 = gelu_erf(bf2f(proj[(size_t)(m0 + s0 + 1) * NP + C_GZV + g * 128 + cch]));
              w[e] = cvt_pk_bf16((v0 - stats[s0 * 2]) * stats[s0 * 2 + 1] * lg + lb, (v1 - stats[s0 * 2 + 2]) * stats[s0 * 2 + 3] * lg + lb); }
          *(LAS u32x4*)(vnT + cch * 272 + (sg * 32 + j * 8) * 2) = (u32x4){w[0], w[1], w[2], w[3]}; } }
    __syncthreads();
    const int nk = ((wave * 16 + 15) >> 5) + 1;
    bf16x8 wf[4];
#pragma unroll
    for (int kk = 0; kk < 4; ++kk) wf[kk] = *(const LAS bf16x8*)(wm + (wave * 16 + fr) * 272 + kk * 64 + fq * 16);
    const int t = wave * 16 + fr, m = m0 + t;
    const float bs = a.gmlp_b_s[((size_t)l * 4 + g) * 128 + t];
    bf16_t* br1 = (bf16_t*)(a.ws + WS_BR) + (size_t)M * 512;
#pragma unroll
    for (int ct = 0; ct < 8; ++ct) { f32x4 acc = {0.f, 0.f, 0.f, 0.f};
#pragma unroll
        for (int kk = 0; kk < 4; ++kk) if (kk < nk) { const bf16x8 vf = *(const LAS bf16x8*)(vnT + (ct * 16 + fr) * 272 + kk * 64 + fq * 16); acc = mfma16(vf, wf[kk], acc); }
        const int cc = g * 128 + ct * 16 + 4 * fq;
        const u32x2 uw = *(const u32x2*)(proj + (size_t)m * NP + C_GZU + cc);
        const float u0 = gelu_erf(bflo(uw.x)), u1 = gelu_erf(bfhi(uw.x)), u2 = gelu_erf(bflo(uw.y)), u3 = gelu_erf(bfhi(uw.y));
        u32x2 w; w.x = cvt_pk_bf16(u0 * (acc[0] + bs), u1 * (acc[1] + bs)); w.y = cvt_pk_bf16(u2 * (acc[2] + bs), u3 * (acc[3] + bs));
        *(u32x2*)(br1 + (size_t)m * 512 + cc) = w; }
    __syncthreads();
}

__device__ __forceinline__ void moba_prep_unit(const Args& a, LAS unsigned char* lds, int unit) {
    const int blk = unit & 31, h = (unit >> 5) & 3, b = unit >> 7, m0 = b * SEQ + blk * 256;
    const int tid = otid();
    bf16_t* proj = (bf16_t*)(a.ws + WS_PROJ);
#pragma unroll 2
    for (int it = 0; it < 8; ++it) { const int item = tid + it * NTHREADS, tok = item >> 4, i = item & 15; const size_t m = (size_t)(m0 + tok);
        const float inv = exp2f(-(float)i * (18.931568569324174f / 16.f));
        const float ang = (float)a.pos[m] * inv; float sn, cs; sincosf(ang, &sn, &cs);
        bf16_t* kp = proj + m * NP + C_MK + h * 128 + i; bf16_t* qp = proj + m * NP + C_MQ + h * 128 + i;
        const float k1 = bf2f(kp[0]), k2 = bf2f(kp[16]), q1 = bf2f(qp[0]), q2 = bf2f(qp[16]);
        const unsigned kw = cvt_pk_bf16(k1 * cs - k2 * sn, k2 * cs + k1 * sn), qw = cvt_pk_bf16(q1 * cs - q2 * sn, q2 * cs + q1 * sn);
        kp[0] = (bf16_t)(kw & 0xffffu); kp[16] = (bf16_t)(kw >> 16); qp[0] = (bf16_t)(qw & 0xffffu); qp[16] = (bf16_t)(qw >> 16); }
    __threadfence_block();
    __syncthreads();
    { const int d = tid & 127, kg = tid >> 7; LAS float* red = (LAS float*)lds; float s = 0.f;
#pragma unroll 8
      for (int j = 0; j < 64; ++j) s += bf2f(proj[(size_t)(m0 + kg * 64 + j) * NP + C_MK + h * 128 + d]);
      red[kg * 128 + d] = s;
      __syncthreads();
      if (kg == 0) ((float*)(a.ws + WS_KMEAN))[((size_t)(b * 4 + h) * 32 + blk) * 128 + d] = (red[d] + red[128 + d] + red[256 + d] + red[384 + d]) * (1.f / 256.f);
      __syncthreads(); }
    { LAS unsigned char* tT = lds + 4096;
#pragma unroll 2
      for (int it = 0; it < 8; ++it) { const int p = tid + it * NTHREADS, key = p >> 4, pc = p & 15;
          const u32x4 w = *(const u32x4*)(proj + (size_t)(m0 + key) * NP + C_MV + h * 128 + pc * 8); const unsigned ww[4] = {w.x, w.y, w.z, w.w};
#pragma unroll
          for (int e = 0; e < 4; ++e) { *(LAS bf16_t*)(tT + (pc * 8 + 2 * e) * 528 + key * 2) = (bf16_t)(ww[e] & 0xffffu); *(LAS bf16_t*)(tT + (pc * 8 + 2 * e + 1) * 528 + key * 2) = (bf16_t)(ww[e] >> 16); } }
      __syncthreads();
      bf16_t* VT = (bf16_t*)(a.ws + WS_VT) + (size_t)(b * 4 + h) * 128 * SEQ + blk * 256;
#pragma unroll 2
      for (int it = 0; it < 8; ++it) { const int p = tid + it * NTHREADS, dv = p >> 5, pc = p & 31;
          *(u32x4*)(VT + (size_t)dv * SEQ + pc * 8) = *(const LAS u32x4*)(tT + dv * 528 + pc * 16); }
      __syncthreads(); }
}

__device__ __forceinline__ bf16_t* moba_part(const Args& a, int bh, int row, int k) {
    const size_t pr = (size_t)bh * SEQ + row;
    return (k < 2) ? (bf16_t*)(a.ws + WS_XBF) + (pr * 2 + k) * 128 : (bf16_t*)(a.ws + WS_MERGED) + (pr * 2 + (k - 2)) * 128;
}
__device__ __forceinline__ void moba_core(const Args& a, LAS unsigned char* lds, int b, int h, int row, bool valid, int slot, int kp_first, int ntiles, bool causal, int q0w) {
    const int tid = otid(), lane = tid & 63, fr = lane & 15, fq = lane >> 4;
    const int bh = b * 4 + h;
    const bf16_t* proj = (const bf16_t*)(a.ws + WS_PROJ);
    LAS unsigned char* Ks = lds + 34816;
    LAS unsigned char* Vs = lds + 34816 + 64 * 272;
    const bool wave_any = __builtin_amdgcn_ballot_w64(valid) != 0ull;
    bf16x8 qf[4];
#pragma unroll
    for (int kk = 0; kk < 4; ++kk) qf[kk] = *(const bf16x8*)(proj + (size_t)(b * SEQ + row) * NP + C_MQ + h * 128 + kk * 32 + fq * 8);
    f32x4 o[8];
#pragma unroll
    for (int j = 0; j < 8; ++j) o[j] = (f32x4){0.f, 0.f, 0.f, 0.f};
    float mrun = -INFINITY, lrun = 0.f;
    const bf16_t* kbase = proj + (size_t)(b * SEQ) * NP + C_MK + h * 128;
    const bf16_t* vbase = (const bf16_t*)(a.ws + WS_VT) + (size_t)bh * 128 * SEQ;
    u32x4 kreg[2], vreg[2];
#pragma unroll
    for (int i = 0; i < 2; ++i) { const int p = tid + i * NTHREADS; kreg[i] = *(const u32x4*)(kbase + (size_t)(kp_first + (p >> 4)) * NP + (p & 15) * 8); vreg[i] = *(const u32x4*)(vbase + (size_t)(p >> 3) * SEQ + kp_first + (p & 7) * 8); }
    const float SC = 0.08838834764831845f * 1.4426950408889634f;
    for (int it = 0; it < ntiles; ++it) {
        const int kp0 = kp_first + it * 64;
        __syncthreads();
#pragma unroll
        for (int i = 0; i < 2; ++i) { const int p = tid + i * NTHREADS; *(LAS u32x4*)(Ks + (p >> 4) * 272 + (p & 15) * 16) = kreg[i]; *(LAS u32x4*)(Vs + (p >> 3) * 144 + (p & 7) * 16) = vreg[i]; }
        __syncthreads();
        if (it + 1 < ntiles) { const int kn = kp0 + 64;
#pragma unroll
            for (int i = 0; i < 2; ++i) { const int p = tid + i * NTHREADS; kreg[i] = *(const u32x4*)(kbase + (size_t)(kn + (p >> 4)) * NP + (p & 15) * 8); vreg[i] = *(const u32x4*)(vbase + (size_t)(p >> 3) * SEQ + kn + (p & 7) * 8); } }
        const bool active = causal ? (kp0 <= q0w + 15) : wave_any;
        if (active) {
            f32x4 st[4];
#pragma unroll
            for (int kt = 0; kt < 4; ++kt) { f32x4 acc = {0.f, 0.f, 0.f, 0.f};
#pragma unroll
                for (int kk = 0; kk < 4; ++kk) { const bf16x8 kf = *(const LAS bf16x8*)(Ks + (kt * 16 + fr) * 272 + kk * 64 + fq * 16); acc = mfma16(kf, qf[kk], acc); }
                st[kt] = acc * SC; }
            if (causal) {
#pragma unroll
                for (int kt = 0; kt < 4; ++kt)
#pragma unroll
                    for (int jj = 0; jj < 4; ++jj) if (kp0 + kt * 16 + 4 * fq + jj > row) st[kt][jj] = -INFINITY;
            }
            float mx = -INFINITY;
#pragma unroll
            for (int kt = 0; kt < 4; ++kt) mx = fmaxf(mx, fmaxf(fmaxf(st[kt][0], st[kt][1]), fmaxf(st[kt][2], st[kt][3])));
            mx = fmaxf(mx, __shfl_xor(mx, 16)); mx = fmaxf(mx, __shfl_xor(mx, 32));
            const float mnew = fmaxf(mrun, mx);
            const float msafe = (mnew == -INFINITY) ? 0.f : mnew;
            const float alpha = __builtin_amdgcn_exp2f(mrun - msafe);
            float ls = 0.f;
#pragma unroll
            for (int kt = 0; kt < 4; ++kt)
#pragma unroll
                for (int jj = 0; jj < 4; ++jj) { const float p = __builtin_amdgcn_exp2f(st[kt][jj] - msafe); st[kt][jj] = p; ls += p; }
            ls += __shfl_xor(ls, 16); ls += __shfl_xor(ls, 32);
            lrun = lrun * alpha + ls; mrun = mnew;
            bf16x8 pf[2];
#pragma unroll
            for (int k2 = 0; k2 < 2; ++k2) { const u32x4 w = {cvt_pk_bf16(st[2 * k2][0], st[2 * k2][1]), cvt_pk_bf16(st[2 * k2][2], st[2 * k2][3]), cvt_pk_bf16(st[2 * k2 + 1][0], st[2 * k2 + 1][1]), cvt_pk_bf16(st[2 * k2 + 1][2], st[2 * k2 + 1][3])};
                pf[k2] = __builtin_bit_cast(bf16x8, w); }
#pragma unroll
            for (int dvt = 0; dvt < 8; ++dvt) { f32x4 acc = o[dvt] * alpha;
#pragma unroll
                for (int k2 = 0; k2 < 2; ++k2) { const u32x2 v0 = *(const LAS u32x2*)(Vs + (dvt * 16 + fr) * 144 + (32 * k2 + 4 * fq) * 2), v1 = *(const LAS u32x2*)(Vs + (dvt * 16 + fr) * 144 + (32 * k2 + 16 + 4 * fq) * 2);
                    const u32x4 vw = {v0.x, v0.y, v1.x, v1.y};
                    acc = mfma16(__builtin_bit_cast(bf16x8, vw), pf[k2], acc); }
                o[dvt] = acc; }
        }
    }
    if (valid) {
        const float il = 1.f / lrun;
        bf16_t* op = moba_part(a, bh, row, slot);
#pragma unroll
        for (int dvt = 0; dvt < 8; ++dvt) { u32x2 w; w.x = cvt_pk_bf16(o[dvt][0] * il, o[dvt][1] * il); w.y = cvt_pk_bf16(o[dvt][2] * il, o[dvt][3] * il);
            *(u32x2*)(op + dvt * 16 + 4 * fq) = w; }
        if (fq == 0) ((f32x2*)(a.ws + WS_ML))[((size_t)bh * SEQ + row) * 4 + slot] = (f32x2){mrun, lrun};
    }
    __syncthreads();
}

__device__ __forceinline__ void moba_own_unit(const Args& a, LAS unsigned char* lds, int b, int h, int qt) {
    const int tid = otid(), lane = tid & 63, wave = tid >> 6, fr = lane & 15;
    const int q0 = qt * 128, own = q0 >> 8, bs = own * 256, m0 = b * SEQ + q0, bh = b * 4 + h;
    const bf16_t* proj = (const bf16_t*)(a.ws + WS_PROJ);
    LAS float* km = (LAS float*)lds;
    LAS float* sc = (LAS float*)(lds + 16384);
    const float* kmg = (const float*)(a.ws + WS_KMEAN) + (size_t)bh * 32 * 128;
    int* cnt = (int*)(a.ws + WS_CTL + 14336); int* list = (int*)(a.ws + WS_LIST);
    if (own > 3) {
        for (int e = tid; e < own * 128; e += NTHREADS) km[e] = kmg[e];
        __syncthreads();
        const int row = tid >> 2, part = tid & 3; const bf16_t* qp = proj + (size_t)(m0 + row) * NP + C_MQ + h * 128;
        float s8[8];
#pragma unroll
        for (int jj = 0; jj < 8; ++jj) s8[jj] = 0.f;
#pragma unroll 2
        for (int dc = 0; dc < 16; ++dc) { const u32x4 w = *(const u32x4*)(qp + dc * 8); const float qv[8] = {bflo(w.x), bfhi(w.x), bflo(w.y), bfhi(w.y), bflo(w.z), bfhi(w.z), bflo(w.w), bfhi(w.w)};
#pragma unroll
            for (int jj = 0; jj < 8; ++jj) { const int j = part + 4 * jj; if (j < own) {
#pragma unroll
                for (int e = 0; e < 8; ++e) s8[jj] += qv[e] * km[j * 128 + dc * 8 + e]; } } }
#pragma unroll
        for (int jj = 0; jj < 8; ++jj) { const int j = part + 4 * jj; if (j < own) sc[row * 33 + j] = s8[jj]; }
        __syncthreads();
    }
    if (tid < 128) { const int ent = (q0 + tid) * 4;
        if (own <= 3) { for (int j = 0; j < own; ++j) { const int pos = atomicAdd(&cnt[bh * 32 + j], 1); list[(size_t)(bh * 32 + j) * SEQ + pos] = ent + j; } }
        else { float b0 = -INFINITY, b1 = -INFINITY, b2 = -INFINITY; int i0 = 0, i1 = 0, i2 = 0;
            for (int j = 0; j < own; ++j) { const float v = sc[tid * 33 + j];
                if (v > b0) { b2 = b1; i2 = i1; b1 = b0; i1 = i0; b0 = v; i0 = j; } else if (v > b1) { b2 = b1; i2 = i1; b1 = v; i1 = j; } else if (v > b2) { b2 = v; i2 = j; } }
            int pos = atomicAdd(&cnt[bh * 32 + i0], 1); list[(size_t)(bh * 32 + i0) * SEQ + pos] = ent + 0;
            pos = atomicAdd(&cnt[bh * 32 + i1], 1); list[(size_t)(bh * 32 + i1) * SEQ + pos] = ent + 1;
            pos = atomicAdd(&cnt[bh * 32 + i2], 1); list[(size_t)(bh * 32 + i2) * SEQ + pos] = ent + 2; } }
    moba_core(a, lds, b, h, q0 + wave * 16 + fr, true, 3, bs, ((q0 - bs) >> 6) + 2, true, q0 + wave * 16);
}

__device__ __forceinline__ void phase_moba_gather(const Args& a, LAS unsigned char* lds, int G, int bid) {
    const int tid = otid(), lane = tid & 63, wave = tid >> 6, fr = lane & 15;
    LAS int* start = (LAS int*)(lds + 71680);
    int* cnt = (int*)(a.ws + WS_CTL + 14336); const int* list = (const int*)(a.ws + WS_LIST);
    if (tid < 256) start[tid + 1] = (__hip_atomic_load(&cnt[tid], __ATOMIC_RELAXED, __HIP_MEMORY_SCOPE_AGENT) + 127) >> 7;
    __syncthreads();
    if (tid == 0) { int s = 0; start[0] = 0; for (int i = 1; i <= 256; ++i) { s += start[i]; start[i] = s; } }
    __syncthreads();
    const int total = start[256];
    for (int u = bid; u < total; u += G) {
        int lo = 0, hi = 255;
        while (lo < hi) { const int mid = (lo + hi + 1) >> 1; if (start[mid] <= u) lo = mid; else hi = mid - 1; }
        const int e = lo, bh = e >> 5, j = e & 31, chunk = u - start[e];
        const int c = __hip_atomic_load(&cnt[e], __ATOMIC_RELAXED, __HIP_MEMORY_SCOPE_AGENT);
        const int idx = chunk * 128 + wave * 16 + fr; const bool valid = idx < c;
        const int ent = valid ? list[(size_t)e * SEQ + idx] : 0;
        const int row = valid ? (ent >> 2) : (j + 1) * 256;
        moba_core(a, lds, bh >> 2, bh & 3, row, valid, ent & 3, j * 256, 4, false, 0);
    }
}

__device__ __forceinline__ void phase_moba_combine(const Args& a, int G, int bid) {
    const int tid = otid();
    bf16_t* br2 = (bf16_t*)(a.ws + WS_BR) + (size_t)2 * M * 512;
    for (int p = bid * NTHREADS + tid; p < 8 * SEQ * 4; p += G * NTHREADS) {
        const int pair = p >> 2, part = p & 3, bh = pair >> 13, row = pair & (SEQ - 1), own = row >> 8, nsel = own < 3 ? own : 3;
        const f32x2* ml = (const f32x2*)(a.ws + WS_ML) + (size_t)pair * 4;
        const f32x2 m3 = ml[3]; f32x2 mk[3]; float Mx = m3.x;
#pragma unroll
        for (int k = 0; k < 3; ++k) { mk[k] = (k < nsel) ? ml[k] : (f32x2){-INFINITY, 0.f}; Mx = fmaxf(Mx, mk[k].x); }
        float acc[32];
        float wsum = m3.y * __builtin_amdgcn_exp2f(m3.x - Mx);
        { const bf16_t* op = moba_part(a, bh, row, 3) + part * 32;
#pragma unroll
          for (int q = 0; q < 4; ++q) { const u32x4 w = *(const u32x4*)(op + q * 8); const unsigned ww[4] = {w.x, w.y, w.z, w.w};
#pragma unroll
              for (int e2 = 0; e2 < 4; ++e2) { acc[q * 8 + 2 * e2] = wsum * bflo(ww[e2]); acc[q * 8 + 2 * e2 + 1] = wsum * bfhi(ww[e2]); } } }
#pragma unroll
        for (int k = 0; k < 3; ++k) if (k < nsel) { const float wk = mk[k].y * __builtin_amdgcn_exp2f(mk[k].x - Mx); wsum += wk;
            const bf16_t* op = moba_part(a, bh, row, k) + part * 32;
#pragma unroll
            for (int q = 0; q < 4; ++q) { const u32x4 w = *(const u32x4*)(op + q * 8); const unsigned ww[4] = {w.x, w.y, w.z, w.w};
#pragma unroll
                for (int e2 = 0; e2 < 4; ++e2) { acc[q * 8 + 2 * e2] += wk * bflo(ww[e2]); acc[q * 8 + 2 * e2 + 1] += wk * bfhi(ww[e2]); } } }
        const float iw = 1.f / wsum;
        bf16_t* dst = br2 + (size_t)((bh >> 2) * SEQ + row) * 512 + (bh & 3) * 128 + part * 32;
#pragma unroll
        for (int q = 0; q < 4; ++q) *(u32x4*)(dst + q * 8) = (u32x4){cvt_pk_bf16(acc[q * 8] * iw, acc[q * 8 + 1] * iw), cvt_pk_bf16(acc[q * 8 + 2] * iw, acc[q * 8 + 3] * iw), cvt_pk_bf16(acc[q * 8 + 4] * iw, acc[q * 8 + 5] * iw), cvt_pk_bf16(acc[q * 8 + 6] * iw, acc[q * 8 + 7] * iw)};
    }
}

__device__ __forceinline__ void phase_ln(const Args& a, const float* gam, const float* bet, int G) {
    const int tid = otid(), lane = tid & 63, wave = tid >> 6;
    bf16_t* xbf = (bf16_t*)(a.ws + WS_XBF);
    f32x4 gv[4], bv[4];
#pragma unroll
    for (int j = 0; j < 4; ++j) { gv[j] = *(const f32x4*)(gam + 4 * lane + 256 * j); bv[j] = *(const f32x4*)(bet + 4 * lane + 256 * j); }
    for (int m = blockIdx.x * NWAVES + wave; m < M; m += G * NWAVES) {
        f32x4* xr = (f32x4*)(a.out + (size_t)m * D) + lane;
        f32x4 v[4]; float s = 0.f;
#pragma unroll
        for (int j = 0; j < 4; ++j) { v[j] = xr[64 * j]; s += (v[j][0] + v[j][1]) + (v[j][2] + v[j][3]); }
        const float mean = wave_sum(s) * (1.f / D); float s2 = 0.f;
#pragma unroll
        for (int j = 0; j < 4; ++j) { v[j] = v[j] - mean; s2 += (v[j][0] * v[j][0] + v[j][1] * v[j][1]) + (v[j][2] * v[j][2] + v[j][3] * v[j][3]); }
        const float rstd = 1.f / sqrtf(wave_sum(s2) * (1.f / D) + LN_EPS);
        u32x2* o8 = (u32x2*)(xbf + (size_t)m * D) + lane;
#pragma unroll
        for (int j = 0; j < 4; ++j) { const f32x4 y = v[j] * rstd * gv[j] + bv[j]; xr[64 * j] = y; o8[64 * j] = (u32x2){cvt_pk_bf16(y[0], y[1]), cvt_pk_bf16(y[2], y[3])}; }
    }
}

__global__ void __launch_bounds__(NTHREADS, 2) fwd_mega(Args a) {
    extern __shared__ __attribute__((aligned(16))) unsigned char lds_raw[];
    LAS unsigned char* lds = (LAS unsigned char*)lds_raw;
    cg::grid_group grid = cg::this_grid();
    volatile LAS unsigned* bst = (volatile LAS unsigned*)(lds + LDS_BYTES - 64);
    if (threadIdx.x == 0) { bst[0] = 0u; bst[1] = 0u; }
    __syncthreads();
    XcdBarrier xbar = xcd_barrier_post((unsigned*)(a.ws + WS_CTL), bst);
    const int G = gridDim.x, bid = blockIdx.x;
    const float ALPHA = 1.6817928305074290f;
    bf16_t* xbf = (bf16_t*)(a.ws + WS_XBF); bf16_t* proj = (bf16_t*)(a.ws + WS_PROJ);
    for (int ph = a.ph_lo; ph < a.ph_hi; ++ph) {
        const int l = ph / PH_PER_LAYER, k = ph % PH_PER_LAYER;
        int bidp = bid; asm volatile("" : "+s"(bidp));
        switch (k) {
        case 0: if (l == 0) phase_prep(a, 0, lds, G); break;
        case 1: { pg8::Gemm g{xbf, (const bf16_t*)(a.ws + WS_WIN), M, NP, D, D}; pg8::StaticOrder S; S.init(M, NP, G, bidp);
                  pg8::EpiStore<0> E{proj, NP}; pg8::gemm_phase(lds, g, S, E); } break;
        case 2: {
                  { const int t0 = otid(); if (t0 < 256) ((int*)(a.ws + WS_CTL + 14336))[t0] = 0; }
                  for (int u = bidp; u < 1792; u += G) { if (u < 256) moba_prep_unit(a, lds, u); else if (u < 768) gmlp_unit(a, l, lds, u - 256); else gla_kv_unit(a, l, lds, u - 768); } } break;
        case 3: { gla_scan(a, G);
                  for (int i = 0;; ++i) { const int u = i * G + bidp; if (u >= 512) break;
                      int qt, bh; if (u < 256) { qt = 63 - (u >> 3); bh = u & 7; } else { qt = (u - 256) >> 3; bh = u & 7; }
                      moba_own_unit(a, lds, bh >> 2, bh & 3, qt); } } break;
        case 4: phase_moba_gather(a, lds, G, bidp); break;
        case 5: { phase_moba_combine(a, G, bidp); for (int u = bidp; u < 1024; u += G) gla_out_unit(a, l, lds, u); } break;
        case 6: { pg8::Gemm g{(const bf16_t*)(a.ws + WS_BR), (const bf16_t*)(a.ws + WS_WBR), 3 * M, 3 * D, 512, 512}; pg8::MergeOrder S{G, bidp};
                  pg8::EpiMerge E{proj, (float*)(a.ws + WS_PROJ), (bf16_t*)(a.ws + WS_MERGED)}; pg8::gemm_phase(lds, g, S, E); } break;
        case 7: { pg8::Gemm g{(const bf16_t*)(a.ws + WS_MERGED), (const bf16_t*)(a.ws + WS_WOUT), M, D, D, D}; pg8::StaticOrder S; S.init(M, D, G, bidp);
                  pg8::EpiResid E{l == 0 ? a.x : a.out, a.out, ALPHA}; pg8::gemm_phase(lds, g, S, E); } break;
        case 8: phase_ln(a, a.ln1_g + (size_t)l * D, a.ln1_b + (size_t)l * D, G); break;
        case 9: { pg8::Gemm g{xbf, (const bf16_t*)(a.ws + WS_W1), M, FF, D, D}; pg8::StaticOrder S; S.init(M, FF, G, bidp);
                  pg8::EpiStore<2> E{proj, FF}; pg8::gemm_phase(lds, g, S, E); } break;
        case 10: { pg8::Gemm g{proj, (const bf16_t*)(a.ws + WS_W2), M, D, FF, FF}; pg8::StaticOrder S; S.init(M, D, G, bidp);
                  pg8::EpiResid E{a.out, a.out, ALPHA}; pg8::gemm_phase(lds, g, S, E); } break;
        default: phase_ln(a, a.ln2_g + (size_t)l * D, a.ln2_b + (size_t)l * D, G); if (l + 1 < DEPTH) phase_prep(a, l + 1, lds, G); break;
        }
        if (ph + 1 < a.ph_hi && !(ph % PH_PER_LAYER == 0 && ph > 0)) { if (ph == 0) grid.sync(); else xcd_barrier(xbar); }
    }
}

#ifndef MK_PER_PHASE
#define MK_PER_PHASE 0
#endif
extern "C" void kernel_launch(void* const* d_in, const int* in_sizes, int n_in, void* d_out, int out_size, void* d_ws, size_t ws_size, hipStream_t stream) {
    static int grid = 0;
    if (grid == 0) {
        if (n_in != 18 || out_size != M * D || ws_size < WS_END) { fprintf(stderr, "kernel_launch: unexpected problem (n_in %d out %d ws %zu)\n", n_in, out_size, ws_size); grid = -1; return; }
        int dev = 0, cus = 0, per_cu = 0;
        if (hipGetDevice(&dev) != hipSuccess || hipDeviceGetAttribute(&cus, hipDeviceAttributeMultiprocessorCount, dev) != hipSuccess) { grid = -1; return; }
        if (hipFuncSetAttribute((const void*)fwd_mega, hipFuncAttributeMaxDynamicSharedMemorySize, LDS_BYTES) != hipSuccess) { fprintf(stderr, "kernel_launch: hipFuncSetAttribute failed\n"); grid = -1; return; }
        if (hipOccupancyMaxActiveBlocksPerMultiprocessor(&per_cu, (const void*)fwd_mega, NTHREADS, LDS_BYTES) != hipSuccess || per_cu < 1) { fprintf(stderr, "kernel_launch: occupancy query says %d\n", per_cu); per_cu = 1; }
        (void)hipGetLastError();
        grid = cus;
        if (grid < 32) { fprintf(stderr, "kernel_launch: needs >= 32 CUs\n"); grid = -1; return; }
    }
    if (grid < 0) return;
    Args a{};
    a.x = (const float*)d_in[0]; a.pos = (const int*)d_in[1]; a.w_in = (const float*)d_in[2]; a.w_gate_up = (const float*)d_in[3]; a.b_gate = (const float*)d_in[4];
    a.gla_norm_w = (const float*)d_in[5]; a.gmlp_ln_g = (const float*)d_in[6]; a.gmlp_ln_b = (const float*)d_in[7]; a.gmlp_w_s = (const float*)d_in[8]; a.gmlp_b_s = (const float*)d_in[9];
    a.w_branch = (const float*)d_in[10]; a.w_out = (const float*)d_in[11]; a.ln1_g = (const float*)d_in[12]; a.ln1_b = (const float*)d_in[13]; a.w_ff1 = (const float*)d_in[14];
    a.w_ff2 = (const float*)d_in[15]; a.ln2_g = (const float*)d_in[16]; a.ln2_b = (const float*)d_in[17]; a.out = (float*)d_out; a.ws = (unsigned char*)d_ws;
    if (hipMemsetAsync((char*)d_ws + WS_CTL, 0, CTL_BYTES, stream) != hipSuccess) { fprintf(stderr, "kernel_launch: memset of barrier words failed\n"); return; }
#if MK_PER_PHASE
    for (int ph = 0; ph < N_PHASES; ++ph) { a.ph_lo = ph; a.ph_hi = ph + 1; hipLaunchKernelGGL(fwd_mega, dim3(grid), dim3(NTHREADS), LDS_BYTES, stream, a); }
#else
    a.ph_lo = 0; a.ph_hi = N_PHASES;
    void* args[] = {&a};
    hipError_t e = hipLaunchCooperativeKernel((const void*)fwd_mega, dim3(grid), dim3(NTHREADS), args, LDS_BYTES, stream);
    if (e != hipSuccess) fprintf(stderr, "kernel_launch: cooperative launch failed: %s (grid %d)\n", hipGetErrorString(e), grid);
#endif
}
```

```cpp
#include <hip/hip_runtime.h>
#include <hip/hip_cooperative_groups.h>
#include <cstdio>
#include <cstdint>
namespace cg = cooperative_groups;

#define LAS __attribute__((address_space(3)))
typedef unsigned short bf16_t;
typedef short bf16x8 __attribute__((ext_vector_type(8)));
typedef short s16x4 __attribute__((ext_vector_type(4)));
typedef float f32x4 __attribute__((ext_vector_type(4)));
typedef float f32x2 __attribute__((ext_vector_type(2)));
typedef unsigned u32x4 __attribute__((ext_vector_type(4)));
typedef unsigned u32x2 __attribute__((ext_vector_type(2)));

constexpr int BATCH = 2, SEQ = 8192, M = BATCH * SEQ, D = 1024, DEPTH = 4, FF = 4096;
constexpr int IN_COLS = 7696, NP = 7936, C_LR = 7680;
constexpr int C_GQ = 0, C_GK = 512, C_GV = 1024, C_GG = 1536, C_GZU = 2048, C_GZV = 2560, C_MQ = 3072, C_MK = 3584, C_MV = 4096, C_GL = 4608;
constexpr int NWAVES = 8, NTHREADS = 512;
constexpr int LDS_BYTES = 147456;
constexpr float LN_EPS = 1e-5f, RMS_EPS = 1e-6f;
constexpr int PH_PER_LAYER = 12, N_PHASES = DEPTH * PH_PER_LAYER;

constexpr size_t MiB = 1u << 20;
constexpr size_t WS_WIN = 0, WS_GLR = 15 * MiB, WS_WBR = 16 * MiB, WS_WOUT = 19 * MiB, WS_W1 = 21 * MiB, WS_W2 = 29 * MiB;
constexpr size_t WS_XBF = 38 * MiB;
constexpr size_t WS_BR = 70 * MiB;
constexpr size_t WS_ST = 118 * MiB;
constexpr size_t WS_DEC = 150 * MiB;
constexpr size_t WS_KMEAN = WS_DEC + 512 * 1024;
constexpr size_t WS_VT = 151 * MiB;
constexpr size_t WS_MERGED = 167 * MiB;
constexpr size_t WS_PROJ = 200 * MiB;
constexpr size_t WS_CTL = 448 * MiB, CTL_BYTES = 16384;
constexpr size_t WS_ML = 449 * MiB;
constexpr size_t WS_LIST = 451 * MiB;
constexpr size_t WS_END = 459 * MiB;

typedef __bf16 bf16x2_t __attribute__((ext_vector_type(2)));
__device__ __forceinline__ unsigned cvt_pk_bf16(float lo, float hi) { const f32x2 v = {lo, hi}; const bf16x2_t b = __builtin_convertvector(v, bf16x2_t); return __builtin_bit_cast(unsigned, b); }
__device__ __forceinline__ float bf2f(unsigned h) { return __builtin_bit_cast(float, h << 16); }
__device__ __forceinline__ float bflo(unsigned w) { return __builtin_bit_cast(float, w << 16); }
__device__ __forceinline__ float bfhi(unsigned w) { return __builtin_bit_cast(float, w & 0xffff0000u); }
__device__ __forceinline__ int otid() { int t = threadIdx.x; asm volatile("" : "+v"(t)); return t; }
__device__ __forceinline__ f32x4 mfma16(bf16x8 a, bf16x8 b, f32x4 c) { return __builtin_amdgcn_mfma_f32_16x16x32_bf16(a, b, c, 0, 0, 0); }

namespace pg8 {
constexpr int BM = 256, BK = 64, HALF = 128, HTB = HALF * BK * 2, NXCD = 8, WGM = 8;
__host__ __device__ __forceinline__ int lds_byte(int r, int c) { const int st = (r >> 4) * 2 + (c >> 5), rr = r & 15, cc = c & 31, ob = rr * 64 + cc * 2; return st * 1024 + (ob ^ (((ob >> 9) & 1) << 5)); }
__host__ __device__ __forceinline__ void stage_rc(int b, int& R, int& C) { const int st = b / 1024, sb = b % 1024, swz = sb ^ (((sb >> 9) & 1) << 5); R = (st >> 1) * 16 + swz / 64; C = (st & 1) * 32 + (swz % 64) / 2; }
__host__ __device__ __forceinline__ int perm32(int rho) { const int n = rho >> 4, i = rho & 15; return 8 * (i >> 2) + 4 * n + (i & 3); }

struct Unit { int pm, pn; };
struct Gemm { const bf16_t* A; const bf16_t* Bt; int M, N, K, lda; };

struct StaticOrder {
    int nM, nN, nwg, G, c;
    __device__ void init(int M_, int N_, int G_, int c_) { nM = M_ / BM; nN = N_ / BM; nwg = nM * nN; G = G_; c = c_; }
    __device__ bool next(int i, Unit& u) const {
        const long L = (long)i * G + c; if (L >= nwg) return false;
        int wgid = (int)L; { const int q = nwg / NXCD, r = nwg % NXCD, xcd = wgid % NXCD, off = wgid / NXCD; wgid = (xcd < r ? xcd * (q + 1) : r * (q + 1) + (xcd - r) * q) + off; }
        const int nig = WGM * nN, gid = wgid / nig, fm = gid * WGM, gsz = (nM - fm) < WGM ? (nM - fm) : WGM;
        u.pm = fm + ((wgid % nig) % gsz); u.pn = (wgid % nig) / gsz; return true;
    }
};
struct MergeOrder {
    int G, c;
    __device__ bool next(int i, Unit& u) const { const int t = (i / 3) * G + c; if (t >= 256) return false; const int br = i % 3; u.pm = br * 64 + (t >> 2); u.pn = br * 4 + (t & 3); return true; }
};

template <int ACT  > struct EpiStore {
    bf16_t* O; int ldc;
    __device__ __forceinline__ void operator()(const f32x4 (&acc)[2][2][4][2], const Unit& u, int wr, int wc, int fr, int fq) const {
        const int row0 = u.pm * BM + wr * 64 + fr, col0 = u.pn * BM + wc * 32 + 8 * fq;
#pragma unroll
        for (int ai = 0; ai < 2; ++ai)
#pragma unroll
            for (int m = 0; m < 4; ++m) { bf16_t* rowp = O + (size_t)(row0 + ai * HALF + m * 16) * ldc + col0;
#pragma unroll
                for (int bj = 0; bj < 2; ++bj) { f32x4 v0 = acc[ai][bj][m][0], v1 = acc[ai][bj][m][1];
                    if (ACT == 2) {
#pragma unroll
                        for (int e = 0; e < 4; ++e) { float a = fmaxf(v0[e], 0.f), b = fmaxf(v1[e], 0.f); v0[e] = a * a; v1[e] = b * b; } }
                    u32x4 w; w.x = cvt_pk_bf16(v0[0], v0[1]); w.y = cvt_pk_bf16(v0[2], v0[3]); w.z = cvt_pk_bf16(v1[0], v1[1]); w.w = cvt_pk_bf16(v1[2], v1[3]);
                    *(u32x4*)(rowp + bj * HALF) = w; } }
    }
};
struct EpiResid {
    const float* R; float* O; float alpha;
    __device__ __forceinline__ void operator()(const f32x4 (&acc)[2][2][4][2], const Unit& u, int wr, int wc, int fr, int fq) const {
        const int row0 = u.pm * BM + wr * 64 + fr, col0 = u.pn * BM + wc * 32 + 8 * fq;
#pragma unroll
        for (int ai = 0; ai < 2; ++ai)
#pragma unroll
            for (int m = 0; m < 4; ++m) { const size_t off = (size_t)(row0 + ai * HALF + m * 16) * 1024 + col0;
#pragma unroll
                for (int bj = 0; bj < 2; ++bj) { const f32x4 r0 = *(const f32x4*)(R + off + bj * HALF), r1 = *(const f32x4*)(R + off + bj * HALF + 4);
                    *(f32x4*)(O + off + bj * HALF) = r0 * alpha + acc[ai][bj][m][0]; *(f32x4*)(O + off + bj * HALF + 4) = r1 * alpha + acc[ai][bj][m][1]; } }
    }
};
struct EpiMerge {
    const bf16_t* proj; float* stash; bf16_t* merged;
    __device__ __forceinline__ void operator()(const f32x4 (&acc)[2][2][4][2], const Unit& u, int wr, int wc, int fr, int fq) const {
        const int br = u.pm >> 6, tm = u.pm & 63, tn = u.pn & 3;
        const int row0 = tm * BM + wr * 64 + fr, col0 = tn * BM + wc * 32 + 8 * fq;
#pragma unroll
        for (int ai = 0; ai < 2; ++ai)
#pragma unroll
            for (int m = 0; m < 4; ++m) { const int row = row0 + ai * HALF + m * 16;
#pragma unroll
                for (int bj = 0; bj < 2; ++bj) { const int col = col0 + bj * HALF;
                    const u32x4 gw = *(const u32x4*)(proj + (size_t)row * NP + C_GL + br * 1024 + col);
                    float g[8] = {bflo(gw.x), bfhi(gw.x), bflo(gw.y), bfhi(gw.y), bflo(gw.z), bfhi(gw.z), bflo(gw.w), bfhi(gw.w)};
                    f32x4 v0, v1;
#pragma unroll
                    for (int e = 0; e < 4; ++e) { v0[e] = acc[ai][bj][m][0][e] / (1.f + __expf(-g[e])); v1[e] = acc[ai][bj][m][1][e] / (1.f + __expf(-g[4 + e])); }
                    float* sp = stash + (size_t)row * (NP / 2) + col;
                    if (br == 0) { *(f32x4*)sp = v0; *(f32x4*)(sp + 4) = v1; }
                    else { v0 += *(const f32x4*)sp; v1 += *(const f32x4*)(sp + 4);
                        if (br == 1) { *(f32x4*)sp = v0; *(f32x4*)(sp + 4) = v1; }
                        else { u32x4 w; w.x = cvt_pk_bf16(v0[0], v0[1]); w.y = cvt_pk_bf16(v0[2], v0[3]); w.z = cvt_pk_bf16(v1[0], v1[1]); w.w = cvt_pk_bf16(v1[2], v1[3]);
                            *(u32x4*)(merged + (size_t)row * 1024 + col) = w; } } } }
    }
};

template <class Epi, class Sched>
__device__ __forceinline__ void gemm_phase(LAS unsigned char* lds, const Gemm g, const Sched& S, const Epi& E) {
    const int tid = otid(), wid = __builtin_amdgcn_readfirstlane(tid >> 6), lane = tid & 63, wr = wid >> 2, wc = wid & 3, fr = lane & 15, fq = lane >> 4;
    const int K = g.K, nt = K / BK, lda = g.lda;
    unsigned voffA[2], voffB[2];
#pragma unroll
    for (int i = 0; i < 2; ++i) { int R, C; stage_rc(tid * 16 + i * 8192, R, C); const int Rb = (R & ~31) + perm32(R & 31);
        voffA[i] = (unsigned)(R * lda + C) * 2u; voffB[i] = (unsigned)(Rb * K + C) * 2u; }
    const size_t kstep = (size_t)(BK * 2);
    const size_t hstepA = (size_t)HALF * lda * 2, hstepB = (size_t)HALF * K * 2;
    const size_t tstepA = 2 * hstepA, tstepB = 2 * hstepB;
    const unsigned ldsw = (unsigned)wid * 1024u;
    const int aoff = lds_byte(wr * 64 + fr, fq * 8), boff = lds_byte(wc * 32 + fr, fq * 8);
#define PG8_SA(b, h) (((b) * 2 + (h)) * HTB)
#define PG8_SB(b, h) ((4 + (b) * 2 + (h)) * HTB)
#define PG8_STAGE(bufoff, gbase, voff) do { _Pragma("unroll") for (int _i = 0; _i < 2; ++_i) \
        __builtin_amdgcn_global_load_lds((const unsigned*)((const char*)(gbase) + (voff)[_i]), (LAS unsigned*)(lds + (bufoff) + ldsw + _i * 8192), 16, 0, 0); } while (0)
#define PG8_LDA(dst, b, h) do { _Pragma("unroll") for (int m = 0; m < 4; ++m) _Pragma("unroll") for (int k = 0; k < 2; ++k) dst[m][k] = *(const LAS bf16x8*)(lds + PG8_SA(b, h) + aoff + m * 2048 + k * 1024); } while (0)
#define PG8_LDB(dst, b, h) do { _Pragma("unroll") for (int n = 0; n < 2; ++n) _Pragma("unroll") for (int k = 0; k < 2; ++k) dst[n][k] = *(const LAS bf16x8*)(lds + PG8_SB(b, h) + boff + n * 2048 + k * 1024); } while (0)
#define PG8_MMA(ai, bj, At, Bt) do { __builtin_amdgcn_s_setprio(1); _Pragma("unroll") for (int m = 0; m < 4; ++m) _Pragma("unroll") for (int n = 0; n < 2; ++n) _Pragma("unroll") for (int k = 0; k < 2; ++k) \
        acc[ai][bj][m][n] = __builtin_amdgcn_mfma_f32_16x16x32_bf16(Bt[n][k], At[m][k], acc[ai][bj][m][n], 0, 0, 0); __builtin_amdgcn_s_setprio(0); } while (0)
#define PG8_WAIT_V(n) asm volatile("s_waitcnt vmcnt(" #n ")" ::: "memory")
#define PG8_WAIT_L(n) asm volatile("s_waitcnt lgkmcnt(" #n ")" ::: "memory")
#define PG8_BAR __builtin_amdgcn_s_barrier()
#define PG8_SCHED __builtin_amdgcn_sched_barrier(0)
    Unit cur, nxt; int ui = 0;
    if (!S.next(0, cur)) return;
    f32x4 acc[2][2][4][2];
#pragma unroll
    for (int a = 0; a < 2; ++a)
#pragma unroll
        for (int b = 0; b < 2; ++b)
#pragma unroll
            for (int m = 0; m < 4; ++m)
#pragma unroll
                for (int n = 0; n < 2; ++n) acc[a][b][m][n] = (f32x4){0.f, 0.f, 0.f, 0.f};
    bf16x8 At[4][2], B0[2][2], B1[2][2];
    const char* cA = (const char*)g.A + (size_t)cur.pm * tstepA; const char* cB = (const char*)g.Bt + (size_t)cur.pn * tstepB;
    PG8_STAGE(PG8_SB(0, 0), cB, voffB); PG8_STAGE(PG8_SB(0, 1), cB + hstepB, voffB); PG8_STAGE(PG8_SA(0, 0), cA, voffA); PG8_STAGE(PG8_SA(0, 1), cA + hstepA, voffA);
    if (wr == 1) PG8_BAR;
    PG8_WAIT_V(2); PG8_BAR;
    PG8_STAGE(PG8_SB(1, 0), cB + kstep, voffB); PG8_STAGE(PG8_SA(1, 0), cA + kstep, voffA); PG8_STAGE(PG8_SB(1, 1), cB + hstepB + kstep, voffB);
    PG8_WAIT_V(6); PG8_BAR;
    for (;;) {
        const bool has_next = S.next(ui + 1, nxt);
        const char* nA = has_next ? (const char*)g.A + (size_t)nxt.pm * tstepA : cA; const char* nB = has_next ? (const char*)g.Bt + (size_t)nxt.pn * tstepB : cB;
        for (int t = 0; t < nt; t += 2) {
            const bool last = (t == nt - 2);
            const char* a1 = cA + (size_t)(t + 1) * kstep;
            const char* a2 = last ? nA : cA + (size_t)(t + 2) * kstep; const char* b2 = last ? nB : cB + (size_t)(t + 2) * kstep;
            const char* a3 = a2 + kstep; const char* b3 = b2 + kstep;
            PG8_LDB(B0, 0, 0); PG8_LDB(B1, 0, 1); PG8_SCHED; PG8_LDA(At, 0, 0); PG8_STAGE(PG8_SA(1, 1), a1 + hstepA, voffA);
            PG8_WAIT_V(8); PG8_WAIT_L(0); PG8_BAR; PG8_MMA(0, 0, At, B0); PG8_MMA(0, 1, At, B1); PG8_BAR; PG8_SCHED;
            PG8_LDA(At, 0, 1); PG8_STAGE(PG8_SB(0, 0), b2, voffB); PG8_STAGE(PG8_SB(0, 1), b2 + hstepB, voffB); PG8_STAGE(PG8_SA(0, 0), a2, voffA);
            PG8_WAIT_V(8); PG8_WAIT_L(0); PG8_BAR; PG8_MMA(1, 0, At, B0); PG8_MMA(1, 1, At, B1); PG8_BAR; PG8_SCHED;
            PG8_LDB(B0, 1, 0); PG8_LDB(B1, 1, 1); PG8_SCHED; PG8_LDA(At, 1, 0); PG8_STAGE(PG8_SA(0, 1), a2 + hstepA, voffA);
            PG8_WAIT_V(8); PG8_WAIT_L(0); PG8_BAR; PG8_MMA(0, 0, At, B0); PG8_MMA(0, 1, At, B1); PG8_BAR; PG8_SCHED;
            PG8_LDA(At, 1, 1); PG8_STAGE(PG8_SB(1, 0), b3, voffB); PG8_STAGE(PG8_SB(1, 1), b3 + hstepB, voffB); PG8_STAGE(PG8_SA(1, 0), a3, voffA);
            PG8_WAIT_V(8); PG8_WAIT_L(0); PG8_BAR; PG8_MMA(1, 0, At, B0); PG8_MMA(1, 1, At, B1); PG8_BAR; PG8_SCHED;
        }
        if (wr == 0) PG8_BAR;
        E(acc, cur, wr, wc, fr, fq);
        if (!has_next) break;
#pragma unroll
        for (int a = 0; a < 2; ++a)
#pragma unroll
            for (int b = 0; b < 2; ++b)
#pragma unroll
                for (int m = 0; m < 4; ++m)
#pragma unroll
                    for (int n = 0; n < 2; ++n) acc[a][b][m][n] = (f32x4){0.f, 0.f, 0.f, 0.f};
        cur = nxt; cA = nA; cB = nB; ++ui;
        if (wr == 1) PG8_BAR;
    }
    PG8_WAIT_V(0);
    PG8_BAR;
#undef PG8_SA
#undef PG8_SB
#undef PG8_STAGE
#undef PG8_LDA
#undef PG8_LDB
#undef PG8_MMA
#undef PG8_WAIT_V
#undef PG8_WAIT_L
#undef PG8_BAR
#undef PG8_SCHED
}
}


#define XB_TMO      128
#define XB_XCNT(j)  (256  + 64 * (j))
#define XB_XSUB(j)  (1280 + 64 * (j))
#define XB_XGEN(j)  (2304 + 64 * (j))
#define XB_TOP      3328
#define XB_TOPGEN   3392
#define XCD_BAR_WORDS 3456
#define XB_SPIN_CAP (1u << 18)
__device__ __forceinline__ unsigned xb_ld(unsigned* p)              { return __hip_atomic_load(p, __ATOMIC_RELAXED, __HIP_MEMORY_SCOPE_AGENT); }
__device__ __forceinline__ unsigned xb_add(unsigned* p, unsigned v) { return __hip_atomic_fetch_add(p, v, __ATOMIC_RELAXED, __HIP_MEMORY_SCOPE_AGENT); }
__device__ __forceinline__ unsigned xb_xcc_id() { return (unsigned)__builtin_amdgcn_s_getreg((3 << 11) | 20) & 0xFu; }
#define XB_SPIN(cond, bar) do { unsigned _sp = 0; while (cond) { __builtin_amdgcn_s_sleep(1); \
    if ((++_sp & 255u) == 0u) { if (xb_ld(&(bar)[XB_TMO])) break; if (_sp > XB_SPIN_CAP) { atomicAdd(&(bar)[XB_TMO], 1u); break; } } } } while (0)
struct XcdBarrier { unsigned* bar; unsigned x; volatile LAS unsigned* st; };
__device__ __forceinline__ XcdBarrier xcd_barrier_post(unsigned* bar, volatile LAS unsigned* st) {
    XcdBarrier b; b.bar = bar; b.x = xb_xcc_id(); b.st = st;
    if (threadIdx.x == 0) (void)xb_add(&bar[XB_XCNT(b.x)], 1u);
    return b;
}
__device__ __forceinline__ void xcd_barrier_complete(unsigned* bar, unsigned x, unsigned& nloc, unsigned& nx) {
    const unsigned G = gridDim.x * gridDim.y * gridDim.z;
    unsigned sum, cnt, mine, sp = 0u;
    for (;;) {
        sum = 0u; cnt = 0u; mine = 0u;
#pragma unroll
        for (unsigned j = 0; j < 16; ++j) { const unsigned c = xb_ld(&bar[XB_XCNT(j)]); sum += c; cnt += (c > 0u) ? 1u : 0u; mine = (j == x) ? c : mine; }
        if (sum == G) break;
        __builtin_amdgcn_s_sleep(1);
        if ((++sp & 255u) == 0u) { if (xb_ld(&bar[XB_TMO])) break; if (sp > XB_SPIN_CAP) { atomicAdd(&bar[XB_TMO], 1u); break; } }
    }
    nloc = mine > 0u ? mine : 1u; nx = cnt > 0u ? cnt : 1u;
}
__device__ __forceinline__ void xcd_barrier(const XcdBarrier& b) {
    asm volatile("s_waitcnt vmcnt(0)" ::: "memory");
    __syncthreads();
    if (threadIdx.x == 0) {
        unsigned* bar = b.bar;
        __builtin_amdgcn_s_waitcnt(0);
        unsigned nloc = b.st[0], nx = b.st[1];
        if (nloc == 0u) { xcd_barrier_complete(bar, b.x, nloc, nx); b.st[0] = nloc; b.st[1] = nx; }
        const unsigned old = xb_add(&bar[XB_XSUB(b.x)], 1u);
        const unsigned gen = old / nloc;
        if (old + 1u == (gen + 1u) * nloc) {
            __builtin_amdgcn_fence(__ATOMIC_RELEASE, "agent");
            asm volatile("s_waitcnt vmcnt(0)" ::: "memory");
            const unsigned og = xb_add(&bar[XB_TOP], 1u);
            const unsigned tg = og / nx;
            if (og + 1u == (tg + 1u) * nx) xb_add(&bar[XB_TOPGEN], 1u);
            else XB_SPIN(xb_ld(&bar[XB_TOPGEN]) == tg, bar);
            __builtin_amdgcn_fence(__ATOMIC_ACQUIRE, "agent");
            xb_add(&bar[XB_XGEN(b.x)], 1u);
            asm volatile("s_waitcnt vmcnt(0)" ::: "memory");
        } else {
            XB_SPIN(xb_ld(&bar[XB_XGEN(b.x)]) == gen, bar);
            __builtin_amdgcn_fence(__ATOMIC_ACQUIRE, "agent");
            asm volatile("s_waitcnt vmcnt(0)" ::: "memory");
        }
    }
    __syncthreads();
}

struct Args {
    const float* x; const int* pos; const float* w_in; const float* w_gate_up; const float* b_gate; const float* gla_norm_w; const float* gmlp_ln_g; const float* gmlp_ln_b;
    const float* gmlp_w_s; const float* gmlp_b_s; const float* w_branch; const float* w_out; const float* ln1_g; const float* ln1_b; const float* w_ff1; const float* w_ff2;
    const float* ln2_g; const float* ln2_b; float* out; unsigned char* ws; int ph_lo, ph_hi;
};

__device__ __forceinline__ float wave_sum(float v) {
#pragma unroll
    for (int o = 1; o < 64; o <<= 1) v += __shfl_xor(v, o);
    return v;
}

__device__ __forceinline__ void transpose_item(const float* W, int ldw, int col0, int K, int nblk, bf16_t* WT, int row_off, LAS float* scr, int item, int lane) {
    const int kb = item / nblk, nb = item % nblk, k0 = 64 * kb, n0 = 32 * nb;
#pragma unroll 8
    for (int i = 0; i < 32; ++i) { const int kk = 2 * i + (lane >> 5); scr[kk * 33 + (lane & 31)] = W[(size_t)(k0 + kk) * ldw + col0 + n0 + (lane & 31)]; }
    asm volatile("s_waitcnt lgkmcnt(0)" ::: "memory");
    const int c = lane & 7;
#pragma unroll
    for (int j = 0; j < 4; ++j) { const int n = (lane >> 3) + 8 * j; const LAS float* s = scr + (8 * c) * 33 + n;
        u32x4 o; o.x = cvt_pk_bf16(s[0 * 33], s[1 * 33]); o.y = cvt_pk_bf16(s[2 * 33], s[3 * 33]); o.z = cvt_pk_bf16(s[4 * 33], s[5 * 33]); o.w = cvt_pk_bf16(s[6 * 33], s[7 * 33]);
        *(u32x4*)(WT + (size_t)(row_off + n0 + n) * K + k0 + 8 * c) = o; }
    asm volatile("s_waitcnt lgkmcnt(0)" ::: "memory");
}

__device__ __forceinline__ void phase_prep(const Args& a, int l, LAS unsigned char* lds, int G) {
    const int tid = otid(), lane = tid & 63, wave = tid >> 6;
    LAS float* scr = (LAS float*)(lds + wave * 16384);
    const int gw = blockIdx.x * NWAVES + wave, NGW = G * NWAVES;
    bf16_t* WinT = (bf16_t*)(a.ws + WS_WIN); bf16_t* WbrT = (bf16_t*)(a.ws + WS_WBR); bf16_t* WoutT = (bf16_t*)(a.ws + WS_WOUT); bf16_t* W1T = (bf16_t*)(a.ws + WS_W1); bf16_t* W2T = (bf16_t*)(a.ws + WS_W2);
    const float* win = a.w_in + (size_t)l * D * IN_COLS;
    constexpr int I_IN_A = 16 * 64, I_IN_B = 16 * 176, I_BR = 8 * 32, I_OUT = 16 * 32, I_1 = 16 * 128, I_2 = 64 * 32;
    constexpr int NITEMS = I_IN_A + I_IN_B + 3 * I_BR + I_OUT + I_1 + I_2;
    for (int it = gw; it < NITEMS; it += NGW) {
        int r = it;
        if (r < I_IN_A) { transpose_item(win, IN_COLS, 0, D, 64, WinT, 0, scr, r, lane); continue; } r -= I_IN_A;
        if (r < I_IN_B) { transpose_item(win, IN_COLS, 2064, D, 176, WinT, 2048, scr, r, lane); continue; } r -= I_IN_B;
        if (r < 3 * I_BR) { const int br = r / I_BR; transpose_item(a.w_branch + ((size_t)l * 3 + br) * 512 * 1024, 1024, 0, 512, 32, WbrT, br * 1024, scr, r % I_BR, lane); continue; } r -= 3 * I_BR;
        if (r < I_OUT) { transpose_item(a.w_out + (size_t)l * D * D, D, 0, D, 32, WoutT, 0, scr, r, lane); continue; } r -= I_OUT;
        if (r < I_1) { transpose_item(a.w_ff1 + (size_t)l * D * FF, FF, 0, D, 128, W1T, 0, scr, r, lane); continue; } r -= I_1;
        transpose_item(a.w_ff2 + (size_t)l * FF * D, D, 0, FF, 32, W2T, 0, scr, r, lane);
    }
    { bf16_t* glrT = (bf16_t*)(a.ws + WS_GLR);
      const int e = blockIdx.x * NTHREADS + tid;
      if (e < 16 * 1024) { const int n = e >> 10, k = e & 1023; glrT[e] = (bf16_t)(cvt_pk_bf16(win[(size_t)k * IN_COLS + 2048 + n], 0.f) & 0xffffu); } }
    if (l == 0) {
        bf16_t* xbf = (bf16_t*)(a.ws + WS_XBF);
        for (size_t e = (size_t)(blockIdx.x * NTHREADS + tid) * 8; e < (size_t)M * D; e += (size_t)G * NTHREADS * 8) {
            const f32x4 v0 = *(const f32x4*)(a.x + e), v1 = *(const f32x4*)(a.x + e + 4);
            u32x4 w; w.x = cvt_pk_bf16(v0[0], v0[1]); w.y = cvt_pk_bf16(v0[2], v0[3]); w.z = cvt_pk_bf16(v1[0], v1[1]); w.w = cvt_pk_bf16(v1[2], v1[3]);
            *(u32x4*)(xbf + e) = w; }
    }
}

__device__ __forceinline__ void gla_bcum(const Args& a, int l, LAS unsigned char* lds, int m0, int h, float (&c)[16], float& bend) {
    const int tid = otid(), lane = tid & 63, wave = tid >> 6, fr = lane & 15, fq = lane >> 4;
    LAS float* lr = (LAS float*)lds; LAS float* tot = (LAS float*)(lds + 4352);
    const bf16_t* xbf = (const bf16_t*)(a.ws + WS_XBF); const bf16_t* glrT = (const bf16_t*)(a.ws + WS_GLR);
    if (tid < 128) {
        const int s = tid >> 1, hf = tid & 1;
        const u32x4 w = *(const u32x4*)((const bf16_t*)(a.ws + WS_PROJ) + (size_t)(m0 + s) * NP + C_LR + hf * 8);
        LAS float* lp = lr + s * 17 + hf * 8;
        lp[0] = bflo(w.x); lp[1] = bfhi(w.x); lp[2] = bflo(w.y); lp[3] = bfhi(w.y); lp[4] = bflo(w.z); lp[5] = bfhi(w.z); lp[6] = bflo(w.w); lp[7] = bfhi(w.w);
    }
    __syncthreads();
    const int d = tid & 127, g = tid >> 7, col = h * 128 + d;
    float wu[16];
#pragma unroll
    for (int r = 0; r < 16; ++r) wu[r] = a.w_gate_up[((size_t)l * 16 + r) * 512 + col];
    const float bg = a.b_gate[(size_t)l * 512 + col];
    float run = 0.f;
#pragma unroll
    for (int i = 0; i < 16; ++i) { const int s = g * 16 + i; float z = bg;
#pragma unroll
        for (int r = 0; r < 16; ++r) z += lr[s * 17 + r] * wu[r];
        const float la = (fminf(z, 0.f) - __logf(1.f + __expf(-fabsf(z)))) * (1.f / 16.f);
        run += la; c[i] = run; }
    tot[g * 128 + d] = run;
    __syncthreads();
    float pre = 0.f, all = 0.f;
#pragma unroll
    for (int gg = 0; gg < 4; ++gg) { const float t = tot[gg * 128 + d]; all += t; if (gg < g) pre += t; }
#pragma unroll
    for (int i = 0; i < 16; ++i) c[i] += pre;
    bend = all;
}

__device__ __forceinline__ void gla_kv_unit(const Args& a, int l, LAS unsigned char* lds, int unit) {
    const int h = unit & 3, n = (unit >> 2) & 127, b = unit >> 9, m0 = b * SEQ + n * 64;
    const int tid = otid(), lane = tid & 63, wave = tid >> 6, fr = lane & 15, fq = lane >> 4;
    const bf16_t* proj = (const bf16_t*)(a.ws + WS_PROJ);
    const int d = tid & 127, g = tid >> 7, col = h * 128 + d;
    unsigned kraw[8], vw[8];
#pragma unroll
    for (int i = 0; i < 16; i += 2) { const size_t r0 = (size_t)(m0 + g * 16 + i) * NP, r1 = r0 + NP;
        kraw[i >> 1] = (unsigned)proj[r0 + C_GK + col] | ((unsigned)proj[r1 + C_GK + col] << 16); vw[i >> 1] = (unsigned)proj[r0 + C_GV + col] | ((unsigned)proj[r1 + C_GV + col] << 16); }
    float c[16], bend; gla_bcum(a, l, lds, m0, h, c, bend);
    LAS unsigned char* keT = lds + 8192; LAS unsigned char* vT = lds + 8192 + 128 * 144;
    unsigned kw[8];
#pragma unroll
    for (int i = 0; i < 16; i += 2) { const float k0 = bflo(kraw[i >> 1]) * __expf(bend - c[i]), k1 = bfhi(kraw[i >> 1]) * __expf(bend - c[i + 1]); kw[i >> 1] = cvt_pk_bf16(k0, k1); }
    *(LAS u32x4*)(keT + d * 144 + g * 32) = (u32x4){kw[0], kw[1], kw[2], kw[3]}; *(LAS u32x4*)(keT + d * 144 + g * 32 + 16) = (u32x4){kw[4], kw[5], kw[6], kw[7]};
    *(LAS u32x4*)(vT + d * 144 + g * 32) = (u32x4){vw[0], vw[1], vw[2], vw[3]}; *(LAS u32x4*)(vT + d * 144 + g * 32 + 16) = (u32x4){vw[4], vw[5], vw[6], vw[7]};
    const int bh = b * 4 + h;
    if (g == 0) ((float*)(a.ws + WS_DEC))[((size_t)bh * 128 + n) * 128 + d] = __expf(bend);
    __syncthreads();
    bf16_t* ST = (bf16_t*)(a.ws + WS_ST) + ((size_t)bh * 128 + n) * 16384;
    bf16x8 af[2];
#pragma unroll
    for (int kk = 0; kk < 2; ++kk) af[kk] = *(const LAS bf16x8*)(keT + (wave * 16 + fr) * 144 + kk * 64 + fq * 16);
#pragma unroll
    for (int dvt = 0; dvt < 8; ++dvt) { f32x4 acc = {0.f, 0.f, 0.f, 0.f};
#pragma unroll
        for (int kk = 0; kk < 2; ++kk) { const bf16x8 bv = *(const LAS bf16x8*)(vT + (dvt * 16 + fr) * 144 + kk * 64 + fq * 16); acc = mfma16(af[kk], bv, acc); }
        u32x2 w; w.x = cvt_pk_bf16(acc[0], acc[1]); w.y = cvt_pk_bf16(acc[2], acc[3]);
        *(u32x2*)(ST + (size_t)(dvt * 16 + fr) * 128 + wave * 16 + 4 * fq) = w; }
    __syncthreads();
}

__device__ __forceinline__ void gla_scan(const Args& a, int G) {
    const int tid = otid();
    for (int e = blockIdx.x * NTHREADS + tid; e < 8 * 128 * 64; e += G * NTHREADS) {
        const int dkp = e & 63, dv = (e >> 6) & 127, bh = e >> 13;
        unsigned* st = (unsigned*)(a.ws + WS_ST) + ((size_t)bh * 128 * 16384 + (size_t)dv * 128) / 2 + dkp;
        const f32x2* dec = (const f32x2*)(a.ws + WS_DEC) + ((size_t)bh * 128 * 128) / 2 + dkp;
        float s0 = 0.f, s1 = 0.f;
#pragma unroll 8
        for (int n = 0; n < 128; ++n) { const unsigned kv = st[(size_t)n * 8192]; const f32x2 dc = dec[n * 64];
            st[(size_t)n * 8192] = cvt_pk_bf16(s0, s1);
            s0 = dc.x * s0 + bflo(kv); s1 = dc.y * s1 + bfhi(kv); }
    }
}

__device__ __forceinline__ void gla_out_unit(const Args& a, int l, LAS unsigned char* lds, int unit) {
    const int h = unit & 3, n = (unit >> 2) & 127, b = unit >> 9, m0 = b * SEQ + n * 64;
    const int tid = otid(), lane = tid & 63, wave = tid >> 6, fr = lane & 15, fq = lane >> 4;
    const bf16_t* proj = (const bf16_t*)(a.ws + WS_PROJ);
    const int d = tid & 127, g = tid >> 7, col = h * 128 + d;
    unsigned qraw[8], kraw[8], vw[8];
#pragma unroll
    for (int i = 0; i < 16; i += 2) { const size_t r0 = (size_t)(m0 + g * 16 + i) * NP, r1 = r0 + NP;
        qraw[i >> 1] = (unsigned)proj[r0 + C_GQ + col] | ((unsigned)proj[r1 + C_GQ + col] << 16); kraw[i >> 1] = (unsigned)proj[r0 + C_GK + col] | ((unsigned)proj[r1 + C_GK + col] << 16);
        vw[i >> 1] = (unsigned)proj[r0 + C_GV + col] | ((unsigned)proj[r1 + C_GV + col] << 16); }
    float c[16], bend; gla_bcum(a, l, lds, m0, h, c, bend);
    LAS unsigned char* qd = lds + 8192;
    LAS unsigned char* ki = qd + 64 * 272;
    LAS unsigned char* vT = ki + 64 * 272;
    LAS unsigned char* at = vT + 128 * 144;
    LAS float* ssq = (LAS float*)(at + 64 * 144);
#pragma unroll
    for (int i = 0; i < 16; i += 2) {
        const float e0 = __expf(c[i]), e1 = __expf(c[i + 1]);
        const float q0 = bflo(qraw[i >> 1]) * e0, q1 = bfhi(qraw[i >> 1]) * e1;
        const float k0 = bflo(kraw[i >> 1]) * 0.08838834764831845f / e0, k1 = bfhi(kraw[i >> 1]) * 0.08838834764831845f / e1;
        *(LAS bf16_t*)(qd + (g * 16 + i) * 272 + d * 2) = (bf16_t)(cvt_pk_bf16(q0, 0.f) & 0xffffu); *(LAS bf16_t*)(qd + (g * 16 + i + 1) * 272 + d * 2) = (bf16_t)(cvt_pk_bf16(q1, 0.f) & 0xffffu);
        *(LAS bf16_t*)(ki + (g * 16 + i) * 272 + d * 2) = (bf16_t)(cvt_pk_bf16(k0, 0.f) & 0xffffu); *(LAS bf16_t*)(ki + (g * 16 + i + 1) * 272 + d * 2) = (bf16_t)(cvt_pk_bf16(k1, 0.f) & 0xffffu); }
    *(LAS u32x4*)(vT + d * 144 + g * 32) = (u32x4){vw[0], vw[1], vw[2], vw[3]}; *(LAS u32x4*)(vT + d * 144 + g * 32 + 16) = (u32x4){vw[4], vw[5], vw[6], vw[7]};
    __syncthreads();
    { const int tt = wave >> 1;
      bf16x8 qf[4];
#pragma unroll
      for (int kk = 0; kk < 4; ++kk) qf[kk] = *(const LAS bf16x8*)(qd + (tt * 16 + fr) * 272 + kk * 64 + fq * 16);
#pragma unroll
      for (int s2 = 0; s2 < 2; ++s2) { const int stl = (wave & 1) * 2 + s2; f32x4 acc = {0.f, 0.f, 0.f, 0.f};
#pragma unroll
          for (int kk = 0; kk < 4; ++kk) { const bf16x8 kf = *(const LAS bf16x8*)(ki + (stl * 16 + fr) * 272 + kk * 64 + fq * 16); acc = mfma16(kf, qf[kk], acc); }
          const int t = tt * 16 + fr, s0 = stl * 16 + 4 * fq;
#pragma unroll
          for (int jj = 0; jj < 4; ++jj) if (s0 + jj > t) acc[jj] = 0.f;
          u32x2 w; w.x = cvt_pk_bf16(acc[0], acc[1]); w.y = cvt_pk_bf16(acc[2], acc[3]);
          *(LAS u32x2*)(at + t * 144 + s0 * 2) = w; } }
    __syncthreads();
    const int tt = wave & 3, dvh = wave >> 2, bh = b * 4 + h;
    const bf16_t* ST = (const bf16_t*)(a.ws + WS_ST) + ((size_t)bh * 128 + n) * 16384;
    bf16x8 atf[2], qf[4];
#pragma unroll
    for (int kk = 0; kk < 2; ++kk) atf[kk] = *(const LAS bf16x8*)(at + (tt * 16 + fr) * 144 + kk * 64 + fq * 16);
#pragma unroll
    for (int kk = 0; kk < 4; ++kk) qf[kk] = *(const LAS bf16x8*)(qd + (tt * 16 + fr) * 272 + kk * 64 + fq * 16);
    f32x4 o[4]; float sq = 0.f;
#pragma unroll
    for (int j = 0; j < 4; ++j) { const int dvt = dvh * 4 + j; f32x4 acc = {0.f, 0.f, 0.f, 0.f};
#pragma unroll
        for (int kk = 0; kk < 2; ++kk) { const bf16x8 vf = *(const LAS bf16x8*)(vT + (dvt * 16 + fr) * 144 + kk * 64 + fq * 16); acc = mfma16(vf, atf[kk], acc); }
        f32x4 acs = {0.f, 0.f, 0.f, 0.f};
#pragma unroll
        for (int kk = 0; kk < 4; ++kk) { const bf16x8 sf = *(const bf16x8*)(ST + (size_t)(dvt * 16 + fr) * 128 + kk * 32 + fq * 8); acs = mfma16(sf, qf[kk], acs); }
        acc += acs * 0.08838834764831845f;
        o[j] = acc; sq += acc[0] * acc[0] + acc[1] * acc[1] + acc[2] * acc[2] + acc[3] * acc[3]; }
    sq += __shfl_xor(sq, 16); sq += __shfl_xor(sq, 32);
    if (fq == 0) ssq[dvh * 64 + tt * 16 + fr] = sq;
    __syncthreads();
    const float rs = 1.f / sqrtf((ssq[tt * 16 + fr] + ssq[64 + tt * 16 + fr]) * (1.f / 128.f) + RMS_EPS);
    const int m = m0 + tt * 16 + fr;
    bf16_t* br0 = (bf16_t*)(a.ws + WS_BR);
#pragma unroll
    for (int j = 0; j < 4; ++j) { const int dv = (dvh * 4 + j) * 16 + 4 * fq;
        const f32x4 nw = *(const f32x4*)(a.gla_norm_w + (size_t)l * 128 + dv);
        const u32x2 gw = *(const u32x2*)(proj + (size_t)m * NP + C_GG + h * 128 + dv);
        const float gg[4] = {bflo(gw.x), bfhi(gw.x), bflo(gw.y), bfhi(gw.y)}; float r[4];
#pragma unroll
        for (int e = 0; e < 4; ++e) r[e] = o[j][e] * rs * nw[e] * (gg[e] / (1.f + __expf(-gg[e])));
        u32x2 w; w.x = cvt_pk_bf16(r[0], r[1]); w.y = cvt_pk_bf16(r[2], r[3]);
        *(u32x2*)(br0 + (size_t)m * 512 + h * 128 + dv) = w; }
    __syncthreads();
}

__device__ __forceinline__ float gelu_erf(float v) {
    const float av = fabsf(v), t = __builtin_amdgcn_rcpf(av * 0.2316418882f + 1.0f);
    float q = t * 0.5307027145f + (-0.7265760135f); q = q * t + 0.7107068705f; q = q * t + (-0.142248368f); q = q * t + 0.127414796f; q = q * t;
    const float e = __builtin_amdgcn_exp2f((v * v) * (-0.72134752044f));
    const float m = v * (q * e);
    return v < 0.f ? m : v - m;
}
__device__ __forceinline__ void gmlp_unit(const Args& a, int l, LAS unsigned char* lds, int unit) {
    const int g = unit & 3, nc = (unit >> 2) & 63, b = unit >> 8, m0 = b * SEQ + nc * 128;
    const int tid = otid(), lane = tid & 63, wave = tid >> 6, fr = lane & 15, fq = lane >> 4;
    const bf16_t* proj = (const bf16_t*)(a.ws + WS_PROJ);
    LAS float* stats = (LAS float*)lds;
    LAS unsigned char* vnT = lds + 1024;
    LAS unsigned char* wm = vnT + 128 * 272;
    { const int tok = tid >> 2, part = tid & 3; const bf16_t* vp = proj + (size_t)(m0 + tok) * NP + C_GZV + part * 128;
      float s = 0.f, s2 = 0.f;
#pragma unroll 4
      for (int j = 0; j < 16; ++j) { const u32x4 w = *(const u32x4*)(vp + j * 8); const unsigned ww[4] = {w.x, w.y, w.z, w.w};
#pragma unroll
          for (int e = 0; e < 4; ++e) { const float g0 = gelu_erf(bflo(ww[e])), g1 = gelu_erf(bfhi(ww[e])); s += g0 + g1; s2 += g0 * g0 + g1 * g1; } }
      s += __shfl_xor(s, 1); s += __shfl_xor(s, 2); s2 += __shfl_xor(s2, 1); s2 += __shfl_xor(s2, 2);
      const float mean = s * (1.f / 512.f), var = fmaxf(s2 * (1.f / 512.f) - mean * mean, 0.f);
      if (part == 0) { stats[tok * 2] = mean; stats[tok * 2 + 1] = 1.f / sqrtf(var + LN_EPS); } }
    { const int t = tid >> 2, sq4 = (tid & 3) * 32; const float* wp = a.gmlp_w_s + (((size_t)l * 4 + g) * 128 + t) * 128 + sq4;
#pragma unroll
      for (int j = 0; j < 4; ++j) { const f32x4 w0 = *(const f32x4*)(wp + j * 8), w1 = *(const f32x4*)(wp + j * 8 + 4); float v[8] = {w0[0], w0[1], w0[2], w0[3], w1[0], w1[1], w1[2], w1[3]};
#pragma unroll
          for (int e = 0; e < 8; ++e) if (sq4 + j * 8 + e > t) v[e] = 0.f;
          *(LAS u32x4*)(wm + t * 272 + (sq4 + j * 8) * 2) = (u32x4){cvt_pk_bf16(v[0], v[1]), cvt_pk_bf16(v[2], v[3]), cvt_pk_bf16(v[4], v[5]), cvt_pk_bf16(v[6], v[7])}; } }
    __syncthreads();
    { const int cch = tid & 127, sg = tid >> 7; const float lg = a.gmlp_ln_g[(size_t)l * 512 + g * 128 + cch], lb = a.gmlp_ln_b[(size_t)l * 512 + g * 128 + cch];
#pragma unroll
      for (int j = 0; j < 4; ++j) { unsigned w[4];
#pragma unroll
          for (int e = 0; e < 4; ++e) { const int s0 = sg * 32 + j * 8 + e * 2;
              const float v0 = gelu_erf(bf2f(proj[(size_t)(m0 + s0) * NP + C_GZV + g * 128 + cch])), v1 = gelu_erf(bf2f(proj[(size_t)(m0 + s0 + 1) * NP + C_GZV + g * 128 + cch]));
              w[e] = cvt_pk_bf16((v0 - stats[s0 * 2]) * stats[s0 * 2 + 1] * lg + lb, (v1 - stats[s0 * 2 + 2]) * stats[s0 * 2 + 3] * lg + lb); }
          *(LAS u32x4*)(vnT + cch * 272 + (sg * 32 + j * 8) * 2) = (u32x4){w[0], w[1], w[2], w[3]}; } }
    __syncthreads();
    const int nk = ((wave * 16 + 15) >> 5) + 1;
    bf16x8 wf[4];
#pragma unroll
    for (int kk = 0; kk < 4; ++kk) wf[kk] = *(const LAS bf16x8*)(wm + (wave * 16 + fr) * 272 + kk * 64 + fq * 16);
    const int t = wave * 16 + fr, m = m0 + t;
    const float bs = a.gmlp_b_s[((size_t)l * 4 + g) * 128 + t];
    bf16_t* br1 = (bf16_t*)(a.ws + WS_BR) + (size_t)M * 512;
#pragma unroll
    for (int ct = 0; ct < 8; ++ct) { f32x4 acc = {0.f, 0.f, 0.f, 0.f};
#pragma unroll
        for (int kk = 0; kk < 4; ++kk) if (kk < nk) { const bf16x8 vf = *(const LAS bf16x8*)(vnT + (ct * 16 + fr) * 272 + kk * 64 + fq * 16); acc = mfma16(vf, wf[kk], acc); }
        const int cc = g * 128 + ct * 16 + 4 * fq;
        const u32x2 uw = *(const u32x2*)(proj + (size_t)m * NP + C_GZU + cc);
        const float u0 = gelu_erf(bflo(uw.x)), u1 = gelu_erf(bfhi(uw.x)), u2 = gelu_erf(bflo(uw.y)), u3 = gelu_erf(bfhi(uw.y));
        u32x2 w; w.x = cvt_pk_bf16(u0 * (acc[0] + bs), u1 * (acc[1] + bs)); w.y = cvt_pk_bf16(u2 * (acc[2] + bs), u3 * (acc[3] + bs));
        *(u32x2*)(br1 + (size_t)m * 512 + cc) = w; }
    __syncthreads();
}

__device__ __forceinline__ void moba_prep_unit(const Args& a, LAS unsigned char* lds, int unit) {
    const int blk = unit & 31, h = (unit >> 5) & 3, b = unit >> 7, m0 = b * SEQ + blk * 256;
    const int tid = otid();
    bf16_t* proj = (bf16_t*)(a.ws + WS_PROJ);
#pragma unroll 2
    for (int it = 0; it < 8; ++it) { const int item = tid + it * NTHREADS, tok = item >> 4, i = item & 15; const size_t m = (size_t)(m0 + tok);
        const float inv = exp2f(-(float)i * (18.931568569324174f / 16.f));
        const float ang = (float)a.pos[m] * inv; float sn, cs; sincosf(ang, &sn, &cs);
        bf16_t* kp = proj + m * NP + C_MK + h * 128 + i; bf16_t* qp = proj + m * NP + C_MQ + h * 128 + i;
        const float k1 = bf2f(kp[0]), k2 = bf2f(kp[16]), q1 = bf2f(qp[0]), q2 = bf2f(qp[16]);
        const unsigned kw = cvt_pk_bf16(k1 * cs - k2 * sn, k2 * cs + k1 * sn), qw = cvt_pk_bf16(q1 * cs - q2 * sn, q2 * cs + q1 * sn);
        kp[0] = (bf16_t)(kw & 0xffffu); kp[16] = (bf16_t)(kw >> 16); qp[0] = (bf16_t)(qw & 0xffffu); qp[16] = (bf16_t)(qw >> 16); }
    __threadfence_block();
    __syncthreads();
    { const int d = tid & 127, kg = tid >> 7; LAS float* red = (LAS float*)lds; float s = 0.f;
#pragma unroll 8
      for (int j = 0; j < 64; ++j) s += bf2f(proj[(size_t)(m0 + kg * 64 + j) * NP + C_MK + h * 128 + d]);
      red[kg * 128 + d] = s;
      __syncthreads();
      if (kg == 0) ((float*)(a.ws + WS_KMEAN))[((size_t)(b * 4 + h) * 32 + blk) * 128 + d] = (red[d] + red[128 + d] + red[256 + d] + red[384 + d]) * (1.f / 256.f);
      __syncthreads(); }
    { LAS unsigned char* tT = lds + 4096;
#pragma unroll 2
      for (int it = 0; it < 8; ++it) { const int p = tid + it * NTHREADS, key = p >> 4, pc = p & 15;
          const u32x4 w = *(const u32x4*)(proj + (size_t)(m0 + key) * NP + C_MV + h * 128 + pc * 8); const unsigned ww[4] = {w.x, w.y, w.z, w.w};
#pragma unroll
          for (int e = 0; e < 4; ++e) { *(LAS bf16_t*)(tT + (pc * 8 + 2 * e) * 528 + key * 2) = (bf16_t)(ww[e] & 0xffffu); *(LAS bf16_t*)(tT + (pc * 8 + 2 * e + 1) * 528 + key * 2) = (bf16_t)(ww[e] >> 16); } }
      __syncthreads();
      bf16_t* VT = (bf16_t*)(a.ws + WS_VT) + (size_t)(b * 4 + h) * 128 * SEQ + blk * 256;
#pragma unroll 2
      for (int it = 0; it < 8; ++it) { const int p = tid + it * NTHREADS, dv = p >> 5, pc = p & 31;
          *(u32x4*)(VT + (size_t)dv * SEQ + pc * 8) = *(const LAS u32x4*)(tT + dv * 528 + pc * 16); }
      __syncthreads(); }
}

__device__ __forceinline__ bf16_t* moba_part(const Args& a, int bh, int row, int k) {
    const size_t pr = (size_t)bh * SEQ + row;
    return (k < 2) ? (bf16_t*)(a.ws + WS_XBF) + (pr * 2 + k) * 128 : (bf16_t*)(a.ws + WS_MERGED) + (pr * 2 + (k - 2)) * 128;
}
__device__ __forceinline__ void moba_core(const Args& a, LAS unsigned char* lds, int b, int h, int row, bool valid, int slot, int kp_first, int ntiles, bool causal, int q0w) {
    const int tid = otid(), lane = tid & 63, fr = lane & 15, fq = lane >> 4;
    const int bh = b * 4 + h;
    const bf16_t* proj = (const bf16_t*)(a.ws + WS_PROJ);
    LAS unsigned char* Ks = lds + 34816;
    LAS unsigned char* Vs = lds + 34816 + 64 * 272;
    const bool wave_any = __builtin_amdgcn_ballot_w64(valid) != 0ull;
    bf16x8 qf[4];
#pragma unroll
    for (int kk = 0; kk < 4; ++kk) qf[kk] = *(const bf16x8*)(proj + (size_t)(b * SEQ + row) * NP + C_MQ + h * 128 + kk * 32 + fq * 8);
    f32x4 o[8];
#pragma unroll
    for (int j = 0; j < 8; ++j) o[j] = (f32x4){0.f, 0.f, 0.f, 0.f};
    float mrun = -INFINITY, lrun = 0.f;
    const bf16_t* kbase = proj + (size_t)(b * SEQ) * NP + C_MK + h * 128;
    const bf16_t* vbase = (const bf16_t*)(a.ws + WS_VT) + (size_t)bh * 128 * SEQ;
    u32x4 kreg[2], vreg[2];
#pragma unroll
    for (int i = 0; i < 2; ++i) { const int p = tid + i * NTHREADS; kreg[i] = *(const u32x4*)(kbase + (size_t)(kp_first + (p >> 4)) * NP + (p & 15) * 8); vreg[i] = *(const u32x4*)(vbase + (size_t)(p >> 3) * SEQ + kp_first + (p & 7) * 8); }
    const float SC = 0.08838834764831845f * 1.4426950408889634f;
    for (int it = 0; it < ntiles; ++it) {
        const int kp0 = kp_first + it * 64;
        __syncthreads();
#pragma unroll
        for (int i = 0; i < 2; ++i) { const int p = tid + i * NTHREADS; *(LAS u32x4*)(Ks + (p >> 4) * 272 + (p & 15) * 16) = kreg[i]; *(LAS u32x4*)(Vs + (p >> 3) * 144 + (p & 7) * 16) = vreg[i]; }
        __syncthreads();
        if (it + 1 < ntiles) { const int kn = kp0 + 64;
#pragma unroll
            for (int i = 0; i < 2; ++i) { const int p = tid + i * NTHREADS; kreg[i] = *(const u32x4*)(kbase + (size_t)(kn + (p >> 4)) * NP + (p & 15) * 8); vreg[i] = *(const u32x4*)(vbase + (size_t)(p >> 3) * SEQ + kn + (p & 7) * 8); } }
        const bool active = causal ? (kp0 <= q0w + 15) : wave_any;
        if (active) {
            f32x4 st[4];
#pragma unroll
            for (int kt = 0; kt < 4; ++kt) { f32x4 acc = {0.f, 0.f, 0.f, 0.f};
#pragma unroll
                for (int kk = 0; kk < 4; ++kk) { const bf16x8 kf = *(const LAS bf16x8*)(Ks + (kt * 16 + fr) * 272 + kk * 64 + fq * 16); acc = mfma16(kf, qf[kk], acc); }
                st[kt] = acc * SC; }
            if (causal) {
#pragma unroll
                for (int kt = 0; kt < 4; ++kt)
#pragma unroll
                    for (int jj = 0; jj < 4; ++jj) if (kp0 + kt * 16 + 4 * fq + jj > row) st[kt][jj] = -INFINITY;
            }
            float mx = -INFINITY;
#pragma unroll
            for (int kt = 0; kt < 4; ++kt) mx = fmaxf(mx, fmaxf(fmaxf(st[kt][0], st[kt][1]), fmaxf(st[kt][2], st[kt][3])));
            mx = fmaxf(mx, __shfl_xor(mx, 16)); mx = fmaxf(mx, __shfl_xor(mx, 32));
            const float mnew = fmaxf(mrun, mx);
            const float msafe = (mnew == -INFINITY) ? 0.f : mnew;
            const float alpha = __builtin_amdgcn_exp2f(mrun - msafe);
            float ls = 0.f;
#pragma unroll
            for (int kt = 0; kt < 4; ++kt)
#pragma unroll
                for (int jj = 0; jj < 4; ++jj) { const float p = __builtin_amdgcn_exp2f(st[kt][jj] - msafe); st[kt][jj] = p; ls += p; }
            ls += __shfl_xor(ls, 16); ls += __shfl_xor(ls, 32);
            lrun = lrun * alpha + ls; mrun = mnew;
            bf16x8 pf[2];
#pragma unroll
            for (int k2 = 0; k2 < 2; ++k2) { const u32x4 w = {cvt_pk_bf16(st[2 * k2][0], st[2 * k2][1]), cvt_pk_bf16(st[2 * k2][2], st[2 * k2][3]), cvt_pk_bf16(st[2 * k2 + 1][0], st[2 * k2 + 1][1]), cvt_pk_bf16(st[2 * k2 + 1][2], st[2 * k2 + 1][3])};
                pf[k2] = __builtin_bit_cast(bf16x8, w); }
#pragma unroll
            for (int dvt = 0; dvt < 8; ++dvt) { f32x4 acc = o[dvt] * alpha;
#pragma unroll
                for (int k2 = 0; k2 < 2; ++k2) { const u32x2 v0 = *(const LAS u32x2*)(Vs + (dvt * 16 + fr) * 144 + (32 * k2 + 4 * fq) * 2), v1 = *(const LAS u32x2*)(Vs + (dvt * 16 + fr) * 144 + (32 * k2 + 16 + 4 * fq) * 2);
                    const u32x4 vw = {v0.x, v0.y, v1.x, v1.y};
                    acc = mfma16(__builtin_bit_cast(bf16x8, vw), pf[k2], acc); }
                o[dvt] = acc; }
        }
    }
    if (valid) {
        const float il = 1.f / lrun;
        bf16_t* op = moba_part(a, bh, row, slot);
#pragma unroll
        for (int dvt = 0; dvt < 8; ++dvt) { u32x2 w; w.x = cvt_pk_bf16(o[dvt][0] * il, o[dvt][1] * il); w.y = cvt_pk_bf16(o[dvt][2] * il, o[dvt][3] * il);
            *(u32x2*)(op + dvt * 16 + 4 * fq) = w; }
        if (fq == 0) ((f32x2*)(a.ws + WS_ML))[((size_t)bh * SEQ + row) * 4 + slot] = (f32x2){mrun, lrun};
    }
    __syncthreads();
}

__device__ __forceinline__ void moba_own_unit(const Args& a, LAS unsigned char* lds, int b, int h, int qt) {
    const int tid = otid(), lane = tid & 63, wave = tid >> 6, fr = lane & 15;
    const int q0 = qt * 128, own = q0 >> 8, bs = own * 256, m0 = b * SEQ + q0, bh = b * 4 + h;
    const bf16_t* proj = (const bf16_t*)(a.ws + WS_PROJ);
    LAS float* km = (LAS float*)lds;
    LAS float* sc = (LAS float*)(lds + 16384);
    const float* kmg = (const float*)(a.ws + WS_KMEAN) + (size_t)bh * 32 * 128;
    int* cnt = (int*)(a.ws + WS_CTL + 14336); int* list = (int*)(a.ws + WS_LIST);
    if (own > 3) {
        for (int e = tid; e < own * 128; e += NTHREADS) km[e] = kmg[e];
        __syncthreads();
        const int row = tid >> 2, part = tid & 3; const bf16_t* qp = proj + (size_t)(m0 + row) * NP + C_MQ + h * 128;
        float s8[8];
#pragma unroll
        for (int jj = 0; jj < 8; ++jj) s8[jj] = 0.f;
#pragma unroll 2
        for (int dc = 0; dc < 16; ++dc) { const u32x4 w = *(const u32x4*)(qp + dc * 8); const float qv[8] = {bflo(w.x), bfhi(w.x), bflo(w.y), bfhi(w.y), bflo(w.z), bfhi(w.z), bflo(w.w), bfhi(w.w)};
#pragma unroll
            for (int jj = 0; jj < 8; ++jj) { const int j = part + 4 * jj; if (j < own) {
#pragma unroll
                for (int e = 0; e < 8; ++e) s8[jj] += qv[e] * km[j * 128 + dc * 8 + e]; } } }
#pragma unroll
        for (int jj = 0; jj < 8; ++jj) { const int j = part + 4 * jj; if (j < own) sc[row * 33 + j] = s8[jj]; }
        __syncthreads();
    }
    if (tid < 128) { const int ent = (q0 + tid) * 4;
        if (own <= 3) { for (int j = 0; j < own; ++j) { const int pos = atomicAdd(&cnt[bh * 32 + j], 1); list[(size_t)(bh * 32 + j) * SEQ + pos] = ent + j; } }
        else { float b0 = -INFINITY, b1 = -INFINITY, b2 = -INFINITY; int i0 = 0, i1 = 0, i2 = 0;
            for (int j = 0; j < own; ++j) { const float v = sc[tid * 33 + j];
                if (v > b0) { b2 = b1; i2 = i1; b1 = b0; i1 = i0; b0 = v; i0 = j; } else if (v > b1) { b2 = b1; i2 = i1; b1 = v; i1 = j; } else if (v > b2) { b2 = v; i2 = j; } }
            int pos = atomicAdd(&cnt[bh * 32 + i0], 1); list[(size_t)(bh * 32 + i0) * SEQ + pos] = ent + 0;
            pos = atomicAdd(&cnt[bh * 32 + i1], 1); list[(size_t)(bh * 32 + i1) * SEQ + pos] = ent + 1;
            pos = atomicAdd(&cnt[bh * 32 + i2], 1); list[(size_t)(bh * 32 + i2) * SEQ + pos] = ent + 2; } }
    moba_core(a, lds, b, h, q0 + wave * 16 + fr, true, 3, bs, ((q0 - bs) >> 6) + 2, true, q0 + wave * 16);
}

__device__ __forceinline__ void phase_moba_gather(const Args& a, LAS unsigned char* lds, int G, int bid) {
    const int tid = otid(), lane = tid & 63, wave = tid >> 6, fr = lane & 15;
    LAS int* start = (LAS int*)(lds + 71680);
    int* cnt = (int*)(a.ws + WS_CTL + 14336); const int* list = (const int*)(a.ws + WS_LIST);
    if (tid < 256) start[tid + 1] = (__hip_atomic_load(&cnt[tid], __ATOMIC_RELAXED, __HIP_MEMORY_SCOPE_AGENT) + 127) >> 7;
    __syncthreads();
    if (tid == 0) { int s = 0; start[0] = 0; for (int i = 1; i <= 256; ++i) { s += start[i]; start[i] = s; } }
    __syncthreads();
    const int total = start[256];
    for (int u = bid; u < total; u += G) {
        int lo = 0, hi = 255;
        while (lo < hi) { const int mid = (lo + hi + 1) >> 1; if (start[mid] <= u) lo = mid; else hi = mid - 1; }
        const int e = lo, bh = e >> 5, j = e & 31, chunk = u - start[e];
        const int c = __hip_atomic_load(&cnt[e], __ATOMIC_RELAXED, __HIP_MEMORY_SCOPE_AGENT);
        const int idx = chunk * 128 + wave * 16 + fr; const bool valid = idx < c;
        const int ent = valid ? list[(size_t)e * SEQ + idx] : 0;
        const int row = valid ? (ent >> 2) : (j + 1) * 256;
        moba_core(a, lds, bh >> 2, bh & 3, row, valid, ent & 3, j * 256, 4, false, 0);
    }
}

__device__ __forceinline__ void phase_moba_combine(const Args& a, int G, int bid) {
    const int tid = otid();
    bf16_t* br2 = (bf16_t*)(a.ws + WS_BR) + (size_t)2 * M * 512;
    for (int p = bid * NTHREADS + tid; p < 8 * SEQ * 4; p += G * NTHREADS) {
        const int pair = p >> 2, part = p & 3, bh = pair >> 13, row = pair & (SEQ - 1), own = row >> 8, nsel = own < 3 ? own : 3;
        const f32x2* ml = (const f32x2*)(a.ws + WS_ML) + (size_t)pair * 4;
        const f32x2 m3 = ml[3]; f32x2 mk[3]; float Mx = m3.x;
#pragma unroll
        for (int k = 0; k < 3; ++k) { mk[k] = (k < nsel) ? ml[k] : (f32x2){-INFINITY, 0.f}; Mx = fmaxf(Mx, mk[k].x); }
        float acc[32];
        float wsum = m3.y * __builtin_amdgcn_exp2f(m3.x - Mx);
        { const bf16_t* op = moba_part(a, bh, row, 3) + part * 32;
#pragma unroll
          for (int q = 0; q < 4; ++q) { const u32x4 w = *(const u32x4*)(op + q * 8); const unsigned ww[4] = {w.x, w.y, w.z, w.w};
#pragma unroll
              for (int e2 = 0; e2 < 4; ++e2) { acc[q * 8 + 2 * e2] = wsum * bflo(ww[e2]); acc[q * 8 + 2 * e2 + 1] = wsum * bfhi(ww[e2]); } } }
#pragma unroll
        for (int k = 0; k < 3; ++k) if (k < nsel) { const float wk = mk[k].y * __builtin_amdgcn_exp2f(mk[k].x - Mx); wsum += wk;
            const bf16_t* op = moba_part(a, bh, row, k) + part * 32;
#pragma unroll
            for (int q = 0; q < 4; ++q) { const u32x4 w = *(const u32x4*)(op + q * 8); const unsigned ww[4] = {w.x, w.y, w.z, w.w};
#pragma unroll
                for (int e2 = 0; e2 < 4; ++e2) { acc[q * 8 + 2 * e2] += wk * bflo(ww[e2]); acc[q * 8 + 2 * e2 + 1] += wk * bfhi(ww[e2]); } } }
        const float iw = 1.f / wsum;
        bf16_t* dst = br2 + (size_t)((bh >> 2) * SEQ + row) * 512 + (bh & 3) * 128 + part * 32;
#pragma unroll
        for (int q = 0; q < 4; ++q) *(u32x4*)(dst + q * 8) = (u32x4){cvt_pk_bf16(acc[q * 8] * iw, acc[q * 8 + 1] * iw), cvt_pk_bf16(acc[q * 8 + 2] * iw, acc[q * 8 + 3] * iw), cvt_pk_bf16(acc[q * 8 + 4] * iw, acc[q * 8 + 5] * iw), cvt_pk_bf16(acc[q * 8 + 6] * iw, acc[q * 8 + 7] * iw)};
    }
}

__device__ __forceinline__ void phase_ln(const Args& a, const float* gam, const float* bet, int G) {
    const int tid = otid(), lane = tid & 63, wave = tid >> 6;
    bf16_t* xbf = (bf16_t*)(a.ws + WS_XBF);
    f32x4 gv[4], bv[4];
#pragma unroll
    for (int j = 0; j < 4; ++j) { gv[j] = *(const f32x4*)(gam + 4 * lane + 256 * j); bv[j] = *(const f32x4*)(bet + 4 * lane + 256 * j); }
    for (int m = blockIdx.x * NWAVES + wave; m < M; m += G * NWAVES) {
        f32x4* xr = (f32x4*)(a.out + (size_t)m * D) + lane;
        f32x4 v[4]; float s = 0.f;
#pragma unroll
        for (int j = 0; j < 4; ++j) { v[j] = xr[64 * j]; s += (v[j][0] + v[j][1]) + (v[j][2] + v[j][3]); }
        const float mean = wave_sum(s) * (1.f / D); float s2 = 0.f;
#pragma unroll
        for (int j = 0; j < 4; ++j) { v[j] = v[j] - mean; s2 += (v[j][0] * v[j][0] + v[j][1] * v[j][1]) + (v[j][2] * v[j][2] + v[j][3] * v[j][3]); }
        const float rstd = 1.f / sqrtf(wave_sum(s2) * (1.f / D) + LN_EPS);
        u32x2* o8 = (u32x2*)(xbf + (size_t)m * D) + lane;
#pragma unroll
        for (int j = 0; j < 4; ++j) { const f32x4 y = v[j] * rstd * gv[j] + bv[j]; xr[64 * j] = y; o8[64 * j] = (u32x2){cvt_pk_bf16(y[0], y[1]), cvt_pk_bf16(y[2], y[3])}; }
    }
}

__global__ void __launch_bounds__(NTHREADS, 2) fwd_mega(Args a) {
    extern __shared__ __attribute__((aligned(16))) unsigned char lds_raw[];
    LAS unsigned char* lds = (LAS unsigned char*)lds_raw;
    cg::grid_group grid = cg::this_grid();
    volatile LAS unsigned* bst = (volatile LAS unsigned*)(lds + LDS_BYTES - 64);
    if (threadIdx.x == 0) { bst[0] = 0u; bst[1] = 0u; }
    __syncthreads();
    XcdBarrier xbar = xcd_barrier_post((unsigned*)(a.ws + WS_CTL), bst);
    const int G = gridDim.x, bid = blockIdx.x;
    const float ALPHA = 1.6817928305074290f;
    bf16_t* xbf = (bf16_t*)(a.ws + WS_XBF); bf16_t* proj = (bf16_t*)(a.ws + WS_PROJ);
    for (int ph = a.ph_lo; ph < a.ph_hi; ++ph) {
        const int l = ph / PH_PER_LAYER, k = ph % PH_PER_LAYER;
        int bidp = bid; asm volatile("" : "+s"(bidp));
        switch (k) {
        case 0: if (l == 0) phase_prep(a, 0, lds, G); break;
        case 1: { pg8::Gemm g{xbf, (const bf16_t*)(a.ws + WS_WIN), M, NP, D, D}; pg8::StaticOrder S; S.init(M, NP, G, bidp);
                  pg8::EpiStore<0> E{proj, NP}; pg8::gemm_phase(lds, g, S, E); } break;
        case 2: {
                  { const int t0 = otid(); if (t0 < 256) ((int*)(a.ws + WS_CTL + 14336))[t0] = 0; }
                  for (int u = bidp; u < 1792; u += G) { if (u < 256) moba_prep_unit(a, lds, u); else if (u < 768) gmlp_unit(a, l, lds, u - 256); else gla_kv_unit(a, l, lds, u - 768); } } break;
        case 3: { gla_scan(a, G);
                  for (int i = 0;; ++i) { const int u = i * G + bidp; if (u >= 512) break;
                      int qt, bh; if (u < 256) { qt = 63 - (u >> 3); bh = u & 7; } else { qt = (u - 256) >> 3; bh = u & 7; }
                      moba_own_unit(a, lds, bh >> 2, bh & 3, qt); } } break;
        case 4: phase_moba_gather(a, lds, G, bidp); break;
        case 5: { phase_moba_combine(a, G, bidp); for (int u = bidp; u < 1024; u += G) gla_out_unit(a, l, lds, u); } break;
        case 6: { pg8::Gemm g{(const bf16_t*)(a.ws + WS_BR), (const bf16_t*)(a.ws + WS_WBR), 3 * M, 3 * D, 512, 512}; pg8::MergeOrder S{G, bidp};
                  pg8::EpiMerge E{proj, (float*)(a.ws + WS_PROJ), (bf16_t*)(a.ws + WS_MERGED)}; pg8::gemm_phase(lds, g, S, E); } break;
        case 7: { pg8::Gemm g{(const bf16_t*)(a.ws + WS_MERGED), (const bf16_t*)(a.ws + WS_WOUT), M, D, D, D}; pg8::StaticOrder S; S.init(M, D, G, bidp);
                  pg8::EpiResid E{l == 0 ? a.x : a.out, a.out, ALPHA}; pg8::gemm_phase(lds, g, S, E); } break;
        case 8: phase_ln(a, a.ln1_g + (size_t)l * D, a.ln1_b + (size_t)l * D, G); break;
        case 9: { pg8::Gemm g{xbf, (const bf16_t*)(a.ws + WS_W1), M, FF, D, D}; pg8::StaticOrder S; S.init(M, FF, G, bidp);
                  pg8::EpiStore<2> E{proj, FF}; pg8::gemm_phase(lds, g, S, E); } break;
        case 10: { pg8::Gemm g{proj, (const bf16_t*)(a.ws + WS_W2), M, D, FF, FF}; pg8::StaticOrder S; S.init(M, D, G, bidp);
                  pg8::EpiResid E{a.out, a.out, ALPHA}; pg8::gemm_phase(lds, g, S, E); } break;
        default: phase_ln(a, a.ln2_g + (size_t)l * D, a.ln2_b + (size_t)l * D, G); if (l + 1 < DEPTH) phase_prep(a, l + 1, lds, G); break;
        }
        if (ph + 1 < a.ph_hi && !(ph % PH_PER_LAYER == 0 && ph > 0)) { if (ph == 0) grid.sync(); else xcd_barrier(xbar); }
    }
}

#ifndef MK_PER_PHASE
#define MK_PER_PHASE 0
#endif
extern "C" void kernel_launch(void* const* d_in, const int* in_sizes, int n_in, void* d_out, int out_size, void* d_ws, size_t ws_size, hipStream_t stream) {
    static int grid = 0;
    if (grid == 0) {
        if (n_in != 18 || out_size != M * D || ws_size < WS_END) { fprintf(stderr, "kernel_launch: unexpected problem (n_in %d out %d ws %zu)\n", n_in, out_size, ws_size); grid = -1; return; }
        int dev = 0, cus = 0, per_cu = 0;
        if (hipGetDevice(&dev) != hipSuccess || hipDeviceGetAttribute(&cus, hipDeviceAttributeMultiprocessorCount, dev) != hipSuccess) { grid = -1; return; }
        if (hipFuncSetAttribute((const void*)fwd_mega, hipFuncAttributeMaxDynamicSharedMemorySize, LDS_BYTES) != hipSuccess) { fprintf(stderr, "kernel_launch: hipFuncSetAttribute failed\n"); grid = -1; return; }
        if (hipOccupancyMaxActiveBlocksPerMultiprocessor(&per_cu, (const void*)fwd_mega, NTHREADS, LDS_BYTES) != hipSuccess || per_cu < 1) { fprintf(stderr, "kernel_launch: occupancy query says %d\n", per_cu); per_cu = 1; }
        (void)hipGetLastError();
        grid = cus;
        if (grid < 32) { fprintf(stderr, "kernel_launch: needs >= 32 CUs\n"); grid = -1; return; }
    }
    if (grid < 0) return;
    Args a{};
    a.x = (const float*)d_in[0]; a.pos = (const int*)d_in[1]; a.w_in = (const float*)d_in[2]; a.w_gate_up = (const float*)d_in[3]; a.b_gate = (const float*)d_in[4];
    a.gla_norm_w = (const float*)d_in[5]; a.gmlp_ln_g = (const float*)d_in[6]; a.gmlp_ln_b = (const float*)d_in[7]; a.gmlp_w_s = (const float*)d_in[8]; a.gmlp_b_s = (const float*)d_in[9];
    a.w_branch = (const float*)d_in[10]; a.w_out = (const float*)d_in[11]; a.ln1_g = (const float*)d_in[12]; a.ln1_b = (const float*)d_in[13]; a.w_ff1 = (const float*)d_in[14];
    a.w_ff2 = (const float*)d_in[15]; a.ln2_g = (const float*)d_in[16]; a.ln2_b = (const float*)d_in[17]; a.out = (float*)d_out; a.ws = (unsigned char*)d_ws;
    if (hipMemsetAsync((char*)d_ws + WS_CTL, 0, CTL_BYTES, stream) != hipSuccess) { fprintf(stderr, "kernel_launch: memset of barrier words failed\n"); return; }
#if MK_PER_PHASE
    for (int ph = 0; ph < N_PHASES; ++ph) { a.ph_lo = ph; a.ph_hi = ph + 1; hipLaunchKernelGGL(fwd_mega, dim3(grid), dim3(NTHREADS), LDS_BYTES, stream, a); }
#else
    a.ph_lo = 0; a.ph_hi = N_PHASES;
    void* args[] = {&a};
    hipError_t e = hipLaunchCooperativeKernel((const void*)fwd_mega, dim3(grid), dim3(NTHREADS), args, LDS_BYTES, stream);
    if (e != hipSuccess) fprintf(stderr, "kernel_launch: cooperative launch failed: %s (grid %d)\n", hipGetErrorString(e), grid);
#endif
}
```

```cpp
#include <hip/hip_runtime.h>
#include <hip/hip_cooperative_groups.h>
#include <cstdio>
#include <cstdint>
namespace cg = cooperative_groups;

#define LAS __attribute__((address_space(3)))
typedef unsigned short bf16_t;
typedef short bf16x8 __attribute__((ext_vector_type(8)));
typedef short s16x4 __attribute__((ext_vector_type(4)));
typedef float f32x4 __attribute__((ext_vector_type(4)));
typedef float f32x2 __attribute__((ext_vector_type(2)));
typedef unsigned u32x4 __attribute__((ext_vector_type(4)));
typedef unsigned u32x2 __attribute__((ext_vector_type(2)));

constexpr int BATCH = 2, SEQ = 8192, M = BATCH * SEQ, D = 1024, DEPTH = 4, FF = 4096;
constexpr int IN_COLS = 7696, NP = 7936, C_LR = 7680;
constexpr int C_GQ = 0, C_GK = 512, C_GV = 1024, C_GG = 1536, C_GZU = 2048, C_GZV = 2560, C_MQ = 3072, C_MK = 3584, C_MV = 4096, C_GL = 4608;
constexpr int NWAVES = 8, NTHREADS = 512;
constexpr int LDS_BYTES = 147456;
constexpr float LN_EPS = 1e-5f, RMS_EPS = 1e-6f;
constexpr int PH_PER_LAYER = 12, N_PHASES = DEPTH * PH_PER_LAYER;

constexpr size_t MiB = 1u << 20;
constexpr size_t WS_WIN = 0, WS_GLR = 15 * MiB, WS_WBR = 16 * MiB, WS_WOUT = 19 * MiB, WS_W1 = 21 * MiB, WS_W2 = 29 * MiB;
constexpr size_t WS_XBF = 38 * MiB;
constexpr size_t WS_BR = 70 * MiB;
constexpr size_t WS_ST = 118 * MiB;
constexpr size_t WS_DEC = 150 * MiB;
constexpr size_t WS_KMEAN = WS_DEC + 512 * 1024;
constexpr size_t WS_VT = 151 * MiB;
constexpr size_t WS_MERGED = 167 * MiB;
constexpr size_t WS_PROJ = 200 * MiB;
constexpr size_t WS_CTL = 448 * MiB, CTL_BYTES = 16384;
constexpr size_t WS_ML = 449 * MiB;
constexpr size_t WS_LIST = 451 * MiB;
constexpr size_t WS_END = 459 * MiB;

typedef __bf16 bf16x2_t __attribute__((ext_vector_type(2)));
__device__ __forceinline__ unsigned cvt_pk_bf16(float lo, float hi) { const f32x2 v = {lo, hi}; const bf16x2_t b = __builtin_convertvector(v, bf16x2_t); return __builtin_bit_cast(unsigned, b); }
__device__ __forceinline__ float bf2f(unsigned h) { return __builtin_bit_cast(float, h << 16); }
__device__ __forceinline__ float bflo(unsigned w) { return __builtin_bit_cast(float, w << 16); }
__device__ __forceinline__ float bfhi(unsigned w) { return __builtin_bit_cast(float, w & 0xffff0000u); }
__device__ __forceinline__ int otid() { int t = threadIdx.x; asm volatile("" : "+v"(t)); return t; }
__device__ __forceinline__ f32x4 mfma16(bf16x8 a, bf16x8 b, f32x4 c) { return __builtin_amdgcn_mfma_f32_16x16x32_bf16(a, b, c, 0, 0, 0); }

namespace pg8 {
constexpr int BM = 256, BK = 64, HALF = 128, HTB = HALF * BK * 2, NXCD = 8, WGM = 8;
__host__ __device__ __forceinline__ int lds_byte(int r, int c) { const int st = (r >> 4) * 2 + (c >> 5), rr = r & 15, cc = c & 31, ob = rr * 64 + cc * 2; return st * 1024 + (ob ^ (((ob >> 9) & 1) << 5)); }
__host__ __device__ __forceinline__ void stage_rc(int b, int& R, int& C) { const int st = b / 1024, sb = b % 1024, swz = sb ^ (((sb >> 9) & 1) << 5); R = (st >> 1) * 16 + swz / 64; C = (st & 1) * 32 + (swz % 64) / 2; }
__host__ __device__ __forceinline__ int perm32(int rho) { const int n = rho >> 4, i = rho & 15; return 8 * (i >> 2) + 4 * n + (i & 3); }

struct Unit { int pm, pn; };
struct Gemm { const bf16_t* A; const bf16_t* Bt; int M, N, K, lda; };

struct StaticOrder {
    int nM, nN, nwg, G, c;
    __device__ void init(int M_, int N_, int G_, int c_) { nM = M_ / BM; nN = N_ / BM; nwg = nM * nN; G = G_; c = c_; }
    __device__ bool next(int i, Unit& u) const {
        const long L = (long)i * G + c; if (L >= nwg) return false;
        int wgid = (int)L; { const int q = nwg / NXCD, r = nwg % NXCD, xcd = wgid % NXCD, off = wgid / NXCD; wgid = (xcd < r ? xcd * (q + 1) : r * (q + 1) + (xcd - r) * q) + off; }
        const int nig = WGM * nN, gid = wgid / nig, fm = gid * WGM, gsz = (nM - fm) < WGM ? (nM - fm) : WGM;
        u.pm = fm + ((wgid % nig) % gsz); u.pn = (wgid % nig) / gsz; return true;
    }
};
struct MergeOrder {
    int G, c;
    __device__ bool next(int i, Unit& u) const { const int t = (i / 3) * G + c; if (t >= 256) return false; const int br = i % 3; u.pm = br * 64 + (t >> 2); u.pn = br * 4 + (t & 3); return true; }
};

template <int ACT  > struct EpiStore {
    bf16_t* O; int ldc;
    __device__ __forceinline__ void operator()(const f32x4 (&acc)[2][2][4][2], const Unit& u, int wr, int wc, int fr, int fq) const {
        const int row0 = u.pm * BM + wr * 64 + fr, col0 = u.pn * BM + wc * 32 + 8 * fq;
#pragma unroll
        for (int ai = 0; ai < 2; ++ai)
#pragma unroll
            for (int m = 0; m < 4; ++m) { bf16_t* rowp = O + (size_t)(row0 + ai * HALF + m * 16) * ldc + col0;
#pragma unroll
                for (int bj = 0; bj < 2; ++bj) { f32x4 v0 = acc[ai][bj][m][0], v1 = acc[ai][bj][m][1];
                    if (ACT == 2) {
#pragma unroll
                        for (int e = 0; e < 4; ++e) { float a = fmaxf(v0[e], 0.f), b = fmaxf(v1[e], 0.f); v0[e] = a * a; v1[e] = b * b; } }
                    u32x4 w; w.x = cvt_pk_bf16(v0[0], v0[1]); w.y = cvt_pk_bf16(v0[2], v0[3]); w.z = cvt_pk_bf16(v1[0], v1[1]); w.w = cvt_pk_bf16(v1[2], v1[3]);
                    *(u32x4*)(rowp + bj * HALF) = w; } }
    }
};
struct EpiResid {
    const float* R; float* O; float alpha;
    __device__ __forceinline__ void operator()(const f32x4 (&acc)[2][2][4][2], const Unit& u, int wr, int wc, int fr, int fq) const {
        const int row0 = u.pm * BM + wr * 64 + fr, col0 = u.pn * BM + wc * 32 + 8 * fq;
#pragma unroll
        for (int ai = 0; ai < 2; ++ai)
#pragma unroll
            for (int m = 0; m < 4; ++m) { const size_t off = (size_t)(row0 + ai * HALF + m * 16) * 1024 + col0;
#pragma unroll
                for (int bj = 0; bj < 2; ++bj) { const f32x4 r0 = *(const f32x4*)(R + off + bj * HALF), r1 = *(const f32x4*)(R + off + bj * HALF + 4);
                    *(f32x4*)(O + off + bj * HALF) = r0 * alpha + acc[ai][bj][m][0]; *(f32x4*)(O + off + bj * HALF + 4) = r1 * alpha + acc[ai][bj][m][1]; } }
    }
};
struct EpiMerge {
    const bf16_t* proj; float* stash; bf16_t* merged;
    __device__ __forceinline__ void operator()(const f32x4 (&acc)[2][2][4][2], const Unit& u, int wr, int wc, int fr, int fq) const {
        const int br = u.pm >> 6, tm = u.pm & 63, tn = u.pn & 3;
        const int row0 = tm * BM + wr * 64 + fr, col0 = tn * BM + wc * 32 + 8 * fq;
#pragma unroll
        for (int ai = 0; ai < 2; ++ai)
#pragma unroll
            for (int m = 0; m < 4; ++m) { const int row = row0 + ai * HALF + m * 16;
#pragma unroll
                for (int bj = 0; bj < 2; ++bj) { const int col = col0 + bj * HALF;
                    const u32x4 gw = *(const u32x4*)(proj + (size_t)row * NP + C_GL + br * 1024 + col);
                    float g[8] = {bflo(gw.x), bfhi(gw.x), bflo(gw.y), bfhi(gw.y), bflo(gw.z), bfhi(gw.z), bflo(gw.w), bfhi(gw.w)};
                    f32x4 v0, v1;
#pragma unroll
                    for (int e = 0; e < 4; ++e) { v0[e] = acc[ai][bj][m][0][e] * __builtin_amdgcn_rcpf(1.f + __builtin_amdgcn_exp2f(-1.4426950408889634f * g[e])); v1[e] = acc[ai][bj][m][1][e] * __builtin_amdgcn_rcpf(1.f + __builtin_amdgcn_exp2f(-1.4426950408889634f * g[4 + e])); }
                    float* sp = stash + (size_t)row * (NP / 2) + col;
                    if (br == 0) { *(f32x4*)sp = v0; *(f32x4*)(sp + 4) = v1; }
                    else { v0 += *(const f32x4*)sp; v1 += *(const f32x4*)(sp + 4);
                        if (br == 1) { *(f32x4*)sp = v0; *(f32x4*)(sp + 4) = v1; }
                        else { u32x4 w; w.x = cvt_pk_bf16(v0[0], v0[1]); w.y = cvt_pk_bf16(v0[2], v0[3]); w.z = cvt_pk_bf16(v1[0], v1[1]); w.w = cvt_pk_bf16(v1[2], v1[3]);
                            *(u32x4*)(merged + (size_t)row * 1024 + col) = w; } } } }
    }
};

template <class Epi, class Sched>
__device__ __forceinline__ void gemm_phase(LAS unsigned char* lds, const Gemm g, const Sched& S, const Epi& E) {
    const int tid = otid(), wid = __builtin_amdgcn_readfirstlane(tid >> 6), lane = tid & 63, wr = wid >> 2, wc = wid & 3, fr = lane & 15, fq = lane >> 4;
    const int K = g.K, nt = K / BK, lda = g.lda;
    unsigned voffA[2], voffB[2];
#pragma unroll
    for (int i = 0; i < 2; ++i) { int R, C; stage_rc(tid * 16 + i * 8192, R, C); const int Rb = (R & ~31) + perm32(R & 31);
        voffA[i] = (unsigned)(R * lda + C) * 2u; voffB[i] = (unsigned)(Rb * K + C) * 2u; }
    const size_t kstep = (size_t)(BK * 2);
    const size_t hstepA = (size_t)HALF * lda * 2, hstepB = (size_t)HALF * K * 2;
    const size_t tstepA = 2 * hstepA, tstepB = 2 * hstepB;
    const unsigned ldsw = (unsigned)wid * 1024u;
    const int aoff = lds_byte(wr * 64 + fr, fq * 8), boff = lds_byte(wc * 32 + fr, fq * 8);
#define PG8_SA(b, h) (((b) * 2 + (h)) * HTB)
#define PG8_SB(b, h) ((4 + (b) * 2 + (h)) * HTB)
#define PG8_STAGE(bufoff, gbase, voff) do { _Pragma("unroll") for (int _i = 0; _i < 2; ++_i) \
        __builtin_amdgcn_global_load_lds((const unsigned*)((const char*)(gbase) + (voff)[_i]), (LAS unsigned*)(lds + (bufoff) + ldsw + _i * 8192), 16, 0, 0); } while (0)
#define PG8_LDA(dst, b, h) do { _Pragma("unroll") for (int m = 0; m < 4; ++m) _Pragma("unroll") for (int k = 0; k < 2; ++k) dst[m][k] = *(const LAS bf16x8*)(lds + PG8_SA(b, h) + aoff + m * 2048 + k * 1024); } while (0)
#define PG8_LDB(dst, b, h) do { _Pragma("unroll") for (int n = 0; n < 2; ++n) _Pragma("unroll") for (int k = 0; k < 2; ++k) dst[n][k] = *(const LAS bf16x8*)(lds + PG8_SB(b, h) + boff + n * 2048 + k * 1024); } while (0)
#define PG8_MMA(ai, bj, At, Bt) do { __builtin_amdgcn_s_setprio(1); _Pragma("unroll") for (int m = 0; m < 4; ++m) _Pragma("unroll") for (int n = 0; n < 2; ++n) _Pragma("unroll") for (int k = 0; k < 2; ++k) \
        acc[ai][bj][m][n] = __builtin_amdgcn_mfma_f32_16x16x32_bf16(Bt[n][k], At[m][k], acc[ai][bj][m][n], 0, 0, 0); __builtin_amdgcn_s_setprio(0); } while (0)
#define PG8_WAIT_V(n) asm volatile("s_waitcnt vmcnt(" #n ")" ::: "memory")
#define PG8_WAIT_L(n) asm volatile("s_waitcnt lgkmcnt(" #n ")" ::: "memory")
#define PG8_BAR __builtin_amdgcn_s_barrier()
#define PG8_SCHED __builtin_amdgcn_sched_barrier(0)
    Unit cur, nxt; int ui = 0;
    if (!S.next(0, cur)) return;
    f32x4 acc[2][2][4][2];
#pragma unroll
    for (int a = 0; a < 2; ++a)
#pragma unroll
        for (int b = 0; b < 2; ++b)
#pragma unroll
            for (int m = 0; m < 4; ++m)
#pragma unroll
                for (int n = 0; n < 2; ++n) acc[a][b][m][n] = (f32x4){0.f, 0.f, 0.f, 0.f};
    bf16x8 At[4][2], B0[2][2], B1[2][2];
    const char* cA = (const char*)g.A + (size_t)cur.pm * tstepA; const char* cB = (const char*)g.Bt + (size_t)cur.pn * tstepB;
    PG8_STAGE(PG8_SB(0, 0), cB, voffB); PG8_STAGE(PG8_SB(0, 1), cB + hstepB, voffB); PG8_STAGE(PG8_SA(0, 0), cA, voffA); PG8_STAGE(PG8_SA(0, 1), cA + hstepA, voffA);
    if (wr == 1) PG8_BAR;
    PG8_WAIT_V(2); PG8_BAR;
    PG8_STAGE(PG8_SB(1, 0), cB + kstep, voffB); PG8_STAGE(PG8_SA(1, 0), cA + kstep, voffA); PG8_STAGE(PG8_SB(1, 1), cB + hstepB + kstep, voffB);
    PG8_WAIT_V(6); PG8_BAR;
    for (;;) {
        const bool has_next = S.next(ui + 1, nxt);
        const char* nA = has_next ? (const char*)g.A + (size_t)nxt.pm * tstepA : cA; const char* nB = has_next ? (const char*)g.Bt + (size_t)nxt.pn * tstepB : cB;
        for (int t = 0; t < nt; t += 2) {
            const bool last = (t == nt - 2);
            const char* a1 = cA + (size_t)(t + 1) * kstep;
            const char* a2 = last ? nA : cA + (size_t)(t + 2) * kstep; const char* b2 = last ? nB : cB + (size_t)(t + 2) * kstep;
            const char* a3 = a2 + kstep; const char* b3 = b2 + kstep;
            PG8_LDB(B0, 0, 0); PG8_LDB(B1, 0, 1); PG8_SCHED; PG8_LDA(At, 0, 0); PG8_STAGE(PG8_SA(1, 1), a1 + hstepA, voffA);
            PG8_WAIT_V(8); PG8_WAIT_L(0); PG8_BAR; PG8_MMA(0, 0, At, B0); PG8_MMA(0, 1, At, B1); PG8_BAR; PG8_SCHED;
            PG8_LDA(At, 0, 1); PG8_STAGE(PG8_SB(0, 0), b2, voffB); PG8_STAGE(PG8_SB(0, 1), b2 + hstepB, voffB); PG8_STAGE(PG8_SA(0, 0), a2, voffA);
            PG8_WAIT_V(8); PG8_WAIT_L(0); PG8_BAR; PG8_MMA(1, 0, At, B0); PG8_MMA(1, 1, At, B1); PG8_BAR; PG8_SCHED;
            PG8_LDB(B0, 1, 0); PG8_LDB(B1, 1, 1); PG8_SCHED; PG8_LDA(At, 1, 0); PG8_STAGE(PG8_SA(0, 1), a2 + hstepA, voffA);
            PG8_WAIT_V(8); PG8_WAIT_L(0); PG8_BAR; PG8_MMA(0, 0, At, B0); PG8_MMA(0, 1, At, B1); PG8_BAR; PG8_SCHED;
            PG8_LDA(At, 1, 1); PG8_STAGE(PG8_SB(1, 0), b3, voffB); PG8_STAGE(PG8_SB(1, 1), b3 + hstepB, voffB); PG8_STAGE(PG8_SA(1, 0), a3, voffA);
            PG8_WAIT_V(8); PG8_WAIT_L(0); PG8_BAR; PG8_MMA(1, 0, At, B0); PG8_MMA(1, 1, At, B1); PG8_BAR; PG8_SCHED;
        }
        if (wr == 0) PG8_BAR;
        E(acc, cur, wr, wc, fr, fq);
        if (!has_next) break;
#pragma unroll
        for (int a = 0; a < 2; ++a)
#pragma unroll
            for (int b = 0; b < 2; ++b)
#pragma unroll
                for (int m = 0; m < 4; ++m)
#pragma unroll
                    for (int n = 0; n < 2; ++n) acc[a][b][m][n] = (f32x4){0.f, 0.f, 0.f, 0.f};
        cur = nxt; cA = nA; cB = nB; ++ui;
        if (wr == 1) PG8_BAR;
    }
    PG8_WAIT_V(0);
    PG8_BAR;
#undef PG8_SA
#undef PG8_SB
#undef PG8_STAGE
#undef PG8_LDA
#undef PG8_LDB
#undef PG8_MMA
#undef PG8_WAIT_V
#undef PG8_WAIT_L
#undef PG8_BAR
#undef PG8_SCHED
}
}


#define XB_TMO      128
#define XB_XCNT(j)  (256  + 64 * (j))
#define XB_XSUB(j)  (1280 + 64 * (j))
#define XB_XGEN(j)  (2304 + 64 * (j))
#define XB_TOP      3328
#define XB_TOPGEN   3392
#define XCD_BAR_WORDS 3456
#define XB_SPIN_CAP (1u << 18)
__device__ __forceinline__ unsigned xb_ld(unsigned* p)              { return __hip_atomic_load(p, __ATOMIC_RELAXED, __HIP_MEMORY_SCOPE_AGENT); }
__device__ __forceinline__ unsigned xb_add(unsigned* p, unsigned v) { return __hip_atomic_fetch_add(p, v, __ATOMIC_RELAXED, __HIP_MEMORY_SCOPE_AGENT); }
__device__ __forceinline__ unsigned xb_xcc_id() { return (unsigned)__builtin_amdgcn_s_getreg((3 << 11) | 20) & 0xFu; }
#define XB_SPIN(cond, bar) do { unsigned _sp = 0; while (cond) { __builtin_amdgcn_s_sleep(1); \
    if ((++_sp & 255u) == 0u) { if (xb_ld(&(bar)[XB_TMO])) break; if (_sp > XB_SPIN_CAP) { atomicAdd(&(bar)[XB_TMO], 1u); break; } } } } while (0)
struct XcdBarrier { unsigned* bar; unsigned x; volatile LAS unsigned* st; };
__device__ __forceinline__ XcdBarrier xcd_barrier_post(unsigned* bar, volatile LAS unsigned* st) {
    XcdBarrier b; b.bar = bar; b.x = xb_xcc_id(); b.st = st;
    if (threadIdx.x == 0) (void)xb_add(&bar[XB_XCNT(b.x)], 1u);
    return b;
}
__device__ __forceinline__ void xcd_barrier_complete(unsigned* bar, unsigned x, unsigned& nloc, unsigned& nx) {
    const unsigned G = gridDim.x * gridDim.y * gridDim.z;
    unsigned sum, cnt, mine, sp = 0u;
    for (;;) {
        sum = 0u; cnt = 0u; mine = 0u;
#pragma unroll
        for (unsigned j = 0; j < 16; ++j) { const unsigned c = xb_ld(&bar[XB_XCNT(j)]); sum += c; cnt += (c > 0u) ? 1u : 0u; mine = (j == x) ? c : mine; }
        if (sum == G) break;
        __builtin_amdgcn_s_sleep(1);
        if ((++sp & 255u) == 0u) { if (xb_ld(&bar[XB_TMO])) break; if (sp > XB_SPIN_CAP) { atomicAdd(&bar[XB_TMO], 1u); break; } }
    }
    nloc = mine > 0u ? mine : 1u; nx = cnt > 0u ? cnt : 1u;
}
__device__ __forceinline__ void xcd_barrier(const XcdBarrier& b) {
    asm volatile("s_waitcnt vmcnt(0)" ::: "memory");
    __syncthreads();
    if (threadIdx.x == 0) {
        unsigned* bar = b.bar;
        __builtin_amdgcn_s_waitcnt(0);
        unsigned nloc = b.st[0], nx = b.st[1];
        if (nloc == 0u) { xcd_barrier_complete(bar, b.x, nloc, nx); b.st[0] = nloc; b.st[1] = nx; }
        const unsigned old = xb_add(&bar[XB_XSUB(b.x)], 1u);
        const unsigned gen = old / nloc;
        if (old + 1u == (gen + 1u) * nloc) {
            __builtin_amdgcn_fence(__ATOMIC_RELEASE, "agent");
            asm volatile("s_waitcnt vmcnt(0)" ::: "memory");
            const unsigned og = xb_add(&bar[XB_TOP], 1u);
            const unsigned tg = og / nx;
            if (og + 1u == (tg + 1u) * nx) xb_add(&bar[XB_TOPGEN], 1u);
            else XB_SPIN(xb_ld(&bar[XB_TOPGEN]) == tg, bar);
            __builtin_amdgcn_fence(__ATOMIC_ACQUIRE, "agent");
            xb_add(&bar[XB_XGEN(b.x)], 1u);
            asm volatile("s_waitcnt vmcnt(0)" ::: "memory");
        } else {
            XB_SPIN(xb_ld(&bar[XB_XGEN(b.x)]) == gen, bar);
            __builtin_amdgcn_fence(__ATOMIC_ACQUIRE, "agent");
            asm volatile("s_waitcnt vmcnt(0)" ::: "memory");
        }
    }
    __syncthreads();
}

struct Args {
    const float* x; const int* pos; const float* w_in; const float* w_gate_up; const float* b_gate; const float* gla_norm_w; const float* gmlp_ln_g; const float* gmlp_ln_b;
    const float* gmlp_w_s; const float* gmlp_b_s; const float* w_branch; const float* w_out; const float* ln1_g; const float* ln1_b; const float* w_ff1; const float* w_ff2;
    const float* ln2_g; const float* ln2_b; float* out; unsigned char* ws; int ph_lo, ph_hi;
};

__device__ __forceinline__ float wave_sum(float v) {
#pragma unroll
    for (int o = 1; o < 64; o <<= 1) v += __shfl_xor(v, o);
    return v;
}

__device__ __forceinline__ void transpose_item(const float* W, int ldw, int col0, int K, int nblk, bf16_t* WT, int row_off, LAS float* scr, int item, int lane) {
    const int kb = item / nblk, nb = item % nblk, k0 = 64 * kb, n0 = 32 * nb;
#pragma unroll 8
    for (int i = 0; i < 32; ++i) { const int kk = 2 * i + (lane >> 5); scr[kk * 33 + (lane & 31)] = W[(size_t)(k0 + kk) * ldw + col0 + n0 + (lane & 31)]; }
    asm volatile("s_waitcnt lgkmcnt(0)" ::: "memory");
    const int c = lane & 7;
#pragma unroll
    for (int j = 0; j < 4; ++j) { const int n = (lane >> 3) + 8 * j; const LAS float* s = scr + (8 * c) * 33 + n;
        u32x4 o; o.x = cvt_pk_bf16(s[0 * 33], s[1 * 33]); o.y = cvt_pk_bf16(s[2 * 33], s[3 * 33]); o.z = cvt_pk_bf16(s[4 * 33], s[5 * 33]); o.w = cvt_pk_bf16(s[6 * 33], s[7 * 33]);
        *(u32x4*)(WT + (size_t)(row_off + n0 + n) * K + k0 + 8 * c) = o; }
    asm volatile("s_waitcnt lgkmcnt(0)" ::: "memory");
}

__device__ __forceinline__ void phase_prep(const Args& a, int l, LAS unsigned char* lds, int G) {
    const int tid = otid(), lane = tid & 63, wave = tid >> 6;
    LAS float* scr = (LAS float*)(lds + wave * 16384);
    const int gw = blockIdx.x * NWAVES + wave, NGW = G * NWAVES;
    bf16_t* WinT = (bf16_t*)(a.ws + WS_WIN); bf16_t* WbrT = (bf16_t*)(a.ws + WS_WBR); bf16_t* WoutT = (bf16_t*)(a.ws + WS_WOUT); bf16_t* W1T = (bf16_t*)(a.ws + WS_W1); bf16_t* W2T = (bf16_t*)(a.ws + WS_W2);
    const float* win = a.w_in + (size_t)l * D * IN_COLS;
    constexpr int I_IN_A = 16 * 64, I_IN_B = 16 * 176, I_BR = 8 * 32, I_OUT = 16 * 32, I_1 = 16 * 128, I_2 = 64 * 32;
    constexpr int NITEMS = I_IN_A + I_IN_B + 3 * I_BR + I_OUT + I_1 + I_2;
    for (int it = gw; it < NITEMS; it += NGW) {
        int r = it;
        if (r < I_IN_A) { transpose_item(win, IN_COLS, 0, D, 64, WinT, 0, scr, r, lane); continue; } r -= I_IN_A;
        if (r < I_IN_B) { transpose_item(win, IN_COLS, 2064, D, 176, WinT, 2048, scr, r, lane); continue; } r -= I_IN_B;
        if (r < 3 * I_BR) { const int br = r / I_BR; transpose_item(a.w_branch + ((size_t)l * 3 + br) * 512 * 1024, 1024, 0, 512, 32, WbrT, br * 1024, scr, r % I_BR, lane); continue; } r -= 3 * I_BR;
        if (r < I_OUT) { transpose_item(a.w_out + (size_t)l * D * D, D, 0, D, 32, WoutT, 0, scr, r, lane); continue; } r -= I_OUT;
        if (r < I_1) { transpose_item(a.w_ff1 + (size_t)l * D * FF, FF, 0, D, 128, W1T, 0, scr, r, lane); continue; } r -= I_1;
        transpose_item(a.w_ff2 + (size_t)l * FF * D, D, 0, FF, 32, W2T, 0, scr, r, lane);
    }
    { bf16_t* glrT = (bf16_t*)(a.ws + WS_GLR);
      const int e = blockIdx.x * NTHREADS + tid;
      if (e < 16 * 1024) { const int n = e >> 10, k = e & 1023; glrT[e] = (bf16_t)(cvt_pk_bf16(win[(size_t)k * IN_COLS + 2048 + n], 0.f) & 0xffffu); } }
    if (l == 0) {
        bf16_t* xbf = (bf16_t*)(a.ws + WS_XBF);
        for (size_t e = (size_t)(blockIdx.x * NTHREADS + tid) * 8; e < (size_t)M * D; e += (size_t)G * NTHREADS * 8) {
            const f32x4 v0 = *(const f32x4*)(a.x + e), v1 = *(const f32x4*)(a.x + e + 4);
            u32x4 w; w.x = cvt_pk_bf16(v0[0], v0[1]); w.y = cvt_pk_bf16(v0[2], v0[3]); w.z = cvt_pk_bf16(v1[0], v1[1]); w.w = cvt_pk_bf16(v1[2], v1[3]);
            *(u32x4*)(xbf + e) = w; }
    }
}

__device__ __forceinline__ void gla_bcum(const Args& a, int l, LAS unsigned char* lds, int m0, int h, float (&c)[16], float& bend) {
    const int tid = otid(), lane = tid & 63, wave = tid >> 6, fr = lane & 15, fq = lane >> 4;
    LAS float* lr = (LAS float*)lds; LAS float* tot = (LAS float*)(lds + 4352);
    const bf16_t* xbf = (const bf16_t*)(a.ws + WS_XBF); const bf16_t* glrT = (const bf16_t*)(a.ws + WS_GLR);
    if (tid < 128) {
        const int s = tid >> 1, hf = tid & 1;
        const u32x4 w = *(const u32x4*)((const bf16_t*)(a.ws + WS_PROJ) + (size_t)(m0 + s) * NP + C_LR + hf * 8);
        LAS float* lp = lr + s * 17 + hf * 8;
        lp[0] = bflo(w.x); lp[1] = bfhi(w.x); lp[2] = bflo(w.y); lp[3] = bfhi(w.y); lp[4] = bflo(w.z); lp[5] = bfhi(w.z); lp[6] = bflo(w.w); lp[7] = bfhi(w.w);
    }
    __syncthreads();
    const int d = tid & 127, g = tid >> 7, col = h * 128 + d;
    float wu[16];
#pragma unroll
    for (int r = 0; r < 16; ++r) wu[r] = a.w_gate_up[((size_t)l * 16 + r) * 512 + col];
    const float bg = a.b_gate[(size_t)l * 512 + col];
    float run = 0.f;
#pragma unroll
    for (int i = 0; i < 16; ++i) { const int s = g * 16 + i; float z = bg;
#pragma unroll
        for (int r = 0; r < 16; ++r) z += lr[s * 17 + r] * wu[r];
        const float la = (fminf(z, 0.f) - __logf(1.f + __expf(-fabsf(z)))) * (1.f / 16.f);
        run += la; c[i] = run; }
    tot[g * 128 + d] = run;
    __syncthreads();
    float pre = 0.f, all = 0.f;
#pragma unroll
    for (int gg = 0; gg < 4; ++gg) { const float t = tot[gg * 128 + d]; all += t; if (gg < g) pre += t; }
#pragma unroll
    for (int i = 0; i < 16; ++i) c[i] += pre;
    bend = all;
}

__device__ __forceinline__ void gla_kv_unit(const Args& a, int l, LAS unsigned char* lds, int unit) {
    const int h = unit & 3, n = (unit >> 2) & 127, b = unit >> 9, m0 = b * SEQ + n * 64;
    const int tid = otid(), lane = tid & 63, wave = tid >> 6, fr = lane & 15, fq = lane >> 4;
    const bf16_t* proj = (const bf16_t*)(a.ws + WS_PROJ);
    const int d = tid & 127, g = tid >> 7, col = h * 128 + d;
    unsigned kraw[8], vw[8];
#pragma unroll
    for (int i = 0; i < 16; i += 2) { const size_t r0 = (size_t)(m0 + g * 16 + i) * NP, r1 = r0 + NP;
        kraw[i >> 1] = (unsigned)proj[r0 + C_GK + col] | ((unsigned)proj[r1 + C_GK + col] << 16); vw[i >> 1] = (unsigned)proj[r0 + C_GV + col] | ((unsigned)proj[r1 + C_GV + col] << 16); }
    float c[16], bend; gla_bcum(a, l, lds, m0, h, c, bend);
    LAS unsigned char* keT = lds + 8192; LAS unsigned char* vT = lds + 8192 + 128 * 144;
    unsigned kw[8];
#pragma unroll
    for (int i = 0; i < 16; i += 2) { const float k0 = bflo(kraw[i >> 1]) * __expf(bend - c[i]), k1 = bfhi(kraw[i >> 1]) * __expf(bend - c[i + 1]); kw[i >> 1] = cvt_pk_bf16(k0, k1); }
    *(LAS u32x4*)(keT + d * 144 + g * 32) = (u32x4){kw[0], kw[1], kw[2], kw[3]}; *(LAS u32x4*)(keT + d * 144 + g * 32 + 16) = (u32x4){kw[4], kw[5], kw[6], kw[7]};
    *(LAS u32x4*)(vT + d * 144 + g * 32) = (u32x4){vw[0], vw[1], vw[2], vw[3]}; *(LAS u32x4*)(vT + d * 144 + g * 32 + 16) = (u32x4){vw[4], vw[5], vw[6], vw[7]};
    const int bh = b * 4 + h;
    if (g == 0) ((float*)(a.ws + WS_DEC))[((size_t)bh * 128 + n) * 128 + d] = __expf(bend);
    __syncthreads();
    bf16_t* ST = (bf16_t*)(a.ws + WS_ST) + ((size_t)bh * 128 + n) * 16384;
    bf16x8 af[2];
#pragma unroll
    for (int kk = 0; kk < 2; ++kk) af[kk] = *(const LAS bf16x8*)(keT + (wave * 16 + fr) * 144 + kk * 64 + fq * 16);
#pragma unroll
    for (int dvt = 0; dvt < 8; ++dvt) { f32x4 acc = {0.f, 0.f, 0.f, 0.f};
#pragma unroll
        for (int kk = 0; kk < 2; ++kk) { const bf16x8 bv = *(const LAS bf16x8*)(vT + (dvt * 16 + fr) * 144 + kk * 64 + fq * 16); acc = mfma16(af[kk], bv, acc); }
        u32x2 w; w.x = cvt_pk_bf16(acc[0], acc[1]); w.y = cvt_pk_bf16(acc[2], acc[3]);
        *(u32x2*)(ST + (size_t)(dvt * 16 + fr) * 128 + wave * 16 + 4 * fq) = w; }
    __syncthreads();
}

__device__ __forceinline__ void gla_scan(const Args& a, int G) {
    const int tid = otid();
    for (int e = blockIdx.x * NTHREADS + tid; e < 8 * 128 * 64; e += G * NTHREADS) {
        const int dkp = e & 63, dv = (e >> 6) & 127, bh = e >> 13;
        unsigned* st = (unsigned*)(a.ws + WS_ST) + ((size_t)bh * 128 * 16384 + (size_t)dv * 128) / 2 + dkp;
        const f32x2* dec = (const f32x2*)(a.ws + WS_DEC) + ((size_t)bh * 128 * 128) / 2 + dkp;
        float s0 = 0.f, s1 = 0.f;
#pragma unroll 8
        for (int n = 0; n < 128; ++n) { const unsigned kv = st[(size_t)n * 8192]; const f32x2 dc = dec[n * 64];
            st[(size_t)n * 8192] = cvt_pk_bf16(s0, s1);
            s0 = dc.x * s0 + bflo(kv); s1 = dc.y * s1 + bfhi(kv); }
    }
}

__device__ __forceinline__ void gla_out_unit(const Args& a, int l, LAS unsigned char* lds, int unit) {
    const int h = unit & 3, n = (unit >> 2) & 127, b = unit >> 9, m0 = b * SEQ + n * 64;
    const int tid = otid(), lane = tid & 63, wave = tid >> 6, fr = lane & 15, fq = lane >> 4;
    const bf16_t* proj = (const bf16_t*)(a.ws + WS_PROJ);
    const int d = tid & 127, g = tid >> 7, col = h * 128 + d;
    unsigned qraw[8], kraw[8], vw[8];
#pragma unroll
    for (int i = 0; i < 16; i += 2) { const size_t r0 = (size_t)(m0 + g * 16 + i) * NP, r1 = r0 + NP;
        qraw[i >> 1] = (unsigned)proj[r0 + C_GQ + col] | ((unsigned)proj[r1 + C_GQ + col] << 16); kraw[i >> 1] = (unsigned)proj[r0 + C_GK + col] | ((unsigned)proj[r1 + C_GK + col] << 16);
        vw[i >> 1] = (unsigned)proj[r0 + C_GV + col] | ((unsigned)proj[r1 + C_GV + col] << 16); }
    float c[16], bend; gla_bcum(a, l, lds, m0, h, c, bend);
    LAS unsigned char* qd = lds + 8192;
    LAS unsigned char* ki = qd + 64 * 272;
    LAS unsigned char* vT = ki + 64 * 272;
    LAS unsigned char* at = vT + 128 * 144;
    LAS float* ssq = (LAS float*)(at + 64 * 144);
#pragma unroll
    for (int i = 0; i < 16; i += 2) {
        const float e0 = __expf(c[i]), e1 = __expf(c[i + 1]);
        const float q0 = bflo(qraw[i >> 1]) * e0, q1 = bfhi(qraw[i >> 1]) * e1;
        const float k0 = bflo(kraw[i >> 1]) * 0.08838834764831845f / e0, k1 = bfhi(kraw[i >> 1]) * 0.08838834764831845f / e1;
        *(LAS bf16_t*)(qd + (g * 16 + i) * 272 + d * 2) = (bf16_t)(cvt_pk_bf16(q0, 0.f) & 0xffffu); *(LAS bf16_t*)(qd + (g * 16 + i + 1) * 272 + d * 2) = (bf16_t)(cvt_pk_bf16(q1, 0.f) & 0xffffu);
        *(LAS bf16_t*)(ki + (g * 16 + i) * 272 + d * 2) = (bf16_t)(cvt_pk_bf16(k0, 0.f) & 0xffffu); *(LAS bf16_t*)(ki + (g * 16 + i + 1) * 272 + d * 2) = (bf16_t)(cvt_pk_bf16(k1, 0.f) & 0xffffu); }
    *(LAS u32x4*)(vT + d * 144 + g * 32) = (u32x4){vw[0], vw[1], vw[2], vw[3]}; *(LAS u32x4*)(vT + d * 144 + g * 32 + 16) = (u32x4){vw[4], vw[5], vw[6], vw[7]};
    __syncthreads();
    { const int tt = wave >> 1;
      bf16x8 qf[4];
#pragma unroll
      for (int kk = 0; kk < 4; ++kk) qf[kk] = *(const LAS bf16x8*)(qd + (tt * 16 + fr) * 272 + kk * 64 + fq * 16);
#pragma unroll
      for (int s2 = 0; s2 < 2; ++s2) { const int stl = (wave & 1) * 2 + s2; f32x4 acc = {0.f, 0.f, 0.f, 0.f};
#pragma unroll
          for (int kk = 0; kk < 4; ++kk) { const bf16x8 kf = *(const LAS bf16x8*)(ki + (stl * 16 + fr) * 272 + kk * 64 + fq * 16); acc = mfma16(kf, qf[kk], acc); }
          const int t = tt * 16 + fr, s0 = stl * 16 + 4 * fq;
#pragma unroll
          for (int jj = 0; jj < 4; ++jj) if (s0 + jj > t) acc[jj] = 0.f;
          u32x2 w; w.x = cvt_pk_bf16(acc[0], acc[1]); w.y = cvt_pk_bf16(acc[2], acc[3]);
          *(LAS u32x2*)(at + t * 144 + s0 * 2) = w; } }
    __syncthreads();
    const int tt = wave & 3, dvh = wave >> 2, bh = b * 4 + h;
    const bf16_t* ST = (const bf16_t*)(a.ws + WS_ST) + ((size_t)bh * 128 + n) * 16384;
    bf16x8 atf[2], qf[4];
#pragma unroll
    for (int kk = 0; kk < 2; ++kk) atf[kk] = *(const LAS bf16x8*)(at + (tt * 16 + fr) * 144 + kk * 64 + fq * 16);
#pragma unroll
    for (int kk = 0; kk < 4; ++kk) qf[kk] = *(const LAS bf16x8*)(qd + (tt * 16 + fr) * 272 + kk * 64 + fq * 16);
    f32x4 o[4]; float sq = 0.f;
#pragma unroll
    for (int j = 0; j < 4; ++j) { const int dvt = dvh * 4 + j; f32x4 acc = {0.f, 0.f, 0.f, 0.f};
#pragma unroll
        for (int kk = 0; kk < 2; ++kk) { const bf16x8 vf = *(const LAS bf16x8*)(vT + (dvt * 16 + fr) * 144 + kk * 64 + fq * 16); acc = mfma16(vf, atf[kk], acc); }
        f32x4 acs = {0.f, 0.f, 0.f, 0.f};
#pragma unroll
        for (int kk = 0; kk < 4; ++kk) { const bf16x8 sf = *(const bf16x8*)(ST + (size_t)(dvt * 16 + fr) * 128 + kk * 32 + fq * 8); acs = mfma16(sf, qf[kk], acs); }
        acc += acs * 0.08838834764831845f;
        o[j] = acc; sq += acc[0] * acc[0] + acc[1] * acc[1] + acc[2] * acc[2] + acc[3] * acc[3]; }
    sq += __shfl_xor(sq, 16); sq += __shfl_xor(sq, 32);
    if (fq == 0) ssq[dvh * 64 + tt * 16 + fr] = sq;
    __syncthreads();
    const float rs = 1.f / sqrtf((ssq[tt * 16 + fr] + ssq[64 + tt * 16 + fr]) * (1.f / 128.f) + RMS_EPS);
    const int m = m0 + tt * 16 + fr;
    bf16_t* br0 = (bf16_t*)(a.ws + WS_BR);
#pragma unroll
    for (int j = 0; j < 4; ++j) { const int dv = (dvh * 4 + j) * 16 + 4 * fq;
        const f32x4 nw = *(const f32x4*)(a.gla_norm_w + (size_t)l * 128 + dv);
        const u32x2 gw = *(const u32x2*)(proj + (size_t)m * NP + C_GG + h * 128 + dv);
        const float gg[4] = {bflo(gw.x), bfhi(gw.x), bflo(gw.y), bfhi(gw.y)}; float r[4];
#pragma unroll
        for (int e = 0; e < 4; ++e) r[e] = o[j][e] * rs * nw[e] * (gg[e] / (1.f + __expf(-gg[e])));
        u32x2 w; w.x = cvt_pk_bf16(r[0], r[1]); w.y = cvt_pk_bf16(r[2], r[3]);
        *(u32x2*)(br0 + (size_t)m * 512 + h * 128 + dv) = w; }
    __syncthreads();
}

__device__ __forceinline__ float gelu_erf(float v) {
    const float av = fabsf(v), t = __builtin_amdgcn_rcpf(av * 0.2316418882f + 1.0f);
    float q = t * 0.5307027145f + (-0.7265760135f); q = q * t + 0.7107068705f; q = q * t + (-0.142248368f); q = q * t + 0.127414796f; q = q * t;
    const float e = __builtin_amdgcn_exp2f((v * v) * (-0.72134752044f));
    const float m = v * (q * e);
    return v < 0.f ? m : v - m;
}
__device__ __forceinline__ void gmlp_unit(const Args& a, int l, LAS unsigned char* lds, int unit) {
    const int g = unit & 3, nc = (unit >> 2) & 63, b = unit >> 8, m0 = b * SEQ + nc * 128;
    const int tid = otid(), lane = tid & 63, wave = tid >> 6, fr = lane & 15, fq = lane >> 4;
    const bf16_t* proj = (const bf16_t*)(a.ws + WS_PROJ);
    LAS float* lgb = (LAS float*)lds;
    LAS unsigned char* vnT = lds + 1024;
    LAS unsigned char* wm = vnT + 128 * 272;
    if (tid < 256) lgb[tid] = (tid < 128 ? a.gmlp_ln_g : a.gmlp_ln_b)[(size_t)l * 512 + g * 128 + (tid & 127)];
    const int tok = tid >> 2, part = tid & 3;
    const int sq4 = part * 32; const float* wp = a.gmlp_w_s + (((size_t)l * 4 + g) * 128 + tok) * 128 + sq4;
    f32x4 wv[8];
#pragma unroll
    for (int j = 0; j < 8; ++j) wv[j] = *(const f32x4*)(wp + j * 4);
    const bf16_t* vp = proj + (size_t)(m0 + tok) * NP + C_GZV + part * 128;
    unsigned pk[64]; float s = 0.f, s2 = 0.f;
#pragma unroll
    for (int j = 0; j < 16; ++j) { const u32x4 w = *(const u32x4*)(vp + j * 8); const unsigned ww[4] = {w.x, w.y, w.z, w.w};
#pragma unroll
        for (int e2 = 0; e2 < 4; ++e2) { const float g0 = gelu_erf(bflo(ww[e2])), g1 = gelu_erf(bfhi(ww[e2])); s += g0 + g1; s2 += g0 * g0 + g1 * g1; pk[j * 4 + e2] = cvt_pk_bf16(g0, g1); } }
    s += __shfl_xor(s, 1); s += __shfl_xor(s, 2); s2 += __shfl_xor(s2, 1); s2 += __shfl_xor(s2, 2);
    const float mean = s * (1.f / 512.f), rstd = 1.f / sqrtf(fmaxf(s2 * (1.f / 512.f) - mean * mean, 0.f) + LN_EPS);
#pragma unroll
    for (int j = 0; j < 4; ++j) { float v[8] = {wv[2 * j][0], wv[2 * j][1], wv[2 * j][2], wv[2 * j][3], wv[2 * j + 1][0], wv[2 * j + 1][1], wv[2 * j + 1][2], wv[2 * j + 1][3]};
#pragma unroll
        for (int e2 = 0; e2 < 8; ++e2) if (sq4 + j * 8 + e2 > tok) v[e2] = 0.f;
        *(LAS u32x4*)(wm + tok * 272 + (sq4 + j * 8) * 2) = (u32x4){cvt_pk_bf16(v[0], v[1]), cvt_pk_bf16(v[2], v[3]), cvt_pk_bf16(v[4], v[5]), cvt_pk_bf16(v[6], v[7])}; }
    __syncthreads();
    if (part == g) {
#pragma unroll
        for (int q = 0; q < 64; ++q) { const int c0 = 2 * q;
            const float v0 = (bflo(pk[q]) - mean) * rstd * lgb[c0] + lgb[128 + c0], v1 = (bfhi(pk[q]) - mean) * rstd * lgb[c0 + 1] + lgb[128 + c0 + 1];
            const unsigned w = cvt_pk_bf16(v0, v1);
            *(LAS bf16_t*)(vnT + c0 * 272 + tok * 2) = (bf16_t)(w & 0xffffu); *(LAS bf16_t*)(vnT + (c0 + 1) * 272 + tok * 2) = (bf16_t)(w >> 16); }
    }
    __syncthreads();
    const int nk = ((wave * 16 + 15) >> 5) + 1;
    bf16x8 wf[4];
#pragma unroll
    for (int kk = 0; kk < 4; ++kk) wf[kk] = *(const LAS bf16x8*)(wm + (wave * 16 + fr) * 272 + kk * 64 + fq * 16);
    const int t = wave * 16 + fr, m = m0 + t;
    const float bs = a.gmlp_b_s[((size_t)l * 4 + g) * 128 + t];
    bf16_t* br1 = (bf16_t*)(a.ws + WS_BR) + (size_t)M * 512;
    u32x2 uw[8];
#pragma unroll
    for (int ct = 0; ct < 8; ++ct) uw[ct] = *(const u32x2*)(proj + (size_t)m * NP + C_GZU + g * 128 + ct * 16 + 4 * fq);
#pragma unroll
    for (int ct = 0; ct < 8; ++ct) { f32x4 acc = {0.f, 0.f, 0.f, 0.f};
#pragma unroll
        for (int kk = 0; kk < 4; ++kk) if (kk < nk) { const bf16x8 vf = *(const LAS bf16x8*)(vnT + (ct * 16 + fr) * 272 + kk * 64 + fq * 16); acc = mfma16(vf, wf[kk], acc); }
        const int cc = g * 128 + ct * 16 + 4 * fq;
        const float u0 = gelu_erf(bflo(uw[ct].x)), u1 = gelu_erf(bfhi(uw[ct].x)), u2 = gelu_erf(bflo(uw[ct].y)), u3 = gelu_erf(bfhi(uw[ct].y));
        u32x2 w; w.x = cvt_pk_bf16(u0 * (acc[0] + bs), u1 * (acc[1] + bs)); w.y = cvt_pk_bf16(u2 * (acc[2] + bs), u3 * (acc[3] + bs));
        *(u32x2*)(br1 + (size_t)m * 512 + cc) = w; }
    __syncthreads();
}

__device__ __forceinline__ void moba_prep_unit(const Args& a, LAS unsigned char* lds, int unit) {
    const int blk = unit & 31, h = (unit >> 5) & 3, b = unit >> 7, m0 = b * SEQ + blk * 256;
    const int tid = otid();
    bf16_t* proj = (bf16_t*)(a.ws + WS_PROJ);
#pragma unroll 2
    for (int it = 0; it < 8; ++it) { const int item = tid + it * NTHREADS, tok = item >> 4, i = item & 15; const size_t m = (size_t)(m0 + tok);
        const float inv = exp2f(-(float)i * (18.931568569324174f / 16.f));
        const float ang = (float)a.pos[m] * inv; float sn, cs; sincosf(ang, &sn, &cs);
        bf16_t* kp = proj + m * NP + C_MK + h * 128 + i; bf16_t* qp = proj + m * NP + C_MQ + h * 128 + i;
        const float k1 = bf2f(kp[0]), k2 = bf2f(kp[16]), q1 = bf2f(qp[0]), q2 = bf2f(qp[16]);
        const unsigned kw = cvt_pk_bf16(k1 * cs - k2 * sn, k2 * cs + k1 * sn), qw = cvt_pk_bf16(q1 * cs - q2 * sn, q2 * cs + q1 * sn);
        kp[0] = (bf16_t)(kw & 0xffffu); kp[16] = (bf16_t)(kw >> 16); qp[0] = (bf16_t)(qw & 0xffffu); qp[16] = (bf16_t)(qw >> 16); }
    __threadfence_block();
    __syncthreads();
    { const int d = tid & 127, kg = tid >> 7; LAS float* red = (LAS float*)lds; float s = 0.f;
#pragma unroll 8
      for (int j = 0; j < 64; ++j) s += bf2f(proj[(size_t)(m0 + kg * 64 + j) * NP + C_MK + h * 128 + d]);
      red[kg * 128 + d] = s;
      __syncthreads();
      if (kg == 0) ((float*)(a.ws + WS_KMEAN))[((size_t)(b * 4 + h) * 32 + blk) * 128 + d] = (red[d] + red[128 + d] + red[256 + d] + red[384 + d]) * (1.f / 256.f);
      __syncthreads(); }
    { LAS unsigned char* tT = lds + 4096;
#pragma unroll 2
      for (int it = 0; it < 8; ++it) { const int p = tid + it * NTHREADS, key = p >> 4, pc = p & 15;
          const u32x4 w = *(const u32x4*)(proj + (size_t)(m0 + key) * NP + C_MV + h * 128 + pc * 8); const unsigned ww[4] = {w.x, w.y, w.z, w.w};
#pragma unroll
          for (int e = 0; e < 4; ++e) { *(LAS bf16_t*)(tT + (pc * 8 + 2 * e) * 528 + key * 2) = (bf16_t)(ww[e] & 0xffffu); *(LAS bf16_t*)(tT + (pc * 8 + 2 * e + 1) * 528 + key * 2) = (bf16_t)(ww[e] >> 16); } }
      __syncthreads();
      bf16_t* VT = (bf16_t*)(a.ws + WS_VT) + (size_t)(b * 4 + h) * 128 * SEQ + blk * 256;
#pragma unroll 2
      for (int it = 0; it < 8; ++it) { const int p = tid + it * NTHREADS, dv = p >> 5, pc = p & 31;
          *(u32x4*)(VT + (size_t)dv * SEQ + pc * 8) = *(const LAS u32x4*)(tT + dv * 528 + pc * 16); }
      __syncthreads(); }
}

__device__ __forceinline__ bf16_t* moba_part(const Args& a, int bh, int row, int k) {
    const size_t pr = (size_t)bh * SEQ + row;
    return (k < 2) ? (bf16_t*)(a.ws + WS_XBF) + (pr * 2 + k) * 128 : (bf16_t*)(a.ws + WS_MERGED) + (pr * 2 + (k - 2)) * 128;
}
__device__ __forceinline__ void moba_core(const Args& a, LAS unsigned char* lds, int b, int h, int row, bool valid, int slot, int kp_first, int ntiles, bool causal, int q0w) {
    const int tid = otid(), lane = tid & 63, fr = lane & 15, fq = lane >> 4;
    const int bh = b * 4 + h;
    const bf16_t* proj = (const bf16_t*)(a.ws + WS_PROJ);
    LAS unsigned char* Ks = lds + 34816;
    LAS unsigned char* Vs = lds + 34816 + 64 * 272;
    const bool wave_any = __builtin_amdgcn_ballot_w64(valid) != 0ull;
    bf16x8 qf[4];
#pragma unroll
    for (int kk = 0; kk < 4; ++kk) qf[kk] = *(const bf16x8*)(proj + (size_t)(b * SEQ + row) * NP + C_MQ + h * 128 + kk * 32 + fq * 8);
    f32x4 o[8];
#pragma unroll
    for (int j = 0; j < 8; ++j) o[j] = (f32x4){0.f, 0.f, 0.f, 0.f};
    float mrun = -INFINITY, lrun = 0.f;
    const bf16_t* kbase = proj + (size_t)(b * SEQ) * NP + C_MK + h * 128;
    const bf16_t* vbase = (const bf16_t*)(a.ws + WS_VT) + (size_t)bh * 128 * SEQ;
    u32x4 kreg[2], vreg[2];
#pragma unroll
    for (int i = 0; i < 2; ++i) { const int p = tid + i * NTHREADS; kreg[i] = *(const u32x4*)(kbase + (size_t)(kp_first + (p >> 4)) * NP + (p & 15) * 8); vreg[i] = *(const u32x4*)(vbase + (size_t)(p >> 3) * SEQ + kp_first + (p & 7) * 8); }
    const float SC = 0.08838834764831845f * 1.4426950408889634f;
    for (int it = 0; it < ntiles; ++it) {
        const int kp0 = kp_first + it * 64;
        __syncthreads();
#pragma unroll
        for (int i = 0; i < 2; ++i) { const int p = tid + i * NTHREADS; *(LAS u32x4*)(Ks + (p >> 4) * 272 + (p & 15) * 16) = kreg[i]; *(LAS u32x4*)(Vs + (p >> 3) * 144 + (p & 7) * 16) = vreg[i]; }
        __syncthreads();
        if (it + 1 < ntiles) { const int kn = kp0 + 64;
#pragma unroll
            for (int i = 0; i < 2; ++i) { const int p = tid + i * NTHREADS; kreg[i] = *(const u32x4*)(kbase + (size_t)(kn + (p >> 4)) * NP + (p & 15) * 8); vreg[i] = *(const u32x4*)(vbase + (size_t)(p >> 3) * SEQ + kn + (p & 7) * 8); } }
        const bool active = causal ? (kp0 <= q0w + 15) : wave_any;
        if (active) {
            f32x4 st[4];
#pragma unroll
            for (int kt = 0; kt < 4; ++kt) { f32x4 acc = {0.f, 0.f, 0.f, 0.f};
#pragma unroll
                for (int kk = 0; kk < 4; ++kk) { const bf16x8 kf = *(const LAS bf16x8*)(Ks + (kt * 16 + fr) * 272 + kk * 64 + fq * 16); acc = mfma16(kf, qf[kk], acc); }
                st[kt] = acc * SC; }
            if (causal) {
#pragma unroll
                for (int kt = 0; kt < 4; ++kt)
#pragma unroll
                    for (int jj = 0; jj < 4; ++jj) if (kp0 + kt * 16 + 4 * fq + jj > row) st[kt][jj] = -INFINITY;
            }
            float mx = -INFINITY;
#pragma unroll
            for (int kt = 0; kt < 4; ++kt) mx = fmaxf(mx, fmaxf(fmaxf(st[kt][0], st[kt][1]), fmaxf(st[kt][2], st[kt][3])));
            mx = fmaxf(mx, __shfl_xor(mx, 16)); mx = fmaxf(mx, __shfl_xor(mx, 32));
            const float mnew = fmaxf(mrun, mx);
            const float msafe = (mnew == -INFINITY) ? 0.f : mnew;
            const float alpha = __builtin_amdgcn_exp2f(mrun - msafe);
            float ls = 0.f;
#pragma unroll
            for (int kt = 0; kt < 4; ++kt)
#pragma unroll
                for (int jj = 0; jj < 4; ++jj) { const float p = __builtin_amdgcn_exp2f(st[kt][jj] - msafe); st[kt][jj] = p; ls += p; }
            ls += __shfl_xor(ls, 16); ls += __shfl_xor(ls, 32);
            lrun = lrun * alpha + ls; mrun = mnew;
            bf16x8 pf[2];
#pragma unroll
            for (int k2 = 0; k2 < 2; ++k2) { const u32x4 w = {cvt_pk_bf16(st[2 * k2][0], st[2 * k2][1]), cvt_pk_bf16(st[2 * k2][2], st[2 * k2][3]), cvt_pk_bf16(st[2 * k2 + 1][0], st[2 * k2 + 1][1]), cvt_pk_bf16(st[2 * k2 + 1][2], st[2 * k2 + 1][3])};
                pf[k2] = __builtin_bit_cast(bf16x8, w); }
#pragma unroll
            for (int dvt = 0; dvt < 8; ++dvt) { f32x4 acc = o[dvt] * alpha;
#pragma unroll
                for (int k2 = 0; k2 < 2; ++k2) { const u32x2 v0 = *(const LAS u32x2*)(Vs + (dvt * 16 + fr) * 144 + (32 * k2 + 4 * fq) * 2), v1 = *(const LAS u32x2*)(Vs + (dvt * 16 + fr) * 144 + (32 * k2 + 16 + 4 * fq) * 2);
                    const u32x4 vw = {v0.x, v0.y, v1.x, v1.y};
                    acc = mfma16(__builtin_bit_cast(bf16x8, vw), pf[k2], acc); }
                o[dvt] = acc; }
        }
    }
    if (valid) {
        const float il = 1.f / lrun;
        bf16_t* op = moba_part(a, bh, row, slot);
#pragma unroll
        for (int dvt = 0; dvt < 8; ++dvt) { u32x2 w; w.x = cvt_pk_bf16(o[dvt][0] * il, o[dvt][1] * il); w.y = cvt_pk_bf16(o[dvt][2] * il, o[dvt][3] * il);
            *(u32x2*)(op + dvt * 16 + 4 * fq) = w; }
        if (fq == 0) ((f32x2*)(a.ws + WS_ML))[((size_t)bh * SEQ + row) * 4 + slot] = (f32x2){mrun, lrun};
    }
    __syncthreads();
}

__device__ __forceinline__ void moba_own_unit(const Args& a, LAS unsigned char* lds, int b, int h, int qt) {
    const int tid = otid(), lane = tid & 63, wave = tid >> 6, fr = lane & 15;
    const int q0 = qt * 128, own = q0 >> 8, bs = own * 256, m0 = b * SEQ + q0, bh = b * 4 + h;
    const bf16_t* proj = (const bf16_t*)(a.ws + WS_PROJ);
    LAS float* km = (LAS float*)lds;
    LAS float* sc = (LAS float*)(lds + 16384);
    const float* kmg = (const float*)(a.ws + WS_KMEAN) + (size_t)bh * 32 * 128;
    int* cnt = (int*)(a.ws + WS_CTL + 14336); int* list = (int*)(a.ws + WS_LIST);
    if (own > 3) {
        for (int e = tid; e < own * 128; e += NTHREADS) km[e] = kmg[e];
        __syncthreads();
        const int row = tid >> 2, part = tid & 3; const bf16_t* qp = proj + (size_t)(m0 + row) * NP + C_MQ + h * 128;
        float s8[8];
#pragma unroll
        for (int jj = 0; jj < 8; ++jj) s8[jj] = 0.f;
#pragma unroll 2
        for (int dc = 0; dc < 16; ++dc) { const u32x4 w = *(const u32x4*)(qp + dc * 8); const float qv[8] = {bflo(w.x), bfhi(w.x), bflo(w.y), bfhi(w.y), bflo(w.z), bfhi(w.z), bflo(w.w), bfhi(w.w)};
#pragma unroll
            for (int jj = 0; jj < 8; ++jj) { const int j = part + 4 * jj; if (j < own) {
#pragma unroll
                for (int e = 0; e < 8; ++e) s8[jj] += qv[e] * km[j * 128 + dc * 8 + e]; } } }
#pragma unroll
        for (int jj = 0; jj < 8; ++jj) { const int j = part + 4 * jj; if (j < own) sc[row * 33 + j] = s8[jj]; }
        __syncthreads();
    }
    if (tid < 128) { const int ent = (q0 + tid) * 4;
        if (own <= 3) { for (int j = 0; j < own; ++j) { const int pos = atomicAdd(&cnt[bh * 32 + j], 1); list[(size_t)(bh * 32 + j) * SEQ + pos] = ent + j; } }
        else { float b0 = -INFINITY, b1 = -INFINITY, b2 = -INFINITY; int i0 = 0, i1 = 0, i2 = 0;
            for (int j = 0; j < own; ++j) { const float v = sc[tid * 33 + j];
                if (v > b0) { b2 = b1; i2 = i1; b1 = b0; i1 = i0; b0 = v; i0 = j; } else if (v > b1) { b2 = b1; i2 = i1; b1 = v; i1 = j; } else if (v > b2) { b2 = v; i2 = j; } }
            int pos = atomicAdd(&cnt[bh * 32 + i0], 1); list[(size_t)(bh * 32 + i0) * SEQ + pos] = ent + 0;
            pos = atomicAdd(&cnt[bh * 32 + i1], 1); list[(size_t)(bh * 32 + i1) * SEQ + pos] = ent + 1;
            pos = atomicAdd(&cnt[bh * 32 + i2], 1); list[(size_t)(bh * 32 + i2) * SEQ + pos] = ent + 2; } }
    moba_core(a, lds, b, h, q0 + wave * 16 + fr, true, 3, bs, ((q0 - bs) >> 6) + 2, true, q0 + wave * 16);
}

__device__ __forceinline__ void phase_moba_gather(const Args& a, LAS unsigned char* lds, int G, int bid) {
    const int tid = otid(), lane = tid & 63, wave = tid >> 6, fr = lane & 15;
    LAS int* start = (LAS int*)(lds + 71680);
    int* cnt = (int*)(a.ws + WS_CTL + 14336); const int* list = (const int*)(a.ws + WS_LIST);
    if (tid < 256) start[tid + 1] = (__hip_atomic_load(&cnt[tid], __ATOMIC_RELAXED, __HIP_MEMORY_SCOPE_AGENT) + 127) >> 7;
    __syncthreads();
    if (tid == 0) { int s = 0; start[0] = 0; for (int i = 1; i <= 256; ++i) { s += start[i]; start[i] = s; } }
    __syncthreads();
    const int total = start[256];
    for (int u = bid; u < total; u += G) {
        int lo = 0, hi = 255;
        while (lo < hi) { const int mid = (lo + hi + 1) >> 1; if (start[mid] <= u) lo = mid; else hi = mid - 1; }
        const int e = lo, bh = e >> 5, j = e & 31, chunk = u - start[e];
        const int c = __hip_atomic_load(&cnt[e], __ATOMIC_RELAXED, __HIP_MEMORY_SCOPE_AGENT);
        const int idx = chunk * 128 + wave * 16 + fr; const bool valid = idx < c;
        const int ent = valid ? list[(size_t)e * SEQ + idx] : 0;
        const int row = valid ? (ent >> 2) : (j + 1) * 256;
        moba_core(a, lds, bh >> 2, bh & 3, row, valid, ent & 3, j * 256, 4, false, 0);
    }
}

__device__ __forceinline__ void phase_moba_combine(const Args& a, int G, int bid) {
    const int tid = otid();
    bf16_t* br2 = (bf16_t*)(a.ws + WS_BR) + (size_t)2 * M * 512;
    for (int p = bid * NTHREADS + tid; p < 8 * SEQ * 4; p += G * NTHREADS) {
        const int pair = p >> 2, part = p & 3, bh = pair >> 13, row = pair & (SEQ - 1), own = row >> 8, nsel = own < 3 ? own : 3;
        const f32x2* ml = (const f32x2*)(a.ws + WS_ML) + (size_t)pair * 4;
        const f32x2 m3 = ml[3]; f32x2 mk[3]; float Mx = m3.x;
#pragma unroll
        for (int k = 0; k < 3; ++k) { mk[k] = (k < nsel) ? ml[k] : (f32x2){-INFINITY, 0.f}; Mx = fmaxf(Mx, mk[k].x); }
        float acc[32];
        float wsum = m3.y * __builtin_amdgcn_exp2f(m3.x - Mx);
        { const bf16_t* op = moba_part(a, bh, row, 3) + part * 32;
#pragma unroll
          for (int q = 0; q < 4; ++q) { const u32x4 w = *(const u32x4*)(op + q * 8); const unsigned ww[4] = {w.x, w.y, w.z, w.w};
#pragma unroll
              for (int e2 = 0; e2 < 4; ++e2) { acc[q * 8 + 2 * e2] = wsum * bflo(ww[e2]); acc[q * 8 + 2 * e2 + 1] = wsum * bfhi(ww[e2]); } } }
#pragma unroll
        for (int k = 0; k < 3; ++k) if (k < nsel) { const float wk = mk[k].y * __builtin_amdgcn_exp2f(mk[k].x - Mx); wsum += wk;
            const bf16_t* op = moba_part(a, bh, row, k) + part * 32;
#pragma unroll
            for (int q = 0; q < 4; ++q) { const u32x4 w = *(const u32x4*)(op + q * 8); const unsigned ww[4] = {w.x, w.y, w.z, w.w};
#pragma unroll
                for (int e2 = 0; e2 < 4; ++e2) { acc[q * 8 + 2 * e2] += wk * bflo(ww[e2]); acc[q * 8 + 2 * e2 + 1] += wk * bfhi(ww[e2]); } } }
        const float iw = 1.f / wsum;
        bf16_t* dst = br2 + (size_t)((bh >> 2) * SEQ + row) * 512 + (bh & 3) * 128 + part * 32;
#pragma unroll
        for (int q = 0; q < 4; ++q) *(u32x4*)(dst + q * 8) = (u32x4){cvt_pk_bf16(acc[q * 8] * iw, acc[q * 8 + 1] * iw), cvt_pk_bf16(acc[q * 8 + 2] * iw, acc[q * 8 + 3] * iw), cvt_pk_bf16(acc[q * 8 + 4] * iw, acc[q * 8 + 5] * iw), cvt_pk_bf16(acc[q * 8 + 6] * iw, acc[q * 8 + 7] * iw)};
    }
}

__device__ __forceinline__ void phase_ln(const Args& a, const float* gam, const float* bet, int G) {
    const int tid = otid(), lane = tid & 63, wave = tid >> 6;
    bf16_t* xbf = (bf16_t*)(a.ws + WS_XBF);
    f32x4 gv[4], bv[4];
#pragma unroll
    for (int j = 0; j < 4; ++j) { gv[j] = *(const f32x4*)(gam + 4 * lane + 256 * j); bv[j] = *(const f32x4*)(bet + 4 * lane + 256 * j); }
    for (int m = blockIdx.x * NWAVES + wave; m < M; m += G * NWAVES) {
        f32x4* xr = (f32x4*)(a.out + (size_t)m * D) + lane;
        f32x4 v[4]; float s = 0.f;
#pragma unroll
        for (int j = 0; j < 4; ++j) { v[j] = xr[64 * j]; s += (v[j][0] + v[j][1]) + (v[j][2] + v[j][3]); }
        const float mean = wave_sum(s) * (1.f / D); float s2 = 0.f;
#pragma unroll
        for (int j = 0; j < 4; ++j) { v[j] = v[j] - mean; s2 += (v[j][0] * v[j][0] + v[j][1] * v[j][1]) + (v[j][2] * v[j][2] + v[j][3] * v[j][3]); }
        const float rstd = 1.f / sqrtf(wave_sum(s2) * (1.f / D) + LN_EPS);
        u32x2* o8 = (u32x2*)(xbf + (size_t)m * D) + lane;
#pragma unroll
        for (int j = 0; j < 4; ++j) { const f32x4 y = v[j] * rstd * gv[j] + bv[j]; xr[64 * j] = y; o8[64 * j] = (u32x2){cvt_pk_bf16(y[0], y[1]), cvt_pk_bf16(y[2], y[3])}; }
    }
}

__global__ void __launch_bounds__(NTHREADS, 2) fwd_mega(Args a) {
    extern __shared__ __attribute__((aligned(16))) unsigned char lds_raw[];
    LAS unsigned char* lds = (LAS unsigned char*)lds_raw;
    cg::grid_group grid = cg::this_grid();
    volatile LAS unsigned* bst = (volatile LAS unsigned*)(lds + LDS_BYTES - 64);
    if (threadIdx.x == 0) { bst[0] = 0u; bst[1] = 0u; }
    __syncthreads();
    XcdBarrier xbar = xcd_barrier_post((unsigned*)(a.ws + WS_CTL), bst);
    const int G = gridDim.x, bid = blockIdx.x;
    const float ALPHA = 1.6817928305074290f;
    bf16_t* xbf = (bf16_t*)(a.ws + WS_XBF); bf16_t* proj = (bf16_t*)(a.ws + WS_PROJ);
    for (int ph = a.ph_lo; ph < a.ph_hi; ++ph) {
        const int l = ph / PH_PER_LAYER, k = ph % PH_PER_LAYER;
        int bidp = bid; asm volatile("" : "+s"(bidp));
        switch (k) {
        case 0: if (l == 0) phase_prep(a, 0, lds, G); break;
        case 1: { pg8::Gemm g{xbf, (const bf16_t*)(a.ws + WS_WIN), M, NP, D, D}; pg8::StaticOrder S; S.init(M, NP, G, bidp);
                  pg8::EpiStore<0> E{proj, NP}; pg8::gemm_phase(lds, g, S, E); } break;
        case 2: {
                  { const int t0 = otid(); if (t0 < 256) ((int*)(a.ws + WS_CTL + 14336))[t0] = 0; }
                  for (int u = bidp; u < 1792; u += G) { if (u < 256) moba_prep_unit(a, lds, u); else if (u < 768) gmlp_unit(a, l, lds, u - 256); else gla_kv_unit(a, l, lds, u - 768); } } break;
        case 3: { gla_scan(a, G);
                  for (int i = 0;; ++i) { const int u = i * G + bidp; if (u >= 512) break;
                      int qt, bh; if (u < 256) { qt = 63 - (u >> 3); bh = u & 7; } else { qt = (u - 256) >> 3; bh = u & 7; }
                      moba_own_unit(a, lds, bh >> 2, bh & 3, qt); } } break;
        case 4: phase_moba_gather(a, lds, G, bidp); break;
        case 5: { phase_moba_combine(a, G, bidp); for (int u = bidp; u < 1024; u += G) gla_out_unit(a, l, lds, u); } break;
        case 6: { pg8::Gemm g{(const bf16_t*)(a.ws + WS_BR), (const bf16_t*)(a.ws + WS_WBR), 3 * M, 3 * D, 512, 512}; pg8::MergeOrder S{G, bidp};
                  pg8::EpiMerge E{proj, (float*)(a.ws + WS_PROJ), (bf16_t*)(a.ws + WS_MERGED)}; pg8::gemm_phase(lds, g, S, E); } break;
        case 7: { pg8::Gemm g{(const bf16_t*)(a.ws + WS_MERGED), (const bf16_t*)(a.ws + WS_WOUT), M, D, D, D}; pg8::StaticOrder S; S.init(M, D, G, bidp);
                  pg8::EpiResid E{l == 0 ? a.x : a.out, a.out, ALPHA}; pg8::gemm_phase(lds, g, S, E); } break;
        case 8: phase_ln(a, a.ln1_g + (size_t)l * D, a.ln1_b + (size_t)l * D, G); break;
        case 9: { pg8::Gemm g{xbf, (const bf16_t*)(a.ws + WS_W1), M, FF, D, D}; pg8::StaticOrder S; S.init(M, FF, G, bidp);
                  pg8::EpiStore<2> E{proj, FF}; pg8::gemm_phase(lds, g, S, E); } break;
        case 10: { pg8::Gemm g{proj, (const bf16_t*)(a.ws + WS_W2), M, D, FF, FF}; pg8::StaticOrder S; S.init(M, D, G, bidp);
                  pg8::EpiResid E{a.out, a.out, ALPHA}; pg8::gemm_phase(lds, g, S, E); } break;
        default: phase_ln(a, a.ln2_g + (size_t)l * D, a.ln2_b + (size_t)l * D, G); if (l + 1 < DEPTH) phase_prep(a, l + 1, lds, G); break;
        }
        if (ph + 1 < a.ph_hi && !(ph % PH_PER_LAYER == 0 && ph > 0)) { if (ph == 0) grid.sync(); else xcd_barrier(xbar); }
    }
}

#ifndef MK_PER_PHASE
#define MK_PER_PHASE 0
#endif
extern "C" void kernel_launch(void* const* d_in, const int* in_sizes, int n_in, void* d_out, int out_size, void* d_ws, size_t ws_size, hipStream_t stream) {
    static int grid = 0;
    if (grid == 0) {
        if (n_in != 18 || out_size != M * D || ws_size < WS_END) { fprintf(stderr, "kernel_launch: unexpected problem (n_in %d out %d ws %zu)\n", n_in, out_size, ws_size); grid = -1; return; }
        int dev = 0, cus = 0, per_cu = 0;
        if (hipGetDevice(&dev) != hipSuccess || hipDeviceGetAttribute(&cus, hipDeviceAttributeMultiprocessorCount, dev) != hipSuccess) { grid = -1; return; }
        if (hipFuncSetAttribute((const void*)fwd_mega, hipFuncAttributeMaxDynamicSharedMemorySize, LDS_BYTES) != hipSuccess) { fprintf(stderr, "kernel_launch: hipFuncSetAttribute failed\n"); grid = -1; return; }
        if (hipOccupancyMaxActiveBlocksPerMultiprocessor(&per_cu, (const void*)fwd_mega, NTHREADS, LDS_BYTES) != hipSuccess || per_cu < 1) { fprintf(stderr, "kernel_launch: occupancy query says %d\n", per_cu); per_cu = 1; }
        (void)hipGetLastError();
        grid = cus;
        if (grid < 32) { fprintf(stderr, "kernel_launch: needs >= 32 CUs\n"); grid = -1; return; }
    }
    if (grid < 0) return;
    Args a{};
    a.x = (const float*)d_in[0]; a.pos = (const int*)d_in[1]; a.w_in = (const float*)d_in[2]; a.w_gate_up = (const float*)d_in[3]; a.b_gate = (const float*)d_in[4];
    a.gla_norm_w = (const float*)d_in[5]; a.gmlp_ln_g = (const float*)d_in[6]; a.gmlp_ln_b = (const float*)d_in[7]; a.gmlp_w_s = (const float*)d_in[8]; a.gmlp_b_s = (const float*)d_in[9];
    a.w_branch = (const float*)d_in[10]; a.w_out = (const float*)d_in[11]; a.ln1_g = (const float*)d_in[12]; a.ln1_b = (const float*)d_in[13]; a.w_ff1 = (const float*)d_in[14];
    a.w_ff2 = (const float*)d_in[15]; a.ln2_g = (const float*)d_in[16]; a.ln2_b = (const float*)d_in[17]; a.out = (float*)d_out; a.ws = (unsigned char*)d_ws;
    if (hipMemsetAsync((char*)d_ws + WS_CTL, 0, CTL_BYTES, stream) != hipSuccess) { fprintf(stderr, "kernel_launch: memset of barrier words failed\n"); return; }
#if MK_PER_PHASE
    for (int ph = 0; ph < N_PHASES; ++ph) { a.ph_lo = ph; a.ph_hi = ph + 1; hipLaunchKernelGGL(fwd_mega, dim3(grid), dim3(NTHREADS), LDS_BYTES, stream, a); }
#else
    a.ph_lo = 0; a.ph_hi = N_PHASES;
    void* args[] = {&a};
    hipError_t e = hipLaunchCooperativeKernel((const void*)fwd_mega, dim3(grid), dim3(NTHREADS), args, LDS_BYTES, stream);
    if (e != hipSuccess) fprintf(stderr, "kernel_launch: cooperative launch failed: %s (grid %d)\n", hipGetErrorString(e), grid);
#endif
}
```
